# Optimizing an MI355X kernel written in HIP

```python
import jax
import jax.numpy as jnp
from jax import lax

D_MODEL = 1024
BATCH = 2
SEQ = 8192
DEPTH = 1

HEAD_DIM = 64
NSA_HEADS = 8
NSA_KV = 2
SWA_HEADS = 8
SWA_KV = 1
CMP_STRIDE = 16
CMP_LEN = 2 * CMP_STRIDE
CMP_HIDDEN = 256
SEL_LEN = 64
SEL_TOPN = 16
SEL_LOCAL = 2
NSA_WINDOW = 512
SWA_WINDOW = 128
Q_BLOCK = 128
D_FF = 2816
ROPE_THETA = 10000.0
RMS_EPS = 1e-6
FFN_HALF = 0.5
NEG_INF = -1e30
FORCE = 1e9

NSA_Q_W = NSA_HEADS * HEAD_DIM
NSA_KV_W = NSA_KV * HEAD_DIM
NSA_GATE_W = 3 * NSA_HEADS
SWA_Q_W = SWA_HEADS * HEAD_DIM
SWA_KV_W = SWA_KV * HEAD_DIM
IN_WIDTHS = (NSA_Q_W, NSA_KV_W, NSA_KV_W, NSA_KV_W, NSA_KV_W, NSA_KV_W, NSA_KV_W, NSA_GATE_W,
             SWA_Q_W, SWA_KV_W, SWA_KV_W, D_MODEL, D_MODEL)

kernel_name = 'hybrid_nsa_swa_sink_macaron'


def _split_points():
    pts, acc = [], 0
    for w in IN_WIDTHS[:-1]:
        acc += w
        pts.append(acc)
    return pts


def _rmsnorm(x, g):
    xf = x.astype(jnp.float32)
    y = xf * lax.rsqrt(jnp.mean(xf * xf, axis=-1, keepdims=True) + RMS_EPS)
    return (y * g.astype(jnp.float32)).astype(x.dtype)


def _swiglu(x, w_gate, w_up, w_down):
    return (jax.nn.silu(x @ w_gate) * (x @ w_up)) @ w_down


def _rope(x, pos):
    half = HEAD_DIM // 2
    inv_freq = ROPE_THETA ** (-jnp.arange(half, dtype=jnp.float32) / half)
    ang = pos.astype(jnp.float32)[..., None] * inv_freq
    cos = jnp.cos(ang)[:, :, None, :]
    sin = jnp.sin(ang)[:, :, None, :]
    xf = x.astype(jnp.float32)
    x1, x2 = xf[..., :half], xf[..., half:]
    return jnp.concatenate([x1 * cos - x2 * sin, x2 * cos + x1 * sin], axis=-1).astype(x.dtype)


def _banded_attention(q, k, v, window, sink):
    B, S, H, D = q.shape
    G = k.shape[2]
    R = H // G
    nb = S // Q_BLOCK
    pad = -(-window // Q_BLOCK) * Q_BLOCK
    L = pad + Q_BLOCK
    kp = jnp.pad(k, ((0, 0), (pad, 0), (0, 0), (0, 0)))
    vp = jnp.pad(v, ((0, 0), (pad, 0), (0, 0), (0, 0)))
    idx = jnp.arange(nb)[:, None] * Q_BLOCK + jnp.arange(L)[None, :]
    kb = kp[:, idx]
    vb = vp[:, idx]
    qb = q.reshape(B, nb, Q_BLOCK, G, R, D)
    s = jnp.einsum('bnqgrd,bnkgd->bngrqk', qb, kb).astype(jnp.float32) * (D ** -0.5)
    qpos = jnp.arange(nb)[:, None] * Q_BLOCK + jnp.arange(Q_BLOCK)[None, :]
    kpos = idx - pad
    diff = qpos[:, :, None] - kpos[:, None, :]
    mask = (diff >= 0) & (diff < window) & (kpos[:, None, :] >= 0)
    s = jnp.where(mask[None, :, None, None], s, NEG_INF)
    if sink is None:
        p = jax.nn.softmax(s, axis=-1)
    else:
        sk = sink.astype(jnp.float32).reshape(G, R)[None, None, :, :, None, None]
        m = jnp.maximum(jnp.max(s, axis=-1, keepdims=True), sk)
        e = jnp.exp(s - m)
        p = e / (jnp.sum(e, axis=-1, keepdims=True) + jnp.exp(sk - m))
    o = jnp.einsum('bngrqk,bnkgd->bnqgrd', p.astype(vb.dtype), vb)
    return o.reshape(B, S, H, D)


def _compress(kv, pe, w1, w2):
    B, S, G, D = kv.shape
    c = kv.reshape(B, S // CMP_STRIDE, CMP_STRIDE, G, D)
    blocks = jnp.concatenate([c[:, :-1], c[:, 1:]], axis=2)
    blocks = blocks + pe[None, None, :, None, :]
    n_cmp = blocks.shape[1]
    flat = blocks.transpose(0, 1, 3, 2, 4).reshape(B, n_cmp, G, CMP_LEN * D)
    return jax.nn.gelu(flat @ w1) @ w2


def _nsa(q, k_cmp, v_cmp, k_slc, v_slc, k_win, v_win, gates, pos, pe_k, wk1, wk2, pe_v, wv1, wv2):
    B, S, H, D = q.shape
    G = NSA_KV
    R = H // G
    scale = D ** -0.5
    n_sel = S // SEL_LEN
    n_top = min(SEL_TOPN, n_sel)
    nb = S // Q_BLOCK
    qg = q.reshape(B, S, G, R, D)
    t = jnp.arange(S)

    kc = _compress(k_cmp, pe_k, wk1, wk2)
    vc = _compress(v_cmp, pe_v, wv1, wv2)
    n_cmp = kc.shape[1]
    kc = _rope(kc, pos[:, CMP_LEN - 1::CMP_STRIDE])
    end = jnp.arange(n_cmp) * CMP_STRIDE + CMP_LEN - 1
    vis = end[None, :] <= t[:, None]
    s = jnp.einsum('bsgrd,bcgd->bgrsc', qg, kc).astype(jnp.float32) * scale
    s = jnp.where(vis, s, NEG_INF)
    p_cmp = jnp.where(vis, jax.nn.softmax(s, axis=-1), 0.0)
    o_cmp = jnp.einsum('bgrsc,bcgd->bsgrd', p_cmp.astype(vc.dtype), vc)

    cs = jnp.arange(n_cmp) * CMP_STRIDE
    ss = jnp.arange(n_sel) * SEL_LEN
    overlap = jnp.clip(jnp.minimum(cs[:, None] + CMP_LEN, ss[None, :] + SEL_LEN)
                       - jnp.maximum(cs[:, None], ss[None, :]), 0, None).astype(jnp.float32) / CMP_LEN
    imp = jnp.einsum('bgrsc,cj->bgsj', p_cmp, overlap)
    blk = jnp.arange(n_sel)[None, :]
    tb = (t // SEL_LEN)[:, None]
    forced = (blk == 0) | ((tb - blk >= 0) & (tb - blk < SEL_LOCAL))
    imp = jnp.where(forced, FORCE, jnp.where(blk > tb, -FORCE, imp))
    _, sel = lax.top_k(imp, n_top)

    kT = k_slc.transpose(0, 2, 1, 3)
    vT = v_slc.transpose(0, 2, 1, 3)
    offs = jnp.arange(SEL_LEN)
    gather = jax.vmap(jax.vmap(lambda a, i: a[i]))

    def one_block(args):
        qb, selb, tq = args
        idx = (selb[..., None] * SEL_LEN + offs).reshape(B, G, Q_BLOCK, n_top * SEL_LEN)
        kb = gather(kT, idx)
        vb = gather(vT, idx)
        sc = jnp.einsum('bqgrd,bgqtd->bgrqt', qb, kb).astype(jnp.float32) * scale
        m = (idx <= tq[None, None, :, None])[:, :, None]
        pr = jax.nn.softmax(jnp.where(m, sc, NEG_INF), axis=-1)
        return jnp.einsum('bgrqt,bgqtd->bqgrd', pr.astype(vb.dtype), vb)

    qs = qg.reshape(B, nb, Q_BLOCK, G, R, D).transpose(1, 0, 2, 3, 4, 5)
    sels = sel.reshape(B, G, nb, Q_BLOCK, n_top).transpose(2, 0, 1, 3, 4)
    tqs = t.reshape(nb, Q_BLOCK)
    o_slc = lax.map(one_block, (qs, sels, tqs))
    o_slc = o_slc.transpose(1, 0, 2, 3, 4, 5).reshape(B, S, G, R, D)

    o_win = _banded_attention(q, k_win, v_win, NSA_WINDOW, None).reshape(B, S, G, R, D)

    g = jax.nn.sigmoid(gates.astype(jnp.float32)).reshape(B, S, 3, G, R, 1)
    o = (g[:, :, 0] * o_cmp.astype(jnp.float32) + g[:, :, 1] * o_slc.astype(jnp.float32)
         + g[:, :, 2] * o_win.astype(jnp.float32))
    return o.astype(q.dtype).reshape(B, S, H * D)


def setup_inputs(seed: int = 0) -> dict:
    key = jax.random.key(seed)
    ks = jax.random.split(key, 24)
    f32 = jnp.float32

    def w(k, shape, fan_in):
        return jax.random.normal(k, shape, f32) * fan_in ** -0.5

    def gain(k, shape):
        return 1.0 + 0.02 * jax.random.normal(k, shape, f32)

    w_in_width = sum(IN_WIDTHS)
    return {
        'x': jax.random.normal(ks[0], (BATCH, SEQ, D_MODEL), f32),
        'positions': jnp.broadcast_to(jnp.arange(SEQ, dtype=jnp.int32), (BATCH, SEQ)),
        'norm_ffn1': gain(ks[1], (DEPTH, D_MODEL)),
        'ffn1_gate': w(ks[2], (DEPTH, D_MODEL, D_FF), D_MODEL),
        'ffn1_up': w(ks[3], (DEPTH, D_MODEL, D_FF), D_MODEL),
        'ffn1_down': w(ks[4], (DEPTH, D_FF, D_MODEL), D_FF),
        'norm_mix': gain(ks[5], (DEPTH, D_MODEL)),
        'w_in': w(ks[6], (DEPTH, D_MODEL, w_in_width), D_MODEL),
        'cmp_pe_k': 0.1 * jax.random.normal(ks[7], (DEPTH, CMP_LEN, HEAD_DIM), f32),
        'cmp_k_w1': w(ks[8], (DEPTH, CMP_LEN * HEAD_DIM, CMP_HIDDEN), CMP_LEN * HEAD_DIM),
        'cmp_k_w2': w(ks[9], (DEPTH, CMP_HIDDEN, HEAD_DIM), CMP_HIDDEN),
        'cmp_pe_v': 0.1 * jax.random.normal(ks[10], (DEPTH, CMP_LEN, HEAD_DIM), f32),
        'cmp_v_w1': w(ks[11], (DEPTH, CMP_LEN * HEAD_DIM, CMP_HIDDEN), CMP_LEN * HEAD_DIM),
        'cmp_v_w2': w(ks[12], (DEPTH, CMP_HIDDEN, HEAD_DIM), CMP_HIDDEN),
        'swa_sinks': jax.random.normal(ks[13], (DEPTH, SWA_HEADS), f32),
        'w_branch_a': w(ks[14], (DEPTH, NSA_Q_W, D_MODEL), NSA_Q_W),
        'w_branch_b': w(ks[15], (DEPTH, SWA_Q_W, D_MODEL), SWA_Q_W),
        'w_out': w(ks[16], (DEPTH, D_MODEL, D_MODEL), D_MODEL),
        'norm_ffn2': gain(ks[17], (DEPTH, D_MODEL)),
        'ffn2_gate': w(ks[18], (DEPTH, D_MODEL, D_FF), D_MODEL),
        'ffn2_up': w(ks[19], (DEPTH, D_MODEL, D_FF), D_MODEL),
        'ffn2_down': w(ks[20], (DEPTH, D_FF, D_MODEL), D_FF),
        'norm_final': gain(ks[21], (D_MODEL,)),
    }


def reference(x, positions, norm_ffn1, ffn1_gate, ffn1_up, ffn1_down, norm_mix, w_in,
              cmp_pe_k, cmp_k_w1, cmp_k_w2, cmp_pe_v, cmp_v_w1, cmp_v_w2, swa_sinks,
              w_branch_a, w_branch_b, w_out, norm_ffn2, ffn2_gate, ffn2_up, ffn2_down, norm_final):
    B, S, _ = x.shape
    pts = _split_points()
    h = x
    for i in range(DEPTH):
        h = h + FFN_HALF * _swiglu(_rmsnorm(h, norm_ffn1[i]), ffn1_gate[i], ffn1_up[i], ffn1_down[i])

        u = _rmsnorm(h, norm_mix[i])
        (nq, kc, vc, ksl, vsl, kwn, vwn, ng, sq, sk, sv, ga, gb) = jnp.split(u @ w_in[i], pts, axis=-1)
        nq = _rope(nq.reshape(B, S, NSA_HEADS, HEAD_DIM), positions)
        kc = kc.reshape(B, S, NSA_KV, HEAD_DIM)
        vc = vc.reshape(B, S, NSA_KV, HEAD_DIM)
        ksl = _rope(ksl.reshape(B, S, NSA_KV, HEAD_DIM), positions)
        vsl = vsl.reshape(B, S, NSA_KV, HEAD_DIM)
        kwn = _rope(kwn.reshape(B, S, NSA_KV, HEAD_DIM), positions)
        vwn = vwn.reshape(B, S, NSA_KV, HEAD_DIM)
        o_a = _nsa(nq, kc, vc, ksl, vsl, kwn, vwn, ng, positions,
                   cmp_pe_k[i], cmp_k_w1[i], cmp_k_w2[i], cmp_pe_v[i], cmp_v_w1[i], cmp_v_w2[i])

        sq = _rope(sq.reshape(B, S, SWA_HEADS, HEAD_DIM), positions)
        sk = _rope(sk.reshape(B, S, SWA_KV, HEAD_DIM), positions)
        sv = sv.reshape(B, S, SWA_KV, HEAD_DIM)
        o_b = _banded_attention(sq, sk, sv, SWA_WINDOW, swa_sinks[i]).reshape(B, S, SWA_Q_W)

        merged = jax.nn.sigmoid(ga) * (o_a @ w_branch_a[i]) + jax.nn.sigmoid(gb) * (o_b @ w_branch_b[i])
        h = h + merged @ w_out[i]

        h = h + FFN_HALF * _swiglu(_rmsnorm(h, norm_ffn2[i]), ffn2_gate[i], ffn2_up[i], ffn2_down[i])
    return _rmsnorm(h, norm_final)
```

```cpp
#include <hip/hip_runtime.h>
#include <hip/hip_cooperative_groups.h>
#include <cstdio>
#include <cstdint>
namespace cg = cooperative_groups;

constexpr int SEQ = 8192, NB = 2, TOK = NB * SEQ, DM = 1024, DFF = 2816;
constexpr float RMS_EPS = 1e-6f;
constexpr float LOG2E = 1.4426950408889634f;
constexpr float C2 = 0.125f * 1.4426950408889634f;
namespace pg8 {
#define PG8_LAS __attribute__((address_space(3)))
typedef unsigned short bf16_t;
typedef short bf16x8 __attribute__((ext_vector_type(8)));
typedef float f32x4 __attribute__((ext_vector_type(4)));
typedef unsigned u32x4 __attribute__((ext_vector_type(4)));
constexpr int BM = 256, BK = 64, HALF = 128, HTB = HALF * BK * 2  , STAGE_BYTES = 8 * HTB, NXCD = 8, WGM = 8;

__host__ __device__ __forceinline__ int lds_byte(int r, int c) { const int st = (r >> 4) * 2 + (c >> 5), rr = r & 15, cc = c & 31, ob = rr * 64 + cc * 2; return st * 1024 + (ob ^ (((ob >> 9) & 1) << 5)); }
__host__ __device__ __forceinline__ void stage_rc(int b, int& R, int& C) { const int st = b / 1024, sb = b % 1024, swz = sb ^ (((sb >> 9) & 1) << 5); R = (st >> 1) * 16 + swz / 64; C = (st & 1) * 32 + (swz % 64) / 2; }
__host__ __device__ __forceinline__ int perm32(int rho) { const int n = rho >> 4, i = rho & 15; return 8 * (i >> 2) + 4 * n + (i & 3); }

struct Unit { int pm, pn; };
struct Gemm { const bf16_t* A; const bf16_t* Bt; int M, N, K; };

struct StaticOrder {
    int nM, nN, nwg, G, c;
    __host__ __device__ void init(int M, int N, int G_, int c_) { nM = M / BM; nN = N / BM; nwg = nM * nN; G = G_; c = c_; }
    __host__ __device__ bool next(int i, Unit& u) const {
        const long L = (long)i * G + c; if (L >= nwg) return false;
        int wgid = (int)L; { const int q = nwg / NXCD, r = nwg % NXCD, xcd = wgid % NXCD, off = wgid / NXCD; wgid = (xcd < r ? xcd * (q + 1) : r * (q + 1) + (xcd - r) * q) + off; }
        const int nig = WGM * nN, gid = wgid / nig, fm = gid * WGM, gsz = (nM - fm) < WGM ? (nM - fm) : WGM;
        u.pm = fm + ((wgid % nig) % gsz); u.pn = (wgid % nig) / gsz; return true;
    }
    __device__ __forceinline__ void a_ready(const Unit&) const {}
    __device__ __forceinline__ void done(const Unit&) const {}
};

typedef __bf16 bf16x2n __attribute__((ext_vector_type(2)));
typedef float f32x2n __attribute__((ext_vector_type(2)));
__device__ __forceinline__ unsigned cvt_pk_bf16(float lo, float hi) { const f32x2n v = {lo, hi}; return __builtin_bit_cast(unsigned, __builtin_convertvector(v, bf16x2n)); }
typedef float f32x2 __attribute__((ext_vector_type(2)));
__device__ __forceinline__ float fast_rcp(float x) { return __builtin_amdgcn_rcpf(x); }
__device__ __forceinline__ float fast_exp2(float x) { return __builtin_amdgcn_exp2f(x); }
__device__ __forceinline__ float sigmoidf_(float x) { return fast_rcp(1.0f + fast_exp2(-x * 1.4426950408889634f)); }
__device__ __forceinline__ float bf2f(unsigned short b) { return __uint_as_float(((unsigned)b) << 16); }
__device__ __forceinline__ u32x4 pack8(f32x4 a, f32x4 b) { u32x4 w; w.x = cvt_pk_bf16(a[0], a[1]); w.y = cvt_pk_bf16(a[2], a[3]); w.z = cvt_pk_bf16(b[0], b[1]); w.w = cvt_pk_bf16(b[2], b[3]); return w; }
__device__ __forceinline__ float rstd_of(const float* ssq, int row) {
    const f32x4* p = (const f32x4*)(ssq + (size_t)row * 16); const f32x4 a = p[0], b = p[1], c = p[2], d = p[3];
    const float s = (((a[0] + a[1]) + (a[2] + a[3])) + ((b[0] + b[1]) + (b[2] + b[3]))) + (((c[0] + c[1]) + (c[2] + c[3])) + ((d[0] + d[1]) + (d[2] + d[3])));
    return 1.0f / sqrtf(s * (1.0f / 1024.0f) + 1e-6f); }

template <bool NT> __device__ __forceinline__ float rstd_row(const float* ssq, int row) {
    const f32x4* p = (const f32x4*)(ssq + (size_t)row * 16);
    const f32x4 a = NT ? __builtin_nontemporal_load(p) : p[0], b = NT ? __builtin_nontemporal_load(p + 1) : p[1], c = NT ? __builtin_nontemporal_load(p + 2) : p[2], d = NT ? __builtin_nontemporal_load(p + 3) : p[3];
    const float s = (((a[0] + a[1]) + (a[2] + a[3])) + ((b[0] + b[1]) + (b[2] + b[3]))) + (((c[0] + c[1]) + (c[2] + c[3])) + ((d[0] + d[1]) + (d[2] + d[3])));
    return 1.0f / sqrtf(s * (1.0f / 1024.0f) + 1e-6f); }
template <bool NT> __device__ __forceinline__ void wave_rstd8(const float* ssq, int rowbase, float (&rs)[2][4]) {
    const int lane = threadIdx.x & 63;
    const float v0 = rstd_row<NT>(ssq, rowbase + lane), v1 = rstd_row<NT>(ssq, rowbase + HALF + lane);
#pragma unroll
    for (int m = 0; m < 4; ++m) { rs[0][m] = __shfl(v0, m * 16 + (lane & 15)); rs[1][m] = __shfl(v1, m * 16 + (lane & 15)); }
}

struct EpiSwiglu {
    static constexpr bool PERM = true, AFTER_DRAIN = false;
    bf16_t* O; const float* ssq;
    __device__ __forceinline__ void operator()(const f32x4 (&acc)[2][2][4][2], const Unit& u, int wr, int wc, int fr, int fq) const {
        asm volatile("" : "+v"(fr), "+v"(fq));
        const int row0 = u.pm * BM + wr * 64 + fr, col0 = u.pn * 128 + wc * 32 + 8 * fq;
        float rsv[2][4]; wave_rstd8<false>(ssq, u.pm * BM + wr * 64, rsv);
#pragma unroll
        for (int ai = 0; ai < 2; ++ai)
#pragma unroll
            for (int m = 0; m < 4; ++m) {
                const int row = row0 + ai * HALF + m * 16; const float rs = rsv[ai][m];
                f32x4 o[2];
#pragma unroll
                for (int n = 0; n < 2; ++n) {
                    const f32x4 g = acc[ai][0][m][n] * rs, up = acc[ai][1][m][n] * rs;
#pragma unroll
                    for (int j = 0; j < 4; ++j) o[n][j] = g[j] * sigmoidf_(g[j]) * up[j];
                }
                *(u32x4*)(O + (size_t)row * 2816 + col0) = pack8(o[0], o[1]);
            }
    }
};

struct EpiResid {
    static constexpr bool PERM = true, AFTER_DRAIN = false;
    const float* base; float* out; bf16_t* xb; float* ssq; float scale;
    __device__ __forceinline__ void operator()(const f32x4 (&acc)[2][2][4][2], const Unit& u, int wr, int wc, int fr, int fq) const {
        asm volatile("" : "+v"(fr), "+v"(fq));
        const int row0 = u.pm * BM + wr * 64 + fr, col0 = u.pn * BM + wc * 32 + 8 * fq;
        f32x4 nb[2][2];
#pragma unroll
        for (int bj = 0; bj < 2; ++bj) { const size_t off = (size_t)row0 * 1024 + col0 + bj * HALF; nb[bj][0] = *(const f32x4*)(base + off); nb[bj][1] = *(const f32x4*)(base + off + 4); }
#pragma unroll
        for (int it = 0; it < 8; ++it) {
            const int ai = it >> 2, m = it & 3;
            const int row = row0 + ai * HALF + m * 16; float s = 0.f;
            f32x4 cb[2][2];
#pragma unroll
            for (int bj = 0; bj < 2; ++bj) { cb[bj][0] = nb[bj][0]; cb[bj][1] = nb[bj][1]; }
            if (it < 7) { const int rown = row0 + ((it + 1) >> 2) * HALF + ((it + 1) & 3) * 16;
#pragma unroll
                for (int bj = 0; bj < 2; ++bj) { const size_t off = (size_t)rown * 1024 + col0 + bj * HALF; nb[bj][0] = *(const f32x4*)(base + off); nb[bj][1] = *(const f32x4*)(base + off + 4); } }
#pragma unroll
            for (int bj = 0; bj < 2; ++bj) {
                const size_t off = (size_t)row * 1024 + col0 + bj * HALF;
                const f32x4 h0 = cb[bj][0] + acc[ai][bj][m][0] * scale, h1 = cb[bj][1] + acc[ai][bj][m][1] * scale;
                *(f32x4*)(out + off) = h0; *(f32x4*)(out + off + 4) = h1;
                if (xb) *(u32x4*)(xb + off) = pack8(h0, h1);
                s += (h0[0] * h0[0] + h0[1] * h0[1]) + (h0[2] * h0[2] + h0[3] * h0[3]) + (h1[0] * h1[0] + h1[1] * h1[1]) + (h1[2] * h1[2] + h1[3] * h1[3]);
            }
            s += __shfl_xor(s, 16); s += __shfl_xor(s, 32);
            if (fq == 0) ssq[(size_t)row * 16 + u.pn * 4 + wc] = s;
            asm volatile("" ::: "memory");
        }
    }
};

template <int PASS> struct EpiMerge {
    static constexpr bool PERM = true, AFTER_DRAIN = false;
    bf16_t* G; const bf16_t* G2;
    __device__ __forceinline__ void operator()(const f32x4 (&acc)[2][2][4][2], const Unit& u, int wr, int wc, int fr, int fq) const {
        asm volatile("" : "+v"(fr), "+v"(fq));
        const int row0 = u.pm * BM + wr * 64 + fr, col0 = u.pn * BM + wc * 32 + 8 * fq;
        unsigned ng[2][4]; u32x4 ng2[2];
#define EPM_LOAD(rw) do { _Pragma("unroll") for (int bj = 0; bj < 2; ++bj) { const size_t off_ = (size_t)(rw) * 1024 + col0 + bj * HALF; unsigned* gp_ = (unsigned*)(G + off_); \
            _Pragma("unroll") for (int q = 0; q < 4; ++q) ng[bj][q] = __hip_atomic_load(gp_ + q, __ATOMIC_RELAXED, __HIP_MEMORY_SCOPE_AGENT); \
            if (PASS == 2) ng2[bj] = *(const u32x4*)(G2 + off_); } } while (0)
        EPM_LOAD(row0);
#pragma unroll
        for (int it = 0; it < 8; ++it) {
            const int ai = it >> 2, m = it & 3;
            const int row = row0 + ai * HALF + m * 16;
            unsigned gw[2][4]; u32x4 g2[2];
#pragma unroll
            for (int bj = 0; bj < 2; ++bj) { g2[bj] = ng2[bj];
#pragma unroll
                for (int q = 0; q < 4; ++q) gw[bj][q] = ng[bj][q]; }
            if (it < 7) { const int rown = row0 + ((it + 1) >> 2) * HALF + ((it + 1) & 3) * 16; EPM_LOAD(rown); }
#pragma unroll
            for (int bj = 0; bj < 2; ++bj) {
                const size_t off = (size_t)row * 1024 + col0 + bj * HALF;
                f32x4 r0, r1;
#pragma unroll
                for (int q = 0; q < 2; ++q) {
                    const float glo = __uint_as_float(gw[bj][q] << 16), ghi = __uint_as_float(gw[bj][q] & 0xffff0000u), hlo = __uint_as_float(gw[bj][2 + q] << 16), hhi = __uint_as_float(gw[bj][2 + q] & 0xffff0000u);
                    if (PASS == 1) { r0[2 * q] = glo * acc[ai][bj][m][0][2 * q]; r0[2 * q + 1] = ghi * acc[ai][bj][m][0][2 * q + 1]; r1[2 * q] = hlo * acc[ai][bj][m][1][2 * q]; r1[2 * q + 1] = hhi * acc[ai][bj][m][1][2 * q + 1]; }
                    else { const unsigned a_ = g2[bj][q], b_ = g2[bj][2 + q];
                        r0[2 * q] = glo + __uint_as_float(a_ << 16) * acc[ai][bj][m][0][2 * q]; r0[2 * q + 1] = ghi + __uint_as_float(a_ & 0xffff0000u) * acc[ai][bj][m][0][2 * q + 1];
                        r1[2 * q] = hlo + __uint_as_float(b_ << 16) * acc[ai][bj][m][1][2 * q]; r1[2 * q + 1] = hhi + __uint_as_float(b_ & 0xffff0000u) * acc[ai][bj][m][1][2 * q + 1]; }
                }
                *(u32x4*)(G + off) = pack8(r0, r1);
            }
            asm volatile("" ::: "memory");
        }
#undef EPM_LOAD
    }
};

__device__ __forceinline__ void rope8(f32x4& v0, f32x4& v1, const f32x4 c, const f32x4 s) {
    f32x4 a, b;
    a[0] = v0[0] * c[0] - v0[1] * s[0]; a[1] = v0[1] * c[0] + v0[0] * s[0];
    a[2] = v0[2] * c[1] - v0[3] * s[1]; a[3] = v0[3] * c[1] + v0[2] * s[1];
    b[0] = v1[0] * c[2] - v1[1] * s[2]; b[1] = v1[1] * c[2] + v1[0] * s[2];
    b[2] = v1[2] * c[3] - v1[3] * s[3]; b[3] = v1[3] * c[3] + v1[2] * s[3];
    v0 = a; v1 = b;
}
__device__ __forceinline__ void store_t8(bf16_t* p, size_t stride, f32x4 v0, f32x4 v1) {
    const u32x4 w = pack8(v0, v1);
    p[0] = (bf16_t)(w.x & 0xffffu); p[stride] = (bf16_t)(w.x >> 16); p[2 * stride] = (bf16_t)(w.y & 0xffffu); p[3 * stride] = (bf16_t)(w.y >> 16);
    p[4 * stride] = (bf16_t)(w.z & 0xffffu); p[5 * stride] = (bf16_t)(w.z >> 16); p[6 * stride] = (bf16_t)(w.w & 0xffffu); p[7 * stride] = (bf16_t)(w.w >> 16);
}

struct EpiProj {
    static constexpr bool PERM = true, AFTER_DRAIN = false;
    const float* ssq; const float* ropeC; const float* ropeS;
    bf16_t *NQ, *KC, *VC, *KSL, *VSLT, *KWN, *VWNT, *SQ, *SK, *SVT, *GA, *GB; float* NG;
    __device__ __forceinline__ void operator()(const f32x4 (&acc)[2][2][4][2], const Unit& u, int wr, int wc, int fr, int fq) const {
        asm volatile("" : "+v"(fr), "+v"(fq));
        const int pn = u.pn;
        const int row0 = u.pm * BM + wr * 64 + fr;
        const int cw0 = wc * 32 + 8 * fq;
        float rsv[2][4]; wave_rstd8<false>(ssq, u.pm * BM + wr * 64, rsv);
        const bool need_rope = pn < 2 || (pn >= 3 && pn <= 6) || pn == 15;
        f32x4 ncs = {0.f, 0.f, 0.f, 0.f}, nsn = {0.f, 0.f, 0.f, 0.f};
        if (need_rope) { ncs = *(const f32x4*)(ropeC + (size_t)row0 * 32 + ((cw0 & 63) >> 1)); nsn = *(const f32x4*)(ropeS + (size_t)row0 * 32 + ((cw0 & 63) >> 1)); }
#pragma unroll
        for (int ai = 0; ai < 2; ++ai)
#pragma unroll
            for (int m = 0; m < 4; ++m) {
                const int row = row0 + ai * HALF + m * 16; const float rs = rsv[ai][m];
                const int b = row >> 13, s = row & 8191;
                const f32x4 cs = ncs, sn = nsn;
                if (need_rope && (ai * 4 + m) < 7) { const int rown = row0 + ((ai * 4 + m + 1) >> 2) * HALF + ((ai * 4 + m + 1) & 3) * 16;
                    ncs = *(const f32x4*)(ropeC + (size_t)rown * 32 + ((cw0 & 63) >> 1)); nsn = *(const f32x4*)(ropeS + (size_t)rown * 32 + ((cw0 & 63) >> 1)); }
#pragma unroll
                for (int bj = 0; bj < 2; ++bj) {
                    f32x4 v0 = acc[ai][bj][m][0] * rs, v1 = acc[ai][bj][m][1] * rs;
                    const int cw = bj * HALF + cw0;
                    if (pn < 2) { rope8(v0, v1, cs, sn); *(u32x4*)(NQ + (size_t)row * 512 + pn * 256 + cw) = pack8(v0, v1); }
                    else if (pn == 2) { bf16_t* dst = bj == 0 ? KC : VC; const int g = cw0 >> 6, d = cw0 & 63;
                        *(u32x4*)(dst + ((size_t)(b * 2 + g) * SEQ + s) * 64 + d) = pack8(v0, v1); }
                    else if (pn <= 4) { const int g = cw0 >> 6, d = cw0 & 63;
                        if (bj == 0) { rope8(v0, v1, cs, sn); bf16_t* dst = pn == 3 ? KSL : KWN; *(u32x4*)(dst + ((size_t)(b * 2 + g) * SEQ + s) * 64 + d) = pack8(v0, v1); }
                        else { bf16_t* dst = pn == 3 ? VSLT : VWNT; store_t8(dst + ((size_t)(b * 2 + g) * 64 + d) * SEQ + s, SEQ, v0, v1); } }
                    else if (pn <= 6) { rope8(v0, v1, cs, sn);
                        const u32x4 w = pack8(v0, v1); unsigned long long* qp = (unsigned long long*)(SQ + (size_t)row * 512 + (pn - 5) * 256 + cw);
                        __hip_atomic_store(qp, (unsigned long long)w.x | ((unsigned long long)w.y << 32), __ATOMIC_RELAXED, __HIP_MEMORY_SCOPE_AGENT);
                        __hip_atomic_store(qp + 1, (unsigned long long)w.z | ((unsigned long long)w.w << 32), __ATOMIC_RELAXED, __HIP_MEMORY_SCOPE_AGENT); }
                    else if (pn <= 14) { bf16_t* dst = pn <= 10 ? GA : GB; const int c = ((pn - 7) & 3) * 256 + cw;
#pragma unroll
                        for (int j = 0; j < 4; ++j) { v0[j] = sigmoidf_(v0[j]); v1[j] = sigmoidf_(v1[j]); }
                        *(u32x4*)(dst + (size_t)row * 1024 + c) = pack8(v0, v1); }
                    else {
                        if (bj == 0) {
                            if (cw0 < 64) { rope8(v0, v1, cs, sn); *(u32x4*)(SK + (size_t)row * 64 + cw0) = pack8(v0, v1); }
                            else store_t8(SVT + ((size_t)b * 64 + (cw0 - 64)) * SEQ + s, SEQ, v0, v1);
                        } else if (cw0 < 24) {
#pragma unroll
                            for (int j = 0; j < 4; ++j) { v0[j] = sigmoidf_(v0[j]); v1[j] = sigmoidf_(v1[j]); }
                            *(f32x4*)(NG + (size_t)row * 24 + cw0) = v0; *(f32x4*)(NG + (size_t)row * 24 + cw0 + 4) = v1;
                        }
                    }
                    asm volatile("" ::: "memory");
                }
            }
    }
};

struct EpiDry {
    static constexpr bool PERM = true, AFTER_DRAIN = false;
    float* sink; int flag;
    __device__ __forceinline__ void operator()(const f32x4 (&acc)[2][2][4][2], const Unit& u, int wr, int wc, int fr, int fq) const {
        if (flag) { f32x4 s = {0.f, 0.f, 0.f, 0.f};
#pragma unroll
            for (int ai = 0; ai < 2; ++ai)
#pragma unroll
                for (int bj = 0; bj < 2; ++bj)
#pragma unroll
                    for (int m = 0; m < 4; ++m) s += acc[ai][bj][m][0] + acc[ai][bj][m][1];
            *(f32x4*)(sink + (size_t)(u.pm * 4 + u.pn) * 4) = s; }
    }
};

struct EpiFinal {
    static constexpr bool PERM = true, AFTER_DRAIN = false;
    const float* base; float* out; float* ssq; const float* gain; unsigned* cnt; float scale;
    __device__ __forceinline__ void operator()(f32x4 (&acc)[2][2][4][2], const Unit& u, int wr, int wc, int fr, int fq) const {
        asm volatile("" : "+v"(fr), "+v"(fq));
        const int row0 = u.pm * BM + wr * 64 + fr, col0 = u.pn * BM + wc * 32 + 8 * fq;
        f32x4 nb[2][2];
#pragma unroll
        for (int bj = 0; bj < 2; ++bj) { const size_t off = (size_t)row0 * 1024 + col0 + bj * HALF; nb[bj][0] = *(const f32x4*)(base + off); nb[bj][1] = *(const f32x4*)(base + off + 4); }
#pragma unroll
        for (int it = 0; it < 8; ++it) {
            const int ai = it >> 2, m = it & 3;
            const int row = row0 + ai * HALF + m * 16; float s = 0.f;
            f32x4 cb[2][2];
#pragma unroll
            for (int bj = 0; bj < 2; ++bj) { cb[bj][0] = nb[bj][0]; cb[bj][1] = nb[bj][1]; }
            if (it < 7) { const int rown = row0 + ((it + 1) >> 2) * HALF + ((it + 1) & 3) * 16;
#pragma unroll
                for (int bj = 0; bj < 2; ++bj) { const size_t off = (size_t)rown * 1024 + col0 + bj * HALF; nb[bj][0] = *(const f32x4*)(base + off); nb[bj][1] = *(const f32x4*)(base + off + 4); } }
#pragma unroll
            for (int bj = 0; bj < 2; ++bj) {
                const f32x4 h0 = cb[bj][0] + acc[ai][bj][m][0] * scale, h1 = cb[bj][1] + acc[ai][bj][m][1] * scale;
                acc[ai][bj][m][0] = h0; acc[ai][bj][m][1] = h1;
                s += (h0[0] * h0[0] + h0[1] * h0[1]) + (h0[2] * h0[2] + h0[3] * h0[3]) + (h1[0] * h1[0] + h1[1] * h1[1]) + (h1[2] * h1[2] + h1[3] * h1[3]);
            }
            s += __shfl_xor(s, 16); s += __shfl_xor(s, 32);
            if (fq == 0) __hip_atomic_store(ssq + (size_t)row * 16 + u.pn * 4 + wc, s, __ATOMIC_RELAXED, __HIP_MEMORY_SCOPE_AGENT);
            asm volatile("" ::: "memory");
        }
        f32x4 gv[2][2];
#pragma unroll
        for (int bj = 0; bj < 2; ++bj) { gv[bj][0] = *(const f32x4*)(gain + col0 + bj * HALF); gv[bj][1] = *(const f32x4*)(gain + col0 + bj * HALF + 4); }
        asm volatile("s_waitcnt vmcnt(0)" ::: "memory");
        __syncthreads();
        if (threadIdx.x == 0) {
            __hip_atomic_fetch_add(cnt + u.pm, 1u, __ATOMIC_RELAXED, __HIP_MEMORY_SCOPE_AGENT);
            while (__hip_atomic_load(cnt + u.pm, __ATOMIC_RELAXED, __HIP_MEMORY_SCOPE_AGENT) < 4u) __builtin_amdgcn_s_sleep(1);
        }
        __syncthreads();
        float rsv[2][4]; wave_rstd8<true>(ssq, u.pm * BM + wr * 64, rsv);
#pragma unroll
        for (int ai = 0; ai < 2; ++ai)
#pragma unroll
            for (int m = 0; m < 4; ++m) {
                const int row = row0 + ai * HALF + m * 16; const float rs = rsv[ai][m];
#pragma unroll
                for (int bj = 0; bj < 2; ++bj) {
                    const size_t off = (size_t)row * 1024 + col0 + bj * HALF;
                    *(f32x4*)(out + off) = acc[ai][bj][m][0] * rs * gv[bj][0]; *(f32x4*)(out + off + 4) = acc[ai][bj][m][1] * rs * gv[bj][1];
                }
            }
    }
};
template <class Epi, class Sched, bool ALIGN_EPI = false, bool SP2 = false>
__device__ __forceinline__ void gemm_phase(PG8_LAS unsigned char* lds, const Gemm g, const Sched& S, const Epi& E) {
    const int tid = threadIdx.x, wid = __builtin_amdgcn_readfirstlane(tid >> 6), lane = tid & 63, wr = wid >> 2, wc = wid & 3, fr = lane & 15, fq = lane >> 4;
    const int K = g.K, nt = K / BK;
    unsigned voffA[2], voffB[2];
#pragma unroll
    for (int i = 0; i < 2; ++i) { int R, C; stage_rc(tid * 16 + i * 8192, R, C); const int Rb = Epi::PERM ? ((R & ~31) + perm32(R & 31)) : R;
        voffA[i] = (unsigned)(R * K + C) * 2u; voffB[i] = (unsigned)(Rb * K + C) * 2u; }
    const size_t kstep = (size_t)(BK * 2);
    const size_t hstep = (size_t)HALF * K * 2;
    const size_t tstep = 2 * hstep;
    const unsigned ldsw = (unsigned)wid * 1024u;
    const int aoff = lds_byte(wr * 64 + fr, fq * 8), boff = lds_byte(wc * 32 + fr, fq * 8);
#define PG8_SA(b, h) (((b) * 2 + (h)) * HTB)
#define PG8_SB(b, h) ((4 + (b) * 2 + (h)) * HTB)
#define PG8_STAGE(bufoff, gbase, voff) do { _Pragma("unroll") for (int _i = 0; _i < 2; ++_i) \
        __builtin_amdgcn_global_load_lds((const unsigned*)((const char*)(gbase) + (voff)[_i]), (PG8_LAS unsigned*)(lds + (bufoff) + ldsw + _i * 8192), 16, 0, 0); } while (0)
#define PG8_LDA(dst, b, h) do { _Pragma("unroll") for (int m = 0; m < 4; ++m) _Pragma("unroll") for (int k = 0; k < 2; ++k) dst[m][k] = *(const PG8_LAS bf16x8*)(lds + PG8_SA(b, h) + aoff + m * 2048 + k * 1024); } while (0)
#define PG8_LDB(dst, b, h) do { _Pragma("unroll") for (int n = 0; n < 2; ++n) _Pragma("unroll") for (int k = 0; k < 2; ++k) dst[n][k] = *(const PG8_LAS bf16x8*)(lds + PG8_SB(b, h) + boff + n * 2048 + k * 1024); } while (0)
#define PG8_MMA(ai, bj, At, Bt) do { __builtin_amdgcn_s_setprio(1); _Pragma("unroll") for (int m = 0; m < 4; ++m) _Pragma("unroll") for (int n = 0; n < 2; ++n) _Pragma("unroll") for (int k = 0; k < 2; ++k) \
        acc[ai][bj][m][n] = __builtin_amdgcn_mfma_f32_16x16x32_bf16(Bt[n][k], At[m][k], acc[ai][bj][m][n], 0, 0, 0); __builtin_amdgcn_s_setprio(0); } while (0)
#define PG8_WAIT_V(n) asm volatile("s_waitcnt vmcnt(" #n ")" ::: "memory")
#define PG8_WAIT_L(n) asm volatile("s_waitcnt lgkmcnt(" #n ")" ::: "memory")
#define PG8_BAR __builtin_amdgcn_s_barrier()
#define PG8_SCHED __builtin_amdgcn_sched_barrier(0)
    Unit cur, nxt; int ui = 0;
    if (!S.next(0, cur)) return;
    f32x4 acc[2][2][4][2];
#pragma unroll
    for (int a = 0; a < 2; ++a)
#pragma unroll
        for (int b = 0; b < 2; ++b)
#pragma unroll
            for (int m = 0; m < 4; ++m)
#pragma unroll
                for (int n = 0; n < 2; ++n) acc[a][b][m][n] = (f32x4){0.f, 0.f, 0.f, 0.f};
    bf16x8 At[4][2], B0[2][2], B1[2][2];
    const char* cA = (const char*)g.A + (size_t)cur.pm * tstep; const char* cB = (const char*)g.Bt + (size_t)cur.pn * tstep;
    S.a_ready(cur);
    if constexpr (SP2) {
        PG8_STAGE(PG8_SB(0, 0), cB, voffB); PG8_STAGE(PG8_SB(0, 1), cB + hstep, voffB); PG8_STAGE(PG8_SA(0, 0), cA, voffA); PG8_STAGE(PG8_SA(0, 1), cA + hstep, voffA);
        if (wr == 1) PG8_BAR;
        PG8_WAIT_V(2); PG8_BAR;
        PG8_STAGE(PG8_SB(1, 0), cB + kstep, voffB); PG8_STAGE(PG8_SA(1, 0), cA + kstep, voffA); PG8_STAGE(PG8_SB(1, 1), cB + hstep + kstep, voffB);
        PG8_WAIT_V(6); PG8_BAR;
    } else {
        PG8_STAGE(PG8_SB(0, 0), cB, voffB); PG8_STAGE(PG8_SA(0, 0), cA, voffA); PG8_STAGE(PG8_SB(0, 1), cB + hstep, voffB); PG8_STAGE(PG8_SA(0, 1), cA + hstep, voffA);
        if (wr == 1) PG8_BAR;
        PG8_WAIT_V(4); PG8_BAR;
        PG8_STAGE(PG8_SB(1, 0), cB + kstep, voffB); PG8_STAGE(PG8_SA(1, 0), cA + kstep, voffA); PG8_STAGE(PG8_SB(1, 1), cB + hstep + kstep, voffB);
        PG8_WAIT_V(6); PG8_BAR;
    }
    for (;;) {
        const bool has_next = S.next(ui + 1, nxt);
        const char* nA = has_next ? (const char*)g.A + (size_t)nxt.pm * tstep : cA; const char* nB = has_next ? (const char*)g.Bt + (size_t)nxt.pn * tstep : cB;
        for (int t = 0; t < nt; t += 2) {
            const bool last = (t == nt - 2);
            const char* a1 = cA + (size_t)(t + 1) * kstep;
            const char* a2 = last ? nA : cA + (size_t)(t + 2) * kstep; const char* b2 = last ? nB : cB + (size_t)(t + 2) * kstep;
            const char* a3 = a2 + kstep; const char* b3 = b2 + kstep;
            if (last && has_next) S.a_ready(nxt);
            if constexpr (SP2) {
            PG8_LDB(B0, 0, 0); PG8_LDB(B1, 0, 1); PG8_SCHED; PG8_LDA(At, 0, 0); PG8_STAGE(PG8_SA(1, 1), a1 + hstep, voffA);
            PG8_WAIT_V(8); PG8_WAIT_L(0); PG8_BAR; PG8_MMA(0, 0, At, B0); PG8_MMA(0, 1, At, B1); PG8_BAR; PG8_SCHED;
            PG8_LDA(At, 0, 1); PG8_STAGE(PG8_SB(0, 0), b2, voffB); PG8_STAGE(PG8_SB(0, 1), b2 + hstep, voffB); PG8_STAGE(PG8_SA(0, 0), a2, voffA);
            PG8_WAIT_V(8); PG8_WAIT_L(0); PG8_BAR; PG8_MMA(1, 0, At, B0); PG8_MMA(1, 1, At, B1); PG8_BAR; PG8_SCHED;
            PG8_LDB(B0, 1, 0); PG8_LDB(B1, 1, 1); PG8_SCHED; PG8_LDA(At, 1, 0); PG8_STAGE(PG8_SA(0, 1), a2 + hstep, voffA);
            PG8_WAIT_V(8); PG8_WAIT_L(0); PG8_BAR; PG8_MMA(0, 0, At, B0); PG8_MMA(0, 1, At, B1); PG8_BAR; PG8_SCHED;
            PG8_LDA(At, 1, 1); PG8_STAGE(PG8_SB(1, 0), b3, voffB); PG8_STAGE(PG8_SB(1, 1), b3 + hstep, voffB); PG8_STAGE(PG8_SA(1, 0), a3, voffA);
            PG8_WAIT_V(8); PG8_WAIT_L(0); PG8_BAR; PG8_MMA(1, 0, At, B0); PG8_MMA(1, 1, At, B1); PG8_BAR; PG8_SCHED;
            } else {
            PG8_LDB(B0, 0, 0); PG8_SCHED; PG8_LDA(At, 0, 0); PG8_STAGE(PG8_SA(1, 1), a1 + hstep, voffA);
            PG8_WAIT_L(8); PG8_BAR; PG8_WAIT_L(0); PG8_MMA(0, 0, At, B0); PG8_BAR; PG8_SCHED;
            PG8_LDB(B1, 0, 1); PG8_STAGE(PG8_SB(0, 0), b2, voffB);
            PG8_BAR; PG8_WAIT_L(0); PG8_MMA(0, 1, At, B1); PG8_BAR;
            PG8_LDA(At, 0, 1); PG8_STAGE(PG8_SA(0, 0), a2, voffA);
            PG8_BAR; PG8_WAIT_L(0); PG8_MMA(1, 0, At, B0); PG8_BAR; PG8_SCHED;
            PG8_STAGE(PG8_SB(0, 1), b2 + hstep, voffB);
            PG8_WAIT_V(6); PG8_BAR; PG8_MMA(1, 1, At, B1); PG8_BAR;
            PG8_LDB(B0, 1, 0); PG8_SCHED; PG8_LDA(At, 1, 0); PG8_STAGE(PG8_SA(0, 1), a2 + hstep, voffA);
            PG8_WAIT_L(8); PG8_BAR; PG8_WAIT_L(0); PG8_MMA(0, 0, At, B0); PG8_BAR; PG8_SCHED;
            PG8_LDB(B1, 1, 1); PG8_STAGE(PG8_SB(1, 0), b3, voffB);
            PG8_BAR; PG8_WAIT_L(0); PG8_MMA(0, 1, At, B1); PG8_BAR;
            PG8_LDA(At, 1, 1); PG8_STAGE(PG8_SA(1, 0), a3, voffA);
            PG8_BAR; PG8_WAIT_L(0); PG8_MMA(1, 0, At, B0); PG8_BAR; PG8_SCHED;
            PG8_STAGE(PG8_SB(1, 1), b3 + hstep, voffB);
            PG8_WAIT_V(6); PG8_BAR; PG8_MMA(1, 1, At, B1); PG8_BAR;
            }
        }
        if constexpr (ALIGN_EPI) { if (wr == 0) PG8_BAR; }
        if constexpr (!Epi::AFTER_DRAIN) { E(acc, cur, wr, wc, fr, fq); S.done(cur); }
        if (!has_next) break;
#pragma unroll
        for (int a = 0; a < 2; ++a)
#pragma unroll
            for (int b = 0; b < 2; ++b)
#pragma unroll
                for (int m = 0; m < 4; ++m)
#pragma unroll
                    for (int n = 0; n < 2; ++n) acc[a][b][m][n] = (f32x4){0.f, 0.f, 0.f, 0.f};
        cur = nxt; cA = nA; cB = nB; ++ui;
        if constexpr (ALIGN_EPI) { if (wr == 1) PG8_BAR; }
    }
    PG8_WAIT_V(0);
    if constexpr (!ALIGN_EPI) { if (wr == 0) PG8_BAR; }
    PG8_BAR;
    if constexpr (Epi::AFTER_DRAIN) { E.fused(acc, cur, wr, wc, fr, fq, lds, wid, lane); S.done(cur); }
#undef PG8_SA
#undef PG8_SB
#undef PG8_STAGE
#undef PG8_LDA
#undef PG8_LDB
#undef PG8_MMA
#undef PG8_WAIT_V
#undef PG8_WAIT_L
#undef PG8_BAR
#undef PG8_SCHED
}
}

using pg8::bf16_t; using pg8::bf16x8; using pg8::f32x4; using pg8::u32x4; using pg8::cvt_pk_bf16; using pg8::fast_exp2; using pg8::fast_rcp; using pg8::bf2f;
#define LAS __attribute__((address_space(3)))
constexpr int NWAVES = 8;
constexpr int LDS_BYTES = 131072 + 4096 + 1024;
constexpr size_t MiB = 1u << 20;
constexpr size_t WS_SEL = 0, WS_KCMP = 512 * 1024, WS_VCMPT = 768 * 1024;
constexpr size_t WS_W1GU = 1 * MiB, WS_W1D = 12 * MiB, WS_WIN = 18 * MiB, WS_CW1K = 26 * MiB, WS_CW1V = 27 * MiB, WS_CW2K = 28 * MiB, WS_CW2V = 28 * MiB + 65536;
constexpr size_t WS_WA = 29 * MiB, WS_WB = 30 * MiB, WS_WOUT = 31 * MiB, WS_W2GU = 33 * MiB, WS_W2D = 44 * MiB, WS_PEB = 49 * MiB + 512 * 1024;
constexpr size_t WS_BAR = 49 * MiB + 576 * 1024, BAR_BYTES = 16384;
constexpr size_t WS_ROPEC = 50 * MiB, WS_ROPES = 52 * MiB;
constexpr size_t WS_XB = 54 * MiB;
constexpr size_t WS_ACT = 86 * MiB;
constexpr size_t WS_GA = 86 * MiB, WS_GB = 118 * MiB;
constexpr size_t WS_SQ = 174 * MiB, WS_OCMP = 190 * MiB, WS_KC = 206 * MiB, WS_VC = 210 * MiB, WS_KSL = 214 * MiB, WS_VSLT = 218 * MiB, WS_KWN = 222 * MiB, WS_VWNT = 226 * MiB;
constexpr size_t WS_SK = 230 * MiB, WS_SVT = 232 * MiB;
constexpr size_t WS_SSQ0 = 234 * MiB, WS_SSQ1 = 235 * MiB, WS_SSQ2 = 236 * MiB, WS_SSQ3 = 237 * MiB;
constexpr size_t WS_NQ = 238 * MiB, WS_NG = 254 * MiB, WS_END = 255 * MiB + 512 * 1024;

__device__ const float INV_FREQ[32] = {1.f, 0.749894202f, 0.562341332f, 0.421696514f, 0.316227764f, 0.237137377f, 0.177827939f, 0.133352146f, 0.100000001f, 0.0749894232f, 0.0562341325f, 0.0421696492f, 0.0316227749f, 0.0237137377f, 0.0177827943f, 0.013335214f, 0.00999999978f, 0.00749894232f, 0.00562341325f, 0.00421696482f, 0.00316227763f, 0.00237137382f, 0.00177827943f, 0.00133352145f, 0.00100000005f, 0.000749894185f, 0.000562341302f, 0.000421696517f, 0.000316227757f, 0.00023713737f, 0.00017782794f, 0.00013335215f};

struct Args { const float* in[23]; float* out; unsigned char* ws; int rep[4]; };

#define LDS_WAIT() asm volatile("s_waitcnt lgkmcnt(0)" ::: "memory")
#define MFMA16(a, b, c) __builtin_amdgcn_mfma_f32_16x16x32_bf16(a, b, c, 0, 0, 0)

__device__ __forceinline__ float wave_sum(float v) {
#pragma unroll
    for (int o = 1; o < 64; o <<= 1) v += __shfl_xor(v, o);
    return v;
}
__device__ __forceinline__ unsigned f2bf(float f) { unsigned u = __builtin_bit_cast(unsigned, f); return (u + 0x7fffu + ((u >> 16) & 1u)) >> 16; }
__device__ __forceinline__ unsigned pk2(float lo, float hi) { return f2bf(lo) | (f2bf(hi) << 16); }

__device__ __forceinline__ int il_pos(int d) { return d < 32 ? 2 * d : 2 * (d - 32) + 1; }
__device__ __forceinline__ int win_dest(int c) {
    if (c < 512) return (c & ~63) + il_pos(c & 63);
    if (c < 768) return c;
    if (c < 896) return (c & ~63) + il_pos(c & 63);
    if (c < 1024) return c;
    if (c < 1152) return (c & ~63) + il_pos(c & 63);
    if (c < 1280) return c;
    if (c < 1304) return 3968 + (c - 1280);
    if (c < 1816) { const int q = c - 1304; return 1280 + (q & ~63) + il_pos(q & 63); }
    if (c < 1880) return 3840 + il_pos(c - 1816);
    if (c < 1944) return 3904 + (c - 1880);
    if (c < 2968) return 1792 + (c - 1944);
    return 2816 + (c - 2968);
}
__device__ __forceinline__ int dest_row(int mode, int row_off, int n) {
    if (mode == 0) return row_off + n;
    if (mode == 1) return (n >> 7) * 256 + (n & 127) + row_off;
    if (mode == 2) return win_dest(n);
    return il_pos(n);
}
__device__ __forceinline__ void transpose_item(const float* __restrict__ W, int K, int N, bf16_t* WT, int mode, int row_off, const float* __restrict__ gain, LAS float* scr, int item, int lane) {
    const int nblk = (N + 31) / 32, kb = item / nblk, nb = item % nblk, k0 = 64 * kb, n0 = 32 * nb;
    const int c4 = (lane & 7) * 4, nn = n0 + c4;
#pragma unroll
    for (int i = 0; i < 8; ++i) { const int kk = 8 * i + (lane >> 3);
        f32x4 v = nn < N ? *(const f32x4*)(W + (size_t)(k0 + kk) * N + nn) : (f32x4){0.f, 0.f, 0.f, 0.f};
        if (gain) v = v * gain[k0 + kk];
        scr[kk * 33 + c4] = v[0]; scr[kk * 33 + c4 + 1] = v[1]; scr[kk * 33 + c4 + 2] = v[2]; scr[kk * 33 + c4 + 3] = v[3]; }
    LDS_WAIT();
    const int c = lane & 7;
#pragma unroll
    for (int j = 0; j < 4; ++j) { const int nl = (lane >> 3) + 8 * j; const int n = n0 + nl;
        if (n < N) { const LAS float* s = scr + (8 * c) * 33 + nl;
            u32x4 o; o.x = pk2(s[0 * 33], s[1 * 33]); o.y = pk2(s[2 * 33], s[3 * 33]); o.z = pk2(s[4 * 33], s[5 * 33]); o.w = pk2(s[6 * 33], s[7 * 33]);
            *(u32x4*)(WT + (size_t)dest_row(mode, row_off, n) * K + k0 + 8 * c) = o; } }
    LDS_WAIT();
}

__device__ __forceinline__ void qk_pair(const bf16_t* __restrict__ K, int kbase, int lane, const bf16x8 (&qf)[2], f32x4& sA, f32x4& sB) {
    const int i = lane & 15, fq = lane >> 4;
    const bf16_t* pa = K + (size_t)(kbase + 8 * (i >> 2) + (i & 3)) * 64 + 8 * fq;
    const bf16x8 a0 = *(const bf16x8*)pa, a1 = *(const bf16x8*)(pa + 32), b0 = *(const bf16x8*)(pa + 256), b1 = *(const bf16x8*)(pa + 288);
    const f32x4 z = {0.f, 0.f, 0.f, 0.f};
    sA = MFMA16(a0, qf[0], z); sA = MFMA16(a1, qf[1], sA);
    sB = MFMA16(b0, qf[0], z); sB = MFMA16(b1, qf[1], sB);
}
__device__ __forceinline__ void pv_pair(const bf16_t* __restrict__ VT, int ldv, int kbase, int lane, bf16x8 pf, f32x4 (&o)[4]) {
    const int i = lane & 15, fq = lane >> 4;
#pragma unroll
    for (int nt = 0; nt < 4; ++nt) { const bf16x8 a = *(const bf16x8*)(VT + (size_t)(16 * nt + i) * ldv + kbase + 8 * fq); o[nt] = MFMA16(a, pf, o[nt]); }
}
__device__ __forceinline__ float rowmax4(float v) {
    const unsigned u = __float_as_uint(v); const auto r = __builtin_amdgcn_permlane16_swap(u, u, false, false);
    const float a = fmaxf(__uint_as_float(r[0]), __uint_as_float(r[1]));
    const unsigned ua = __float_as_uint(a); const auto r2 = __builtin_amdgcn_permlane32_swap(ua, ua, false, false);
    return fmaxf(__uint_as_float(r2[0]), __uint_as_float(r2[1])); }
__device__ __forceinline__ float rowsum4(float v) {
    const unsigned u = __float_as_uint(v); const auto r = __builtin_amdgcn_permlane16_swap(u, u, false, false);
    const float a = __uint_as_float(r[0]) + __uint_as_float(r[1]);
    const unsigned ua = __float_as_uint(a); const auto r2 = __builtin_amdgcn_permlane32_swap(ua, ua, false, false);
    return __uint_as_float(r2[0]) + __uint_as_float(r2[1]); }
constexpr float NEGBIG = -1e30f;
#define SCORES8(sA, sB, key0, lo, hi, s, v) \
    float s[8]; bool v[8]; \
    _Pragma("unroll") for (int e = 0; e < 8; ++e) { const int key_ = (key0) + e; v[e] = (key_ >= (lo)) && (key_ <= (hi)); const float x_ = (e < 4 ? sA[e & 3] : sB[e & 3]) * C2; s[e] = v[e] ? x_ : NEGBIG; }

__device__ __forceinline__ bf16x8 soft_step(f32x4 sA, f32x4 sB, int key0, int lo, int hi, float& m, float& l, f32x4 (&o)[4]) {
    SCORES8(sA, sB, key0, lo, hi, s, v)
    float mx = fmaxf(fmaxf(fmaxf(s[0], s[1]), fmaxf(s[2], s[3])), fmaxf(fmaxf(s[4], s[5]), fmaxf(s[6], s[7])));
    mx = rowmax4(mx);
    const float mn = fmaxf(m, mx), alpha = fast_exp2(m - mn);
    float p[8], sum = 0.f;
#pragma unroll
    for (int e = 0; e < 8; ++e) { p[e] = v[e] ? fast_exp2(s[e] - mn) : 0.f; sum += p[e]; }
    sum = rowsum4(sum);
    l = l * alpha + sum; m = mn;
#pragma unroll
    for (int nt = 0; nt < 4; ++nt) o[nt] = o[nt] * alpha;
    u32x4 w; w.x = cvt_pk_bf16(p[0], p[1]); w.y = cvt_pk_bf16(p[2], p[3]); w.z = cvt_pk_bf16(p[4], p[5]); w.w = cvt_pk_bf16(p[6], p[7]);
    return __builtin_bit_cast(bf16x8, w);
}

#define RLX_AGENT __ATOMIC_RELAXED, __HIP_MEMORY_SCOPE_AGENT
#define XB_TMO      128
#define XB_XCNT(j)  (256  + 64 * (j))
#define XB_XSUB(j)  (1280 + 64 * (j))
#define XB_XGEN(j)  (2304 + 64 * (j))
#define XB_TOP      3328
#define XB_TOPGEN   3392
#define XCD_BAR_WORDS 3456
#define XB_SPIN_CAP (1u << 18)

__device__ __forceinline__ unsigned xb_ld(unsigned* p)              { return __hip_atomic_load(p, __ATOMIC_RELAXED, __HIP_MEMORY_SCOPE_AGENT); }
__device__ __forceinline__ unsigned xb_add(unsigned* p, unsigned v) { return __hip_atomic_fetch_add(p, v, __ATOMIC_RELAXED, __HIP_MEMORY_SCOPE_AGENT); }
__device__ __forceinline__ unsigned xb_xcc_id() { return (unsigned)__builtin_amdgcn_s_getreg((3 << 11) | 20) & 0xFu; }
#define XB_SPIN(cond, bar) do { unsigned _sp = 0; while (cond) { __builtin_amdgcn_s_sleep(1); \
    if ((++_sp & 255u) == 0u) { if (xb_ld(&(bar)[XB_TMO])) break; if (_sp > XB_SPIN_CAP) { atomicAdd(&(bar)[XB_TMO], 1u); break; } } } } while (0)

struct XcdBarrier {
    unsigned* bar; unsigned x;
    volatile LAS unsigned* st;
};

__device__ __forceinline__ XcdBarrier xcd_barrier_post(unsigned* bar, volatile LAS unsigned* st) {
    XcdBarrier b; b.bar = bar; b.x = xb_xcc_id(); b.st = st;
    if (threadIdx.x == 0) (void)xb_add(&bar[XB_XCNT(b.x)], 1u);
    return b;
}
__device__ __forceinline__ void xcd_barrier_complete(unsigned* bar, unsigned x, unsigned& nloc, unsigned& nx) {
    const unsigned G = gridDim.x * gridDim.y * gridDim.z;
    unsigned sum, cnt, mine, sp = 0u;
    for (;;) {
        sum = 0u; cnt = 0u; mine = 0u;
#pragma unroll
        for (unsigned j = 0; j < 16; ++j) { const unsigned c = xb_ld(&bar[XB_XCNT(j)]); sum += c; cnt += (c > 0u) ? 1u : 0u; mine = (j == x) ? c : mine; }
        if (sum == G) break;
        __builtin_amdgcn_s_sleep(1);
        if ((++sp & 255u) == 0u) { if (xb_ld(&bar[XB_TMO])) break; if (sp > XB_SPIN_CAP) { atomicAdd(&bar[XB_TMO], 1u); break; } }
    }
    nloc = mine > 0u ? mine : 1u; nx = cnt > 0u ? cnt : 1u;
}

__device__ __forceinline__ void xcd_barrier(const XcdBarrier& b) {
    asm volatile("s_waitcnt vmcnt(0)" ::: "memory");
    __syncthreads();
    if (threadIdx.x == 0) {
        unsigned* bar = b.bar;
        __builtin_amdgcn_s_waitcnt(0);
        unsigned nloc = b.st[0], nx = b.st[1];
        if (nloc == 0u) { xcd_barrier_complete(bar, b.x, nloc, nx); b.st[0] = nloc; b.st[1] = nx; }
        const unsigned old = xb_add(&bar[XB_XSUB(b.x)], 1u);
        const unsigned gen = old / nloc;
        if (old + 1u == (gen + 1u) * nloc) {
            __builtin_amdgcn_fence(__ATOMIC_RELEASE, "agent");
            asm volatile("s_waitcnt vmcnt(0)" ::: "memory");
            const unsigned og = xb_add(&bar[XB_TOP], 1u);
            const unsigned tg = og / nx;
            if (og + 1u == (tg + 1u) * nx) xb_add(&bar[XB_TOPGEN], 1u);
            else XB_SPIN(xb_ld(&bar[XB_TOPGEN]) == tg, bar);
            __builtin_amdgcn_fence(__ATOMIC_ACQUIRE, "agent");
            xb_add(&bar[XB_XGEN(b.x)], 1u);
            asm volatile("s_waitcnt vmcnt(0)" ::: "memory");
        } else {
            XB_SPIN(xb_ld(&bar[XB_XGEN(b.x)]) == gen, bar);
            __builtin_amdgcn_fence(__ATOMIC_ACQUIRE, "agent");
            asm volatile("s_waitcnt vmcnt(0)" ::: "memory");
        }
    }
    __syncthreads();
}

struct Frag { bf16x8 k0, k1, k2, k3, v0, v1, v2, v3; };
template <bool WITH_V> __device__ __forceinline__ void load_frag(Frag& f, const bf16_t* __restrict__ K, const bf16_t* __restrict__ VT, int ldv, int kbase, int lane) {
    const int i = lane & 15, fq = lane >> 4;
    const bf16_t* pa = K + (size_t)(kbase + 8 * (i >> 2) + (i & 3)) * 64 + 8 * fq;
    f.k0 = *(const bf16x8*)pa; f.k1 = *(const bf16x8*)(pa + 32); f.k2 = *(const bf16x8*)(pa + 256); f.k3 = *(const bf16x8*)(pa + 288);
    if (WITH_V) { const bf16_t* pv = VT + (size_t)i * ldv + kbase + 8 * fq;
        f.v0 = *(const bf16x8*)pv; f.v1 = *(const bf16x8*)(pv + (size_t)16 * ldv); f.v2 = *(const bf16x8*)(pv + (size_t)32 * ldv); f.v3 = *(const bf16x8*)(pv + (size_t)48 * ldv); }
}
__device__ __forceinline__ void qk_frag(const Frag& f, const bf16x8 (&qf)[2], f32x4& sA, f32x4& sB) {
    const f32x4 z = {0.f, 0.f, 0.f, 0.f};
    sA = MFMA16(f.k0, qf[0], z); sA = MFMA16(f.k1, qf[1], sA);
    sB = MFMA16(f.k2, qf[0], z); sB = MFMA16(f.k3, qf[1], sB);
}
__device__ __forceinline__ void pv_frag(const Frag& f, bf16x8 pf, f32x4 (&o)[4]) {
    o[0] = MFMA16(f.v0, pf, o[0]); o[1] = MFMA16(f.v1, pf, o[1]); o[2] = MFMA16(f.v2, pf, o[2]); o[3] = MFMA16(f.v3, pf, o[3]);
}
__device__ __forceinline__ void glds16(const void* g, unsigned lds_base) {
    unsigned sv; asm volatile("s_mov_b32 %0, m0\n\ts_mov_b32 m0, %2\n\ts_nop 0\n\tglobal_load_lds_dwordx4 %1, off\n\ts_mov_b32 m0, %0" : "=&s"(sv) : "v"(g), "s"(lds_base) : "memory"); }
__device__ __forceinline__ void glds16s(const void* sbase, unsigned voff, unsigned lds_base) {
    unsigned sv; asm volatile("s_mov_b32 %0, m0\n\ts_mov_b32 m0, %3\n\ts_nop 0\n\tglobal_load_lds_dwordx4 %1, %2\n\ts_mov_b32 m0, %0" : "=&s"(sv) : "v"(voff), "s"(sbase), "s"(lds_base) : "memory"); }
#define RFL(x) __builtin_amdgcn_readfirstlane(x)
template <bool MASK> __device__ __forceinline__ void soft_step64(const f32x4 (&sc)[4], int key0, int lo, int hi, float rowbias, float& m, float& l, f32x4 (&o)[4], bf16x8& pf0, bf16x8& pf1) {
    float s[16];
#pragma unroll
    for (int e = 0; e < 16; ++e) { const float x = __builtin_fmaf(sc[e >> 2][e & 3], C2, rowbias);
        if (MASK) { const int key_ = key0 + 32 * (e >> 3) + (e & 7); s[e] = (key_ >= lo && key_ <= hi) ? x : NEGBIG; } else s[e] = x; }
    float mx = fmaxf(fmaxf(fmaxf(fmaxf(s[0], s[1]), fmaxf(s[2], s[3])), fmaxf(fmaxf(s[4], s[5]), fmaxf(s[6], s[7]))), fmaxf(fmaxf(fmaxf(s[8], s[9]), fmaxf(s[10], s[11])), fmaxf(fmaxf(s[12], s[13]), fmaxf(s[14], s[15]))));
    mx = rowmax4(mx);
    const float mn = fmaxf(m, mx), alpha = fast_exp2(m - mn);
    float p[16], sum = 0.f;
#pragma unroll
    for (int e = 0; e < 16; ++e) { p[e] = fast_exp2(s[e] - mn); sum += p[e]; }
    sum = rowsum4(sum);
    l = l * alpha + sum; m = mn;
#pragma unroll
    for (int nt = 0; nt < 4; ++nt) o[nt] = o[nt] * alpha;
    u32x4 w0, w1;
    w0.x = cvt_pk_bf16(p[0], p[1]); w0.y = cvt_pk_bf16(p[2], p[3]); w0.z = cvt_pk_bf16(p[4], p[5]); w0.w = cvt_pk_bf16(p[6], p[7]);
    w1.x = cvt_pk_bf16(p[8], p[9]); w1.y = cvt_pk_bf16(p[10], p[11]); w1.z = cvt_pk_bf16(p[12], p[13]); w1.w = cvt_pk_bf16(p[14], p[15]);
    pf0 = __builtin_bit_cast(bf16x8, w0); pf1 = __builtin_bit_cast(bf16x8, w1);
}


__global__ void __launch_bounds__(NWAVES * 64, 2) nsa_fwd(Args args) {
    extern __shared__ __attribute__((aligned(16))) unsigned char lds[];
    cg::grid_group grid = cg::this_grid();
    const int tid = threadIdx.x, lane = tid & 63, wave = __builtin_amdgcn_readfirstlane(tid >> 6);
    const int G = gridDim.x, gw = blockIdx.x * NWAVES + wave, NGW = G * NWAVES;
    unsigned char* ws = args.ws;
    LAS unsigned char* ldsl = (LAS unsigned char*)lds;

    const float* x = args.in[0]; const int* positions = (const int*)args.in[1];
    float* H = args.out;
    float* SSQ0 = (float*)(ws + WS_SSQ0); float* SSQ1 = (float*)(ws + WS_SSQ1); float* SSQ2 = (float*)(ws + WS_SSQ2); float* SSQ3 = (float*)(ws + WS_SSQ3);
    float* PEB = (float*)(ws + WS_PEB);
    bf16_t* W1GU = (bf16_t*)(ws + WS_W1GU); bf16_t* W1D = (bf16_t*)(ws + WS_W1D); bf16_t* WIN = (bf16_t*)(ws + WS_WIN);
    bf16_t* CW1K = (bf16_t*)(ws + WS_CW1K); bf16_t* CW1V = (bf16_t*)(ws + WS_CW1V); bf16_t* CW2K = (bf16_t*)(ws + WS_CW2K); bf16_t* CW2V = (bf16_t*)(ws + WS_CW2V);
    bf16_t* WA = (bf16_t*)(ws + WS_WA); bf16_t* WB = (bf16_t*)(ws + WS_WB); bf16_t* WOUT = (bf16_t*)(ws + WS_WOUT); bf16_t* W2GU = (bf16_t*)(ws + WS_W2GU); bf16_t* W2D = (bf16_t*)(ws + WS_W2D);
    float* ROPEC = (float*)(ws + WS_ROPEC); float* ROPES = (float*)(ws + WS_ROPES);
    bf16_t* XB = (bf16_t*)(ws + WS_XB); bf16_t* ACT = (bf16_t*)(ws + WS_ACT);
    bf16_t* GA = (bf16_t*)(ws + WS_GA); bf16_t* GB = (bf16_t*)(ws + WS_GB); bf16_t* NQ = (bf16_t*)(ws + WS_NQ);
    bf16_t* KCMP = (bf16_t*)(ws + WS_KCMP); bf16_t* VCMPT = (bf16_t*)(ws + WS_VCMPT); unsigned* SEL = (unsigned*)(ws + WS_SEL); float* NG = (float*)(ws + WS_NG);
    bf16_t* SQ = (bf16_t*)(ws + WS_SQ); bf16_t* OCMP = (bf16_t*)(ws + WS_OCMP); bf16_t* KC = (bf16_t*)(ws + WS_KC); bf16_t* VC = (bf16_t*)(ws + WS_VC);
    bf16_t* KSL = (bf16_t*)(ws + WS_KSL); bf16_t* VSLT = (bf16_t*)(ws + WS_VSLT); bf16_t* KWN = (bf16_t*)(ws + WS_KWN); bf16_t* VWNT = (bf16_t*)(ws + WS_VWNT);
    bf16_t* SK = (bf16_t*)(ws + WS_SK); bf16_t* SVT = (bf16_t*)(ws + WS_SVT);
#if defined(DBG_NOFFN1)
    bf16_t* OB = (bf16_t*)(ws + 150 * MiB);
#else
    bf16_t* OB = SQ;
#endif

    const int fr = lane & 15, fq = lane >> 4;
#define GRID_SYNC_CG() do { asm volatile("s_waitcnt vmcnt(0) lgkmcnt(0)" ::: "memory"); __syncthreads(); grid.sync(); \
        __builtin_amdgcn_fence(__ATOMIC_ACQUIRE, "agent"); asm volatile("s_waitcnt vmcnt(0)" ::: "memory"); __syncthreads(); } while (0)
#define GRID_SYNC() xcd_barrier(xbar)
    volatile LAS unsigned* MISC = (volatile LAS unsigned*)(ldsl + LDS_BYTES - 1024);
    if (tid < 16) MISC[tid] = 0u;
    __syncthreads();
    XcdBarrier xbar = xcd_barrier_post((unsigned*)(ws + WS_BAR), MISC + 8);

#ifndef DBG_STOP
#define DBG_STOP 0
#endif
#define DUMP_LOOP(expr) do { for (size_t i_ = (size_t)blockIdx.x * 512 + tid; i_ < (size_t)TOK * DM; i_ += (size_t)G * 512) { args.out[i_] = (expr); } return; } while (0)
    {
        LAS float* scr = (LAS float*)(ldsl + wave * 16384);
        constexpr int I_GU = 16 * 88, I_D = 44 * 32, I_IN = 16 * 125, I_C1 = 32 * 8, I_C2 = 4 * 2, I_AB = 8 * 32, I_O = 16 * 32;
        constexpr int NITEMS = 6 * I_GU + I_IN + 2 * I_C1 + 2 * I_C2 + 2 * I_AB + I_O;
        static_assert(I_GU == I_D, "items");
        for (int it = gw; it < 2 * I_GU + I_IN; it += NGW) {
            int r = it;
            if (r < I_GU) { transpose_item(args.in[3], 1024, 2816, W1GU, 1, 0, args.in[2], scr, r, lane); continue; } r -= I_GU;
            if (r < I_GU) { transpose_item(args.in[4], 1024, 2816, W1GU, 1, 128, args.in[2], scr, r, lane); continue; } r -= I_GU;
            transpose_item(args.in[7], 1024, 3992, WIN, 2, 0, args.in[6], scr, r, lane);
        }
        for (int mrow = gw; mrow < TOK; mrow += NGW) {
            const f32x4* xr = (const f32x4*)(x + (size_t)mrow * DM) + lane;
            unsigned long long* o8 = (unsigned long long*)(XB + (size_t)mrow * DM) + lane;
            float s = 0.f;
#pragma unroll
            for (int j = 0; j < 4; ++j) { const f32x4 v = xr[64 * j]; s += (v[0] * v[0] + v[1] * v[1]) + (v[2] * v[2] + v[3] * v[3]);
                o8[64 * j] = (unsigned long long)pk2(v[0], v[1]) | ((unsigned long long)pk2(v[2], v[3]) << 32); }
            s = wave_sum(s);
            if (lane < 16) SSQ0[(size_t)mrow * 16 + lane] = lane == 0 ? s : 0.f;
        }
        for (int idx = blockIdx.x * (NWAVES * 64) + tid; idx < TOK * 32; idx += G * NWAVES * 64) {
            const int trow = idx >> 5, i = idx & 31;
            const float ang = (float)positions[trow] * INV_FREQ[i];
            const double rev = (double)ang * 0.15915494309189535; const float frac = (float)(rev - __builtin_rint(rev));
            ROPEC[idx] = __builtin_amdgcn_cosf(frac); ROPES[idx] = __builtin_amdgcn_sinf(frac);
        }
        for (int o = gw; o < 512; o += NGW) {
            const int z = o >> 8, j = o & 255; const float* pe = args.in[z ? 11 : 8]; const float* w1 = args.in[z ? 12 : 9];
            float s = 0.f;
            for (int kk = lane; kk < 2048; kk += 64) s += pe[kk] * w1[(size_t)kk * 256 + j];
            s = wave_sum(s);
            if (lane == 0) PEB[o] = s;
        }
    }
    if (args.rep[3] == 77) GRID_SYNC_CG();
    GRID_SYNC();

#if !defined(DBG_NOFFN1)
    { pg8::Gemm g{XB, W1GU, TOK, 2 * DFF, DM}; pg8::StaticOrder S; S.init(TOK, 2 * DFF, G, (int)blockIdx.x);
      pg8::EpiSwiglu E{ACT, SSQ0};
      pg8::gemm_phase<pg8::EpiSwiglu, pg8::StaticOrder, true, true>(ldsl, g, S, E); }
    {
        constexpr int I_GU = 16 * 88, I_D = 44 * 32, I_C1 = 32 * 8, I_C2 = 4 * 2, I_AB = 8 * 32, I_O = 16 * 32;
        constexpr int NLATE = 2 * I_GU + 2 * I_D + 2 * I_C1 + 2 * I_C2 + 2 * I_AB + I_O, NUNITS = (TOK / 256) * (2 * DFF / 256);
        const int rem = NUNITS % G, first = rem ? rem : 0, np = rem ? G - rem : G;
        if ((int)blockIdx.x >= first) {
            LAS float* scr = (LAS float*)(ldsl + wave * 16384);
            for (int it = ((int)blockIdx.x - first) * NWAVES + wave; it < NLATE; it += np * NWAVES) {
                int r = it;
                if (r < I_D) { transpose_item(args.in[5], 2816, 1024, W1D, 0, 0, nullptr, scr, r, lane); continue; } r -= I_D;
                if (r < I_GU) { transpose_item(args.in[19], 1024, 2816, W2GU, 1, 0, args.in[18], scr, r, lane); continue; } r -= I_GU;
                if (r < I_GU) { transpose_item(args.in[20], 1024, 2816, W2GU, 1, 128, args.in[18], scr, r, lane); continue; } r -= I_GU;
                if (r < I_D) { transpose_item(args.in[21], 2816, 1024, W2D, 0, 0, nullptr, scr, r, lane); continue; } r -= I_D;
                if (r < I_C1) { transpose_item(args.in[9], 2048, 256, CW1K, 0, 0, nullptr, scr, r, lane); continue; } r -= I_C1;
                if (r < I_C1) { transpose_item(args.in[12], 2048, 256, CW1V, 0, 0, nullptr, scr, r, lane); continue; } r -= I_C1;
                if (r < I_C2) { transpose_item(args.in[10], 256, 64, CW2K, 3, 0, nullptr, scr, r, lane); continue; } r -= I_C2;
                if (r < I_C2) { transpose_item(args.in[13], 256, 64, CW2V, 0, 0, nullptr, scr, r, lane); continue; } r -= I_C2;
                if (r < I_AB) { transpose_item(args.in[15], 512, 1024, WA, 0, 0, nullptr, scr, r, lane); continue; } r -= I_AB;
                if (r < I_AB) { transpose_item(args.in[16], 512, 1024, WB, 0, 0, nullptr, scr, r, lane); continue; } r -= I_AB;
                transpose_item(args.in[17], 1024, 1024, WOUT, 0, 0, nullptr, scr, r, lane);
            }
        }
    }
    GRID_SYNC();
    if (DBG_STOP == 12) DUMP_LOOP(bf2f(ACT[i_]) + bf2f(ACT[i_ + 16777216]) + (i_ < 12582912 ? bf2f(ACT[i_ + 33554432]) : 0.f));
    if (args.rep[3] == 1) { pg8::Gemm g{XB, W1GU, TOK, 2 * DFF, DM}; pg8::StaticOrder S; S.init(TOK, 2 * DFF, G, (int)blockIdx.x); pg8::EpiDry E{PEB, args.rep[0] - 1};
      pg8::gemm_phase<pg8::EpiDry, pg8::StaticOrder, true, true>(ldsl, g, S, E); GRID_SYNC(); }
    if (args.rep[3] == 2) { pg8::Gemm g{ACT, W1D, TOK, DM, DFF}; pg8::StaticOrder S; S.init(TOK, DM, G, (int)blockIdx.x); pg8::EpiDry E{PEB, args.rep[0] - 1};
      pg8::gemm_phase<pg8::EpiDry, pg8::StaticOrder, true, true>(ldsl, g, S, E); GRID_SYNC(); }
    if (args.rep[3] == 3) { pg8::Gemm g{XB, WIN, TOK, 4096, DM}; pg8::StaticOrder S; S.init(TOK, 4096, G, (int)blockIdx.x); pg8::EpiDry E{PEB, args.rep[0] - 1};
      pg8::gemm_phase<pg8::EpiDry, pg8::StaticOrder, true, true>(ldsl, g, S, E); GRID_SYNC(); }
    if (args.rep[3] == 4) { pg8::Gemm g{XB, WA, TOK, DM, 512}; pg8::StaticOrder S; S.init(TOK, DM, G, (int)blockIdx.x); pg8::EpiDry E{PEB, args.rep[0] - 1};
      pg8::gemm_phase<pg8::EpiDry, pg8::StaticOrder, true, true>(ldsl, g, S, E); GRID_SYNC(); }
    if (args.rep[3] == 6) { GRID_SYNC(); GRID_SYNC(); GRID_SYNC(); GRID_SYNC(); GRID_SYNC(); GRID_SYNC(); GRID_SYNC(); GRID_SYNC(); GRID_SYNC(); GRID_SYNC(); }
    { pg8::Gemm g{ACT, W1D, TOK, DM, DFF}; pg8::StaticOrder S; S.init(TOK, DM, G, (int)blockIdx.x);
      pg8::EpiResid E{x, H, XB, SSQ1, 0.5f};
      pg8::gemm_phase<pg8::EpiResid, pg8::StaticOrder, true, true>(ldsl, g, S, E); }
    GRID_SYNC();
    if (DBG_STOP == 1) return;
#endif
    { pg8::Gemm g{XB, WIN, TOK, 4096, DM}; pg8::StaticOrder S; S.init(TOK, 4096, G, (int)blockIdx.x);
      pg8::EpiProj E{
#if defined(DBG_NOFFN1)
 SSQ0,
#else
 SSQ1,
#endif
 ROPEC, ROPES, NQ, KC, VC, KSL, VSLT, KWN, VWNT, SQ, SK, SVT, GA, GB, NG};
      pg8::gemm_phase<pg8::EpiProj, pg8::StaticOrder, true, true>(ldsl, g, S, E); }
    GRID_SYNC();
    if (DBG_STOP == 13) DUMP_LOOP(bf2f(NQ[i_ & 8388607]) + bf2f(SQ[i_ & 8388607]) + bf2f(KC[i_ & 2097151]) + bf2f(VC[i_ & 2097151]) + bf2f(KSL[i_ & 2097151]) + bf2f(VSLT[i_ & 2097151]) + bf2f(KWN[i_ & 2097151]) + bf2f(VWNT[i_ & 2097151]) + bf2f(SK[i_ & 1048575]) + bf2f(SVT[i_ & 1048575]) + NG[i_ % (TOK * 24)]);
    if (DBG_STOP == 11) DUMP_LOOP(bf2f(GA[i_]) + bf2f(GB[i_]));
    if (DBG_STOP == 2) DUMP_LOOP(bf2f(GA[i_]) + bf2f(GB[i_]) + bf2f(NQ[i_ & 8388607]) + bf2f(SQ[i_ & 8388607]) + bf2f(KC[i_ & 2097151]) + bf2f(VC[i_ & 2097151]) + bf2f(KSL[i_ & 2097151]) + bf2f(VSLT[i_ & 2097151]) + bf2f(KWN[i_ & 2097151]) + bf2f(VWNT[i_ & 2097151]) + bf2f(SK[i_ & 1048575]) + bf2f(SVT[i_ & 1048575]) + NG[i_ % (TOK * 24)]);

    for (int rep = 0; rep < args.rep[0]; ++rep)
    for (int u = blockIdx.x; u < 256; u += G) {
        const int z = u >> 7, r0 = (u & 127) * 16;
        const bf16_t* A = z ? VC : KC; const bf16_t* W1 = z ? CW1V : CW1K; const bf16_t* W2 = z ? CW2V : CW2K; const float* peb = PEB + z * 256;
        bf16_t* hid = (bf16_t*)lds;
        f32x4 acc0 = {0.f, 0.f, 0.f, 0.f}, acc1 = {0.f, 0.f, 0.f, 0.f};
        const bf16_t* ap = A + (size_t)(r0 + fr) * 1024 + 8 * fq;
        const bf16_t* bp0 = W1 + (size_t)(32 * wave + fr) * 2048 + 8 * fq; const bf16_t* bp1 = bp0 + 16 * 2048;
#pragma unroll 8
        for (int k0 = 0; k0 < 2048; k0 += 32) {
            const bf16x8 a = *(const bf16x8*)(ap + k0), b0 = *(const bf16x8*)(bp0 + k0), b1 = *(const bf16x8*)(bp1 + k0);
            acc0 = MFMA16(b0, a, acc0); acc1 = MFMA16(b1, a, acc1);
        }
#pragma unroll
        for (int nt = 0; nt < 2; ++nt) {
            const f32x4 a = nt ? acc1 : acc0; const int col = 32 * wave + 16 * nt + 4 * fq;
            float hv[4];
#pragma unroll
            for (int r = 0; r < 4; ++r) { const float h = a[r] + peb[col + r]; const float uu = 0.7978845608028654f * (h + 0.044715f * h * h * h);
                const float th = 1.0f - 2.0f * fast_rcp(1.0f + fast_exp2(2.0f * LOG2E * uu)); hv[r] = 0.5f * h * (1.0f + th); }
            unsigned* hp = (unsigned*)(hid + fr * 264 + col); hp[0] = cvt_pk_bf16(hv[0], hv[1]); hp[1] = cvt_pk_bf16(hv[2], hv[3]);
        }
        __syncthreads();
        if (wave < 4) {
            f32x4 acc2 = {0.f, 0.f, 0.f, 0.f};
            const bf16_t* wp = W2 + (size_t)(16 * wave + fr) * 256 + 8 * fq;
#pragma unroll
            for (int k0 = 0; k0 < 256; k0 += 32) { const bf16x8 a = *(const bf16x8*)(wp + k0), bb = *(const bf16x8*)(hid + fr * 264 + k0 + 8 * fq); acc2 = MFMA16(a, bb, acc2); }
            const int r = r0 + fr, bg = r >> 9, i = r & 511, bb_ = bg >> 1;
            const bool ok = i < 511;
            if (z == 0) {
                const int trow = bb_ * SEQ + 16 * (ok ? i : 0) + 31, i0 = 8 * wave + 2 * fq;
                const float c0 = ROPEC[(size_t)trow * 32 + i0], s0 = ROPES[(size_t)trow * 32 + i0], c1 = ROPEC[(size_t)trow * 32 + i0 + 1], s1 = ROPES[(size_t)trow * 32 + i0 + 1];
                float o0 = acc2[0] * c0 - acc2[1] * s0, o1 = acc2[1] * c0 + acc2[0] * s0, o2 = acc2[2] * c1 - acc2[3] * s1, o3 = acc2[3] * c1 + acc2[2] * s1;
                if (!ok) { o0 = 0.f; o1 = 0.f; o2 = 0.f; o3 = 0.f; }
                unsigned* kp = (unsigned*)(KCMP + ((size_t)bg * 512 + i) * 64 + 16 * wave + 4 * fq); kp[0] = cvt_pk_bf16(o0, o1); kp[1] = cvt_pk_bf16(o2, o3);
            } else {
#pragma unroll
                for (int rr = 0; rr < 4; ++rr) VCMPT[((size_t)bg * 64 + 16 * wave + 4 * fq + rr) * 512 + i] = (bf16_t)f2bf(ok ? acc2[rr] : 0.f);
            }
        }
        __syncthreads();
    }
    GRID_SYNC();
    if (DBG_STOP == 3) DUMP_LOOP(bf2f(KCMP[i_ & 131071]) + bf2f(VCMPT[i_ & 131071]));

    {
        constexpr int RS = 72;
        bf16_t* Kb = (bf16_t*)lds;
        bf16_t* Vb = (bf16_t*)(lds + 2 * 64 * RS * 2);
        float* Pl = (float*)(lds + 40960 + wave * 10240);
        unsigned long long* KEY = (unsigned long long*)(Pl + 2048);
        const int skr = tid >> 3, sc8 = (tid & 7) * 8;
        const int krow = (skr & 32) + (((skr & 7) < 4) ? (4 * ((skr & 31) >> 3) + (skr & 7)) : (16 + 4 * ((skr & 31) >> 3) + (skr & 7) - 4));
        for (int rep = 0; rep < args.rep[1]; ++rep)
        for (int wu = blockIdx.x; wu < 1024; wu += G) {
            const int bg = wu >> 8, tl0 = wu & 255, tile = (bg & 1) ? 255 - tl0 : tl0, t0w = tile * 32, t0 = t0w + 4 * wave, b = bg >> 1, g = bg & 1;
            const int tl = fr >> 2, hh = fr & 3, t = t0 + tl, head = g * 4 + hh;
            const size_t qrow = (size_t)(b * SEQ + t);
            bf16x8 qf[2]; qf[0] = *(const bf16x8*)(NQ + qrow * 512 + head * 64 + 8 * fq); qf[1] = *(const bf16x8*)(NQ + qrow * 512 + head * 64 + 32 + 8 * fq);
            const bf16_t* Kc = KCMP + (size_t)bg * 512 * 64; const bf16_t* Vc = VCMPT + (size_t)bg * 64 * 512;
            const int hi = (t >= 31) ? ((t - 31) >> 4) : -1;
            const int hiw = (t0 + 3 >= 31) ? ((t0 + 3 - 31) >> 4) : -1;
            const int nst = (2 * tile + 64) >> 6;
            u32x4 kreg, vreg;
#define C_LOADK(s_) do { kreg = *(const u32x4*)(Kc + (size_t)(64 * (s_) + skr) * 64 + sc8); } while (0)
#define C_LOADV(s_) do { vreg = *(const u32x4*)(Vc + (size_t)skr * 512 + 64 * (s_) + sc8); } while (0)
#define C_WRITEK(bufi) do { *(u32x4*)(Kb + (bufi) * 64 * RS + krow * RS + sc8) = kreg; } while (0)
#define C_WRITEV(bufi) do { *(u32x4*)(Vb + (bufi) * 64 * RS + skr * RS + sc8) = vreg; } while (0)
#define C_FRAGK(F, Kt, half) do { const bf16_t* ka = (Kt) + (32 * (half) + fr) * RS + 8 * fq; \
                F.k0 = *(const bf16x8*)ka; F.k1 = *(const bf16x8*)(ka + 32); F.k2 = *(const bf16x8*)(ka + 16 * RS); F.k3 = *(const bf16x8*)(ka + 16 * RS + 32); } while (0)
#define C_FRAGV(F, Vt, half) do { const bf16_t* va = (Vt) + fr * RS + 32 * (half) + 8 * fq; \
                F.v0 = *(const bf16x8*)va; F.v1 = *(const bf16x8*)(va + 16 * RS); F.v2 = *(const bf16x8*)(va + 32 * RS); F.v3 = *(const bf16x8*)(va + 48 * RS); } while (0)
            float m = NEGBIG, l = 0.f;
            C_LOADK(0); C_WRITEK(0);
            __syncthreads();
            for (int s = 0; s < nst; ++s) {
                if (s + 1 < nst) C_LOADK(s + 1);
                const bf16_t* Kt = Kb + (s & 1) * 64 * RS;
#pragma unroll
                for (int half = 0; half < 2; ++half) {
                    const int kbase = 64 * s + 32 * half;
                    if (kbase <= hiw) {
                        Frag F; C_FRAGK(F, Kt, half);
                        f32x4 sA, sB; qk_frag(F, qf, sA, sB);
                        SCORES8(sA, sB, kbase + 8 * fq, 0, hi, sc_, v)
                        float mx = fmaxf(fmaxf(fmaxf(sc_[0], sc_[1]), fmaxf(sc_[2], sc_[3])), fmaxf(fmaxf(sc_[4], sc_[5]), fmaxf(sc_[6], sc_[7])));
                        mx = rowmax4(mx);
                        const float mn = fmaxf(m, mx), alpha = fast_exp2(m - mn);
                        float sum = 0.f;
#pragma unroll
                        for (int e = 0; e < 8; ++e) sum += v[e] ? fast_exp2(sc_[e] - mn) : 0.f;
                        sum = rowsum4(sum);
                        l = l * alpha + sum; m = mn;
                    }
                }
                if (s + 1 < nst) C_WRITEK((s + 1) & 1);
                __syncthreads();
            }
            const float inv_l = l > 0.f ? 1.0f / l : 0.f;
#pragma unroll
            for (int q = 0; q < 8; ++q) ((f32x4*)Pl)[lane + 64 * q] = (f32x4){0.f, 0.f, 0.f, 0.f};
            f32x4 o[4];
#pragma unroll
            for (int nt = 0; nt < 4; ++nt) o[nt] = (f32x4){0.f, 0.f, 0.f, 0.f};
            C_LOADK(0); C_LOADV(0); C_WRITEK(0); C_WRITEV(0);
            __syncthreads();
            for (int s = 0; s < nst; ++s) {
                if (s + 1 < nst) { C_LOADK(s + 1); C_LOADV(s + 1); }
                const bf16_t* Kt = Kb + (s & 1) * 64 * RS; const bf16_t* Vt = Vb + (s & 1) * 64 * RS;
#pragma unroll
                for (int half = 0; half < 2; ++half) {
                    const int kbase = 64 * s + 32 * half;
                    if (kbase <= hiw) {
                        Frag F; C_FRAGK(F, Kt, half); C_FRAGV(F, Vt, half);
                        f32x4 sA, sB; qk_frag(F, qf, sA, sB);
                        SCORES8(sA, sB, kbase + 8 * fq, 0, hi, sc_, v)
                        float p[8], ps[8];
#pragma unroll
                        for (int e = 0; e < 8; ++e) { p[e] = v[e] ? fast_exp2(sc_[e] - m) * inv_l : 0.f; float q_ = p[e] + __shfl_xor(p[e], 1); ps[e] = q_ + __shfl_xor(q_, 2); }
                        if (hh == 0) { f32x4* pp = (f32x4*)(Pl + tl * 512 + kbase + 8 * fq); pp[0] = (f32x4){ps[0], ps[1], ps[2], ps[3]}; pp[1] = (f32x4){ps[4], ps[5], ps[6], ps[7]}; }
                        u32x4 w; w.x = cvt_pk_bf16(p[0], p[1]); w.y = cvt_pk_bf16(p[2], p[3]); w.z = cvt_pk_bf16(p[4], p[5]); w.w = cvt_pk_bf16(p[6], p[7]);
                        pv_frag(F, __builtin_bit_cast(bf16x8, w), o);
                    }
                }
                if (s + 1 < nst) { C_WRITEK((s + 1) & 1); C_WRITEV((s + 1) & 1); }
                __syncthreads();
            }
            {
                const float gc = NG[qrow * 24 + head];
#pragma unroll
                for (int nt = 0; nt < 4; ++nt) { unsigned* op = (unsigned*)(OCMP + qrow * 512 + head * 64 + 16 * nt + 4 * fq);
                    op[0] = cvt_pk_bf16(o[nt][0] * gc, o[nt][1] * gc); op[1] = cvt_pk_bf16(o[nt][2] * gc, o[nt][3] * gc); }
            }
            LDS_WAIT();
            for (int tk = 0; tk < 4; ++tk) {
                const int tt = t0 + tk, tb = tt >> 6;
                const float* P = Pl + tk * 512;
                unsigned hv[2];
#pragma unroll
                for (int q = 0; q < 2; ++q) { const int j = lane + 64 * q;
                    const float a = (j > 0 ? 0.5f * P[4 * j - 1] : 0.f) + P[4 * j] + P[4 * j + 1] + P[4 * j + 2] + 0.5f * P[4 * j + 3];
                    const bool forced = (j == 0) || (j <= tb && tb - j < 2);
                    hv[q] = j > tb ? 0u : (forced ? 0x7f000000u : __float_as_uint(a) + 1u); }
                unsigned T = 0u;
                for (int bit = 30; bit >= 0; --bit) {
                    const unsigned cand = T | (1u << bit);
                    const int cnt = __builtin_popcountll(__ballot(hv[0] >= cand)) + __builtin_popcountll(__ballot(hv[1] >= cand));
                    T = cnt >= 16 ? cand : T;
                }
                const unsigned long long g0 = __ballot(hv[0] > T), g1 = __ballot(hv[1] > T), e0 = __ballot(hv[0] == T), e1 = __ballot(hv[1] == T);
                const int need = 16 - (__builtin_popcountll(g0) + __builtin_popcountll(g1));
                const unsigned long long below = (1ull << lane) - 1ull;
                const bool s0 = (hv[0] > T) || ((hv[0] == T) && __builtin_popcountll(e0 & below) < need);
                const bool s1 = (hv[1] > T) || ((hv[1] == T) && (__builtin_popcountll(e0) + __builtin_popcountll(e1 & below)) < need);
                const unsigned long long b0 = __ballot(s0 && lane <= tb), b1 = __ballot(s1 && lane + 64 <= tb);
                if (lane == 0) { u32x4 w; w.x = (unsigned)b0; w.y = (unsigned)(b0 >> 32); w.z = (unsigned)b1; w.w = (unsigned)(b1 >> 32); *(u32x4*)(SEL + ((size_t)bg * SEQ + tt) * 4) = w; }
            }
            LDS_WAIT();
        }
    }
    GRID_SYNC();
    if (DBG_STOP == 4) DUMP_LOOP(bf2f(OCMP[i_ & 8388607]) + (float)(SEL[i_ & 131071] & 0xffffu));

    {
        constexpr int RB = 4, SLOTB = 32768;
        const unsigned ring_base = (unsigned)(size_t)ldsl;
        const unsigned char* ring = (const unsigned char*)lds;
        unsigned* Usc = (unsigned*)(lds + RB * SLOTB);
        int* lst = (int*)(lds + RB * SLOTB + 128);
        int* nls = (int*)(lds + RB * SLOTB + 128 + 1024);
        int* flg = (int*)(lds + RB * SLOTB + 128 + 1024 + 128);
        const int dl_r = lane >> 3, dl_c = lane & 7;
        const unsigned voffK = (unsigned)((8 * (dl_r >> 2) + (dl_r & 3)) * 128 + ((dl_c ^ dl_r) << 4)), voffV = (unsigned)(dl_r * SEQ * 2 + ((dl_c ^ dl_r) << 4));
        const int offA = fr * 128 + ((fq ^ (fr & 7)) << 4), offB = fr * 128 + (((fq ^ (fr & 7)) ^ 4) << 4);
        for (int rep = 0; rep < args.rep[2]; ++rep)
        for (int wu = blockIdx.x; wu < 512; wu += G) {
            const int k_ = wu >> 8, bb_ = wu & 255, bg = 2 * k_ + (bb_ >> 7), tau = (bb_ & 128) ? 127 - (bb_ & 127) : (bb_ & 127), tile = k_ ? 127 - tau : tau;
            const int t0w = tile * 64, t0 = t0w + 8 * wave, b = bg >> 1, g = bg & 1;
            const int tl = fr >> 2, hh = fr & 3, head = g * 4 + hh;
            const bf16_t* Ks = KSL + (size_t)bg * SEQ * 64; const bf16_t* Vs = VSLT + (size_t)bg * 64 * SEQ;
            const bf16_t* Kw = KWN + (size_t)bg * SEQ * 64; const bf16_t* Vw = VWNT + (size_t)bg * 64 * SEQ;
            bf16x8 qf[2][2]; u32x4 mym[2]; unsigned Uw[2][4]; int tr[2];
#pragma unroll
            for (int rg = 0; rg < 2; ++rg) {
                tr[rg] = t0 + 4 * rg + tl;
                const size_t qrow = (size_t)(b * SEQ + tr[rg]);
                qf[rg][0] = *(const bf16x8*)(NQ + qrow * 512 + head * 64 + 8 * fq); qf[rg][1] = *(const bf16x8*)(NQ + qrow * 512 + head * 64 + 32 + 8 * fq);
                mym[rg] = *(const u32x4*)(SEL + ((size_t)bg * SEQ + tr[rg]) * 4);
#pragma unroll
                for (int w = 0; w < 4; ++w) { const unsigned mw = mym[rg][w];
                    Uw[rg][w] = (unsigned)__builtin_amdgcn_readlane((int)mw, 0) | (unsigned)__builtin_amdgcn_readlane((int)mw, 4) | (unsigned)__builtin_amdgcn_readlane((int)mw, 8) | (unsigned)__builtin_amdgcn_readlane((int)mw, 12); }
            }
            if (lane == 0) { Usc[wave * 4 + 0] = Uw[0][0] | Uw[1][0]; Usc[wave * 4 + 1] = Uw[0][1] | Uw[1][1]; Usc[wave * 4 + 2] = Uw[0][2] | Uw[1][2]; Usc[wave * 4 + 3] = Uw[0][3] | Uw[1][3]; }
            __syncthreads();
            if (wave == 0) {
                int n0 = 0;
#pragma unroll
                for (int q = 0; q < 2; ++q) { const int j = lane + 64 * q; unsigned ug = 0u;
#pragma unroll
                    for (int ww = 0; ww < 8; ++ww) ug |= Usc[ww * 4 + (j >> 5)];
                    const bool in = ((ug >> (j & 31)) & 1u) && (64 * j <= t0w + 63);
                    const unsigned long long bal = __ballot(in);
                    const int pos = n0 + __builtin_popcountll(bal & ((1ull << lane) - 1ull));
                    if (in) lst[pos] = j;
                    n0 += __builtin_popcountll(bal); }
                if (n0 & 1) { if (lane == 0) lst[n0] = 0x100; ++n0; }
                const int jw0 = (t0w - 511 > 0 ? t0w - 511 : 0) >> 6, nw = ((t0w + 63) >> 6) - jw0 + 1;
                if (lane < nw) lst[n0 + lane] = (jw0 + lane) | 0x80;
                if ((nw & 1) && lane == 0) lst[n0 + nw] = 0x180;
                if (lane == 0) nls[0] = n0 + ((nw + 1) & ~1);
                if (lane < 16) flg[lane] = 0;
            }
            __syncthreads();
            const int n = RFL(nls[0]);
            float mS[2], lS[2]; f32x4 oS[2][4];
#pragma unroll
            for (int rg = 0; rg < 2; ++rg) { mS[rg] = NEGBIG; lS[rg] = 0.f;
#pragma unroll
                for (int nt = 0; nt < 4; ++nt) oS[rg][nt] = (f32x4){0.f, 0.f, 0.f, 0.f}; }
            int nslc_ = 0;
            { int c_ = 0; for (int i_ = lane; i_ < n; i_ += 64) c_ += (lst[i_] & 0x80) ? 0 : 1; c_ = (int)wave_sum((float)c_); nslc_ = RFL(c_); }
#define RG_WAIT(ptr, target) do { while (__hip_atomic_load((ptr), __ATOMIC_RELAXED, __HIP_MEMORY_SCOPE_WORKGROUP) < (target)) __builtin_amdgcn_s_sleep(1); asm volatile("" ::: "memory"); } while (0)
#define RG_SIGNAL(ptr) do { LDS_WAIT(); if (lane == 0) __hip_atomic_fetch_add((ptr), 1, __ATOMIC_RELAXED, __HIP_MEMORY_SCOPE_WORKGROUP); } while (0)
#define DMA_ISSUE(k_) do { const int slot_ = (k_) % RB; RG_WAIT(flg + 8 + slot_, 8 * ((k_) / RB)); \
                for (int sub_ = 0; sub_ < 2; ++sub_) { const int e_ = RFL(lst[2 * (k_) + sub_]); \
                  if (!(e_ & 0x100)) { \
                    const int j_ = e_ & 127; const bf16_t* Kg_ = (e_ & 0x80) ? Kw : Ks; const bf16_t* Vg_ = (e_ & 0x80) ? Vw : Vs; const unsigned sb_ = ring_base + slot_ * SLOTB + sub_ * 16384; \
                    _Pragma("unroll") for (int q_ = 0; q_ < 8; ++q_) { constexpr int RC_[4] = {0, 16, 4, 20}; \
                        glds16s(Kg_ + (size_t)(64 * j_ + 32 * (q_ >> 2) + RC_[q_ & 3]) * 64, voffK, sb_ + q_ * 1024); } \
                    _Pragma("unroll") for (int q_ = 0; q_ < 8; ++q_) glds16s(Vg_ + (size_t)(8 * q_) * SEQ + 64 * j_, voffV, sb_ + 8192 + q_ * 1024); } } \
                } while (0)
#define DMA_PUBLISH(k_) do { asm volatile("s_waitcnt vmcnt(0)" ::: "memory"); if (lane == 0) __hip_atomic_store(flg + ((k_) % RB), (k_) / RB + 1, __ATOMIC_RELAXED, __HIP_MEMORY_SCOPE_WORKGROUP); } while (0)
#define ST_COMPUTE(s_, WIN) do { const int slot = (s_) % RB; \
                RG_WAIT(flg + slot, (s_) / RB + 1); \
                for (int sub = 0; sub < 2; ++sub) { const int e = RFL(lst[2 * (s_) + sub]); if (e & 0x100) continue; const int j = e & 127; \
                const unsigned char* Kt = ring + slot * SLOTB + sub * 16384; const unsigned char* Vt = Kt + 8192; \
                bool act[2], inter[2]; float rb[2]; \
                _Pragma("unroll") for (int rg = 0; rg < 2; ++rg) { const int t0g = t0 + 4 * rg; \
                    if (WIN) { act[rg] = (64 * j + 63 >= t0g - 511) && (64 * j <= t0g + 3); inter[rg] = (64 * j >= t0g + 3 - 511) && (64 * j + 63 <= t0g); rb[rg] = 0.f; } \
                    else { const unsigned uw = j < 32 ? Uw[rg][0] : j < 64 ? Uw[rg][1] : j < 96 ? Uw[rg][2] : Uw[rg][3]; act[rg] = (((uw >> (j & 31)) & 1u) != 0u) && (64 * j <= t0g + 3); \
                           const unsigned mw_ = j < 32 ? mym[rg].x : j < 64 ? mym[rg].y : j < 96 ? mym[rg].z : mym[rg].w; rb[rg] = ((mw_ >> (j & 31)) & 1u) ? 0.f : NEGBIG; inter[rg] = (64 * j + 63 <= t0g); } } \
                _Pragma("unroll") for (int rg = 0; rg < 2; ++rg) if (act[rg]) { \
                    const int t = tr[rg]; f32x4 sc[4]; bf16x8 pf0, pf1; bf16x8 kf[8], vf[8]; \
                    _Pragma("unroll") for (int q_ = 0; q_ < 4; ++q_) { kf[2 * q_] = *(const bf16x8*)(Kt + offA + q_ * 2048); kf[2 * q_ + 1] = *(const bf16x8*)(Kt + offB + q_ * 2048); } \
                    __builtin_amdgcn_sched_barrier(0);     \
                    { const f32x4 z_ = {0.f, 0.f, 0.f, 0.f}; \
                      _Pragma("unroll") for (int q_ = 0; q_ < 4; ++q_) { sc[q_] = MFMA16(kf[2 * q_], qf[rg][0], z_); sc[q_] = MFMA16(kf[2 * q_ + 1], qf[rg][1], sc[q_]); } } \
                    vf[0] = *(const bf16x8*)(Vt + offA); vf[1] = *(const bf16x8*)(Vt + offB); \
                    __builtin_amdgcn_sched_barrier(0);     \
                    if (inter[rg]) soft_step64<false>(sc, 64 * j + 8 * fq, (WIN) ? t - 511 : 0, t, rb[rg], mS[rg], lS[rg], oS[rg], pf0, pf1); \
                    else soft_step64<true>(sc, 64 * j + 8 * fq, (WIN) ? t - 511 : 0, t, rb[rg], mS[rg], lS[rg], oS[rg], pf0, pf1); \
                    __builtin_amdgcn_sched_barrier(0); \
                    _Pragma("unroll") for (int nt = 1; nt < 4; ++nt) { vf[2 * nt] = *(const bf16x8*)(Vt + offA + nt * 2048); vf[2 * nt + 1] = *(const bf16x8*)(Vt + offB + nt * 2048); } \
                    __builtin_amdgcn_sched_barrier(0); \
                    _Pragma("unroll") for (int nt = 0; nt < 4; ++nt) { oS[rg][nt] = MFMA16(vf[2 * nt], pf0, oS[rg][nt]); oS[rg][nt] = MFMA16(vf[2 * nt + 1], pf1, oS[rg][nt]); } \
                } } \
                RG_SIGNAL(flg + 8 + slot); } while (0)
#define ST_STAGE(s_, WIN) do { \
                if ((((s_) + 1) & 7) == wave && (s_) >= 1 && (s_) + 1 < np_) DMA_PUBLISH((s_) + 1);            \
                if ((((s_) + 2) & 7) == wave && (s_) + 2 < np_) DMA_ISSUE((s_) + 2); \
                ST_COMPUTE(s_, WIN); } while (0)
            const int np_ = n >> 1, nps_ = nslc_ >> 1;
            if (wave < 2 && wave < np_) { DMA_ISSUE(wave); DMA_PUBLISH(wave); }
            for (int s = 0; s < nps_; ++s) ST_STAGE(s, false);
#pragma unroll
            for (int rg = 0; rg < 2; ++rg) {
                const size_t qrow = (size_t)(b * SEQ + tr[rg]);
                const float a1 = NG[qrow * 24 + 8 + head] / lS[rg];
#pragma unroll
                for (int nt = 0; nt < 4; ++nt) { unsigned* op = (unsigned*)(OCMP + qrow * 512 + head * 64 + 16 * nt + 4 * fq);
                    const unsigned w0 = op[0], w1 = op[1];
                    const float r0 = __uint_as_float(w0 << 16) + a1 * oS[rg][nt][0], r1 = __uint_as_float(w0 & 0xffff0000u) + a1 * oS[rg][nt][1];
                    const float r2 = __uint_as_float(w1 << 16) + a1 * oS[rg][nt][2], r3 = __uint_as_float(w1 & 0xffff0000u) + a1 * oS[rg][nt][3];
                    if (rep == args.rep[2] - 1) { op[0] = cvt_pk_bf16(r0, r1); op[1] = cvt_pk_bf16(r2, r3); }
                    oS[rg][nt] = (f32x4){0.f, 0.f, 0.f, 0.f}; }
                mS[rg] = NEGBIG; lS[rg] = 0.f;
            }
            asm volatile("s_waitcnt vmcnt(0)" ::: "memory");
            for (int s = nps_; s < np_; ++s) ST_STAGE(s, true);
#pragma unroll
            for (int rg = 0; rg < 2; ++rg) {
                const size_t qrow = (size_t)(b * SEQ + tr[rg]);
                const float a2 = NG[qrow * 24 + 16 + head] / lS[rg];
#pragma unroll
                for (int nt = 0; nt < 4; ++nt) { unsigned* op = (unsigned*)(OCMP + qrow * 512 + head * 64 + 16 * nt + 4 * fq);
                    const unsigned w0 = op[0], w1 = op[1];
                    const float r0 = __uint_as_float(w0 << 16) + a2 * oS[rg][nt][0], r1 = __uint_as_float(w0 & 0xffff0000u) + a2 * oS[rg][nt][1];
                    const float r2 = __uint_as_float(w1 << 16) + a2 * oS[rg][nt][2], r3 = __uint_as_float(w1 & 0xffff0000u) + a2 * oS[rg][nt][3];
                    if (rep == args.rep[2] - 1) { op[0] = cvt_pk_bf16(r0, r1); op[1] = cvt_pk_bf16(r2, r3); } }
            }
            LDS_WAIT();
        }
    }
    __syncthreads();
#ifndef SWA_MUL
#define SWA_MUL 1
#endif
    {
        constexpr int RS = 72;
        bf16_t* Kb = (bf16_t*)lds; bf16_t* Vb = (bf16_t*)(lds + 2 * 64 * RS * 2);
        const int skr = tid >> 3, sc8 = (tid & 7) * 8;
        const int krow = (skr & 32) + (((skr & 7) < 4) ? (4 * ((skr & 31) >> 3) + (skr & 7)) : (16 + 4 * ((skr & 31) >> 3) + (skr & 7) - 4));
        for (int rep = 0, nrepS = args.rep[2] * SWA_MUL; rep < nrepS; ++rep)
        for (int wu = blockIdx.x; wu < 512; wu += G) {
            const int b = wu >> 8, t0w = (wu & 255) * 32, t0 = t0w + 4 * wave;
            const int tl = fr >> 3, h = fr & 7;
            const bf16_t* Kp = SK + (size_t)b * SEQ * 64; const bf16_t* Vp = SVT + (size_t)b * 64 * SEQ;
            bf16x8 qf[2][2]; int tr[2]; float mS[2], lS[2]; f32x4 oS[2][4];
#pragma unroll
            for (int rg = 0; rg < 2; ++rg) { tr[rg] = t0 + 2 * rg + tl; const size_t qrow = (size_t)(b * SEQ + tr[rg]);
                qf[rg][0] = *(const bf16x8*)(SQ + qrow * 512 + h * 64 + 8 * fq); qf[rg][1] = *(const bf16x8*)(SQ + qrow * 512 + h * 64 + 32 + 8 * fq);
                mS[rg] = NEGBIG; lS[rg] = 0.f;
#pragma unroll
                for (int nt = 0; nt < 4; ++nt) oS[rg][nt] = (f32x4){0.f, 0.f, 0.f, 0.f}; }
            const int jlo = (t0w - 127 > 0 ? t0w - 127 : 0) >> 6, n = ((t0w + 31) >> 6) - jlo + 1;
            u32x4 kreg, vreg;
#define SW_LOAD(j_) do { kreg = *(const u32x4*)(Kp + (size_t)(64 * (j_) + skr) * 64 + sc8); vreg = *(const u32x4*)(Vp + (size_t)skr * SEQ + 64 * (j_) + sc8); } while (0)
#define SW_WRITE(bufi) do { *(u32x4*)(Kb + (bufi) * 64 * RS + krow * RS + sc8) = kreg; *(u32x4*)(Vb + (bufi) * 64 * RS + skr * RS + sc8) = vreg; } while (0)
            SW_LOAD(jlo); SW_WRITE(0);
            __syncthreads();
            for (int s = 0; s < n; ++s) {
                const int j = jlo + s;
                if (s + 1 < n) SW_LOAD(j + 1);
                const bf16_t* Kt = Kb + (s & 1) * 64 * RS; const bf16_t* Vt = Vb + (s & 1) * 64 * RS;
#pragma unroll
                for (int rg = 0; rg < 2; ++rg) {
                    const int t0g = t0 + 2 * rg, t = tr[rg];
                    const bool act = (64 * j + 63 >= t0g - 127) && (64 * j <= t0g + 1), inter = (64 * j >= t0g + 1 - 127) && (64 * j + 63 <= t0g);
                    if (act) {
                        f32x4 sc[4]; bf16x8 pf0, pf1;
                        { const bf16_t* ka = Kt + fr * RS + 8 * fq; const f32x4 z_ = {0.f, 0.f, 0.f, 0.f};
#pragma unroll
                          for (int q_ = 0; q_ < 4; ++q_) { const bf16x8 ka0 = *(const bf16x8*)(ka + 16 * q_ * RS), ka1 = *(const bf16x8*)(ka + 16 * q_ * RS + 32);
                              sc[q_] = MFMA16(ka0, qf[rg][0], z_); sc[q_] = MFMA16(ka1, qf[rg][1], sc[q_]); } }
                        if (inter) soft_step64<false>(sc, 64 * j + 8 * fq, t - 127, t, 0.f, mS[rg], lS[rg], oS[rg], pf0, pf1);
                        else soft_step64<true>(sc, 64 * j + 8 * fq, t - 127, t, 0.f, mS[rg], lS[rg], oS[rg], pf0, pf1);
                        { const bf16_t* va = Vt + fr * RS + 8 * fq;
#pragma unroll
                          for (int nt = 0; nt < 4; ++nt) { const bf16x8 va0 = *(const bf16x8*)(va + 16 * nt * RS), va1 = *(const bf16x8*)(va + 16 * nt * RS + 32);
                              oS[rg][nt] = MFMA16(va0, pf0, oS[rg][nt]); oS[rg][nt] = MFMA16(va1, pf1, oS[rg][nt]); } }
                    }
                }
                if (s + 1 < n) SW_WRITE((s + 1) & 1);
                __syncthreads();
            }
#pragma unroll
            for (int rg = 0; rg < 2; ++rg) {
                const size_t qrow = (size_t)(b * SEQ + tr[rg]);
                const float sink2 = args.in[14][h] * LOG2E, mf = fmaxf(mS[rg], sink2), aa = fast_exp2(mS[rg] - mf), lt = lS[rg] * aa + fast_exp2(sink2 - mf), scl = aa / lt;
#pragma unroll
                for (int nt = 0; nt < 4; ++nt) { unsigned* op = (unsigned*)(OB + qrow * 512 + h * 64 + 16 * nt + 4 * fq);
                    if (rep == nrepS - 1) { op[0] = cvt_pk_bf16(oS[rg][nt][0] * scl, oS[rg][nt][1] * scl); op[1] = cvt_pk_bf16(oS[rg][nt][2] * scl, oS[rg][nt][3] * scl); } }
            }
        }
    }
    GRID_SYNC();
    if (DBG_STOP == 5) DUMP_LOOP(bf2f(OCMP[i_ & 8388607]) + bf2f(SQ[i_ & 8388607]));
    if (DBG_STOP == 10) DUMP_LOOP(bf2f(GA[i_]) + bf2f(GB[i_]));

#if !defined(DBG_SKIP_PASS1)
    { pg8::Gemm g{OCMP, WA, TOK, DM, 512}; pg8::StaticOrder S; S.init(TOK, DM, G, (int)blockIdx.x);
      pg8::EpiMerge<1> E{GA, nullptr};
      pg8::gemm_phase<pg8::EpiMerge<1>, pg8::StaticOrder, true, true>(ldsl, g, S, E); }
    if (DBG_STOP == 8) { GRID_SYNC(); DUMP_LOOP(bf2f(GA[i_])); }
    if (DBG_STOP == 9) GRID_SYNC();
#endif
#if !defined(DBG_SKIP_PASS2)
    { pg8::Gemm g{OB, WB, TOK, DM, 512}; pg8::StaticOrder S; S.init(TOK, DM, G, (int)blockIdx.x);
      pg8::EpiMerge<2> E{GA, GB};
      pg8::gemm_phase<pg8::EpiMerge<2>, pg8::StaticOrder, true, true>(ldsl, g, S, E); }
#endif
    GRID_SYNC();
    if (DBG_STOP == 6) DUMP_LOOP(bf2f(GA[i_]));
    { pg8::Gemm g{GA, WOUT, TOK, DM, DM}; pg8::StaticOrder S; S.init(TOK, DM, G, (int)blockIdx.x);
#if defined(DBG_NOFFN1)
      pg8::EpiResid E{x, H, XB, SSQ2, 1.0f};
#else
      pg8::EpiResid E{H, H, XB, SSQ2, 1.0f};
#endif
      pg8::gemm_phase<pg8::EpiResid, pg8::StaticOrder, true, true>(ldsl, g, S, E); }
    GRID_SYNC();
    if (DBG_STOP == 7) return;
    { pg8::Gemm g{XB, W2GU, TOK, 2 * DFF, DM}; pg8::StaticOrder S; S.init(TOK, 2 * DFF, G, (int)blockIdx.x);
      pg8::EpiSwiglu E{ACT, SSQ2};
      pg8::gemm_phase<pg8::EpiSwiglu, pg8::StaticOrder, true, true>(ldsl, g, S, E); }
    GRID_SYNC();
    if (G == 256) {
        pg8::Gemm g{ACT, W2D, TOK, DM, DFF}; pg8::StaticOrder S; S.init(TOK, DM, G, (int)blockIdx.x);
        pg8::EpiFinal E{H, H, SSQ3, args.in[22], (unsigned*)(ws + WS_BAR) + 3520, 0.5f};
        pg8::gemm_phase<pg8::EpiFinal, pg8::StaticOrder, true, true>(ldsl, g, S, E);
    } else {
        { pg8::Gemm g{ACT, W2D, TOK, DM, DFF}; pg8::StaticOrder S; S.init(TOK, DM, G, (int)blockIdx.x);
          pg8::EpiResid E{H, H, nullptr, SSQ3, 0.5f};
          pg8::gemm_phase<pg8::EpiResid, pg8::StaticOrder, true, true>(ldsl, g, S, E); }
        GRID_SYNC();
        const float* gf = args.in[22];
        for (int mrow = gw; mrow < TOK; mrow += NGW) {
            const float rs = pg8::rstd_of(SSQ3, mrow);
            f32x4* hr = (f32x4*)(H + (size_t)mrow * DM) + lane; const f32x4* gr = (const f32x4*)gf + lane;
#pragma unroll
            for (int j = 0; j < 4; ++j) { const f32x4 v = hr[64 * j], gg = gr[64 * j]; hr[64 * j] = v * rs * gg; }
        }
    }
}

extern "C" void kernel_launch(void* const* d_in, const int* in_sizes, int n_in, void* d_out, int out_size, void* d_ws, size_t ws_size, hipStream_t stream) {
    static int grid = 0;
    if (grid == 0) {
        int dev = 0, cus = 0, per_cu = 0;
        hipGetDevice(&dev);
        hipDeviceGetAttribute(&cus, hipDeviceAttributeMultiprocessorCount, dev);
        hipFuncSetAttribute((const void*)nsa_fwd, hipFuncAttributeMaxDynamicSharedMemorySize, LDS_BYTES);
        hipOccupancyMaxActiveBlocksPerMultiprocessor(&per_cu, (const void*)nsa_fwd, NWAVES * 64, LDS_BYTES);
        (void)hipGetLastError();
        if (per_cu < 1) per_cu = 1;
        grid = cus;
        if (n_in != 23 || ws_size < WS_END) { fprintf(stderr, "kernel_launch: unexpected n_in %d / ws %zu\n", n_in, ws_size); }
    }
    if (hipMemsetAsync((char*)d_ws + WS_BAR, 0, BAR_BYTES, stream) != hipSuccess) fprintf(stderr, "kernel_launch: memset of barrier words failed\n");
    Args a{};
    for (int i = 0; i < 23; ++i) a.in[i] = (const float*)d_in[i];
    a.out = (float*)d_out; a.ws = (unsigned char*)d_ws;
#ifndef REP4
#define REP4 1
#endif
#ifndef REP5
#define REP5 1
#endif
#ifndef REP6
#define REP6 1
#endif
#ifndef REPG
#define REPG 0
#endif
    a.rep[0] = REP4; a.rep[1] = REP5; a.rep[2] = REP6; a.rep[3] = REPG;
    void* kargs[] = {&a};
    hipError_t e = hipLaunchCooperativeKernel((const void*)nsa_fwd, dim3(grid), dim3(NWAVES * 64), kargs, LDS_BYTES, stream);
    if (e != hipSuccess) fprintf(stderr, "cooperative launch failed: %s (grid %d)\n", hipGetErrorString(e), grid);
}
```

```cpp
#include <hip/hip_runtime.h>
#include <hip/hip_cooperative_groups.h>
#include <cstdio>
#include <cstdint>
namespace cg = cooperative_groups;

constexpr int SEQ = 8192, NB = 2, TOK = NB * SEQ, DM = 1024, DFF = 2816;
constexpr float RMS_EPS = 1e-6f;
constexpr float LOG2E = 1.4426950408889634f;
constexpr float C2 = 0.125f * 1.4426950408889634f;
namespace pg8 {
#define PG8_LAS __attribute__((address_space(3)))
typedef unsigned short bf16_t;
typedef short bf16x8 __attribute__((ext_vector_type(8)));
typedef float f32x4 __attribute__((ext_vector_type(4)));
typedef unsigned u32x4 __attribute__((ext_vector_type(4)));
constexpr int BM = 256, BK = 64, HALF = 128, HTB = HALF * BK * 2  , STAGE_BYTES = 8 * HTB, NXCD = 8, WGM = 8;

__host__ __device__ __forceinline__ int lds_byte(int r, int c) { const int st = (r >> 4) * 2 + (c >> 5), rr = r & 15, cc = c & 31, ob = rr * 64 + cc * 2; return st * 1024 + (ob ^ (((ob >> 9) & 1) << 5)); }
__host__ __device__ __forceinline__ void stage_rc(int b, int& R, int& C) { const int st = b / 1024, sb = b % 1024, swz = sb ^ (((sb >> 9) & 1) << 5); R = (st >> 1) * 16 + swz / 64; C = (st & 1) * 32 + (swz % 64) / 2; }
__host__ __device__ __forceinline__ int perm32(int rho) { const int n = rho >> 4, i = rho & 15; return 8 * (i >> 2) + 4 * n + (i & 3); }

struct Unit { int pm, pn; };
struct Gemm { const bf16_t* A; const bf16_t* Bt; int M, N, K; };

struct StaticOrder {
    int nM, nN, nwg, G, c;
    __host__ __device__ void init(int M, int N, int G_, int c_) { nM = M / BM; nN = N / BM; nwg = nM * nN; G = G_; c = c_; }
    __host__ __device__ bool next(int i, Unit& u) const {
        const long L = (long)i * G + c; if (L >= nwg) return false;
        int wgid = (int)L; { const int q = nwg / NXCD, r = nwg % NXCD, xcd = wgid % NXCD, off = wgid / NXCD; wgid = (xcd < r ? xcd * (q + 1) : r * (q + 1) + (xcd - r) * q) + off; }
        const int nig = WGM * nN, gid = wgid / nig, fm = gid * WGM, gsz = (nM - fm) < WGM ? (nM - fm) : WGM;
        u.pm = fm + ((wgid % nig) % gsz); u.pn = (wgid % nig) / gsz; return true;
    }
    __device__ __forceinline__ void a_ready(const Unit&) const {}
    __device__ __forceinline__ void done(const Unit&) const {}
};

typedef __bf16 bf16x2n __attribute__((ext_vector_type(2)));
typedef float f32x2n __attribute__((ext_vector_type(2)));
__device__ __forceinline__ unsigned cvt_pk_bf16(float lo, float hi) { const f32x2n v = {lo, hi}; return __builtin_bit_cast(unsigned, __builtin_convertvector(v, bf16x2n)); }
typedef float f32x2 __attribute__((ext_vector_type(2)));
__device__ __forceinline__ float fast_rcp(float x) { return __builtin_amdgcn_rcpf(x); }
__device__ __forceinline__ float fast_exp2(float x) { return __builtin_amdgcn_exp2f(x); }
__device__ __forceinline__ float sigmoidf_(float x) { return fast_rcp(1.0f + fast_exp2(-x * 1.4426950408889634f)); }
__device__ __forceinline__ float bf2f(unsigned short b) { return __uint_as_float(((unsigned)b) << 16); }
__device__ __forceinline__ u32x4 pack8(f32x4 a, f32x4 b) { u32x4 w; w.x = cvt_pk_bf16(a[0], a[1]); w.y = cvt_pk_bf16(a[2], a[3]); w.z = cvt_pk_bf16(b[0], b[1]); w.w = cvt_pk_bf16(b[2], b[3]); return w; }
__device__ __forceinline__ float rstd_of(const float* ssq, int row) {
    const f32x4* p = (const f32x4*)(ssq + (size_t)row * 16); const f32x4 a = p[0], b = p[1], c = p[2], d = p[3];
    const float s = (((a[0] + a[1]) + (a[2] + a[3])) + ((b[0] + b[1]) + (b[2] + b[3]))) + (((c[0] + c[1]) + (c[2] + c[3])) + ((d[0] + d[1]) + (d[2] + d[3])));
    return 1.0f / sqrtf(s * (1.0f / 1024.0f) + 1e-6f); }

template <bool NT> __device__ __forceinline__ float rstd_row(const float* ssq, int row) {
    const f32x4* p = (const f32x4*)(ssq + (size_t)row * 16);
    const f32x4 a = NT ? __builtin_nontemporal_load(p) : p[0], b = NT ? __builtin_nontemporal_load(p + 1) : p[1], c = NT ? __builtin_nontemporal_load(p + 2) : p[2], d = NT ? __builtin_nontemporal_load(p + 3) : p[3];
    const float s = (((a[0] + a[1]) + (a[2] + a[3])) + ((b[0] + b[1]) + (b[2] + b[3]))) + (((c[0] + c[1]) + (c[2] + c[3])) + ((d[0] + d[1]) + (d[2] + d[3])));
    return 1.0f / sqrtf(s * (1.0f / 1024.0f) + 1e-6f); }
template <bool NT> __device__ __forceinline__ void wave_rstd8(const float* ssq, int rowbase, float (&rs)[2][4]) {
    const int lane = threadIdx.x & 63;
    const float v0 = rstd_row<NT>(ssq, rowbase + lane), v1 = rstd_row<NT>(ssq, rowbase + HALF + lane);
#pragma unroll
    for (int m = 0; m < 4; ++m) { rs[0][m] = __shfl(v0, m * 16 + (lane & 15)); rs[1][m] = __shfl(v1, m * 16 + (lane & 15)); }
}

struct EpiSwiglu {
    static constexpr bool PERM = true, AFTER_DRAIN = false;
    bf16_t* O; const float* ssq;
    __device__ __forceinline__ void operator()(const f32x4 (&acc)[2][2][4][2], const Unit& u, int wr, int wc, int fr, int fq) const {
        asm volatile("" : "+v"(fr), "+v"(fq));
        const int row0 = u.pm * BM + wr * 64 + fr, col0 = u.pn * 128 + wc * 32 + 8 * fq;
        float rsv[2][4]; wave_rstd8<false>(ssq, u.pm * BM + wr * 64, rsv);
#pragma unroll
        for (int ai = 0; ai < 2; ++ai)
#pragma unroll
            for (int m = 0; m < 4; ++m) {
                const int row = row0 + ai * HALF + m * 16; const float rs = rsv[ai][m];
                f32x4 o[2];
#pragma unroll
                for (int n = 0; n < 2; ++n) {
                    const f32x4 g = acc[ai][0][m][n] * rs, up = acc[ai][1][m][n] * rs;
#pragma unroll
                    for (int j = 0; j < 4; ++j) o[n][j] = g[j] * sigmoidf_(g[j]) * up[j];
                }
                *(u32x4*)(O + (size_t)row * 2816 + col0) = pack8(o[0], o[1]);
            }
    }
};

struct EpiResid {
    static constexpr bool PERM = true, AFTER_DRAIN = false;
    const float* base; float* out; bf16_t* xb; float* ssq; float scale;
    __device__ __forceinline__ void operator()(const f32x4 (&acc)[2][2][4][2], const Unit& u, int wr, int wc, int fr, int fq) const {
        asm volatile("" : "+v"(fr), "+v"(fq));
        const int row0 = u.pm * BM + wr * 64 + fr, col0 = u.pn * BM + wc * 32 + 8 * fq;
        f32x4 nb[2][2];
#pragma unroll
        for (int bj = 0; bj < 2; ++bj) { const size_t off = (size_t)row0 * 1024 + col0 + bj * HALF; nb[bj][0] = *(const f32x4*)(base + off); nb[bj][1] = *(const f32x4*)(base + off + 4); }
#pragma unroll
        for (int it = 0; it < 8; ++it) {
            const int ai = it >> 2, m = it & 3;
            const int row = row0 + ai * HALF + m * 16; float s = 0.f;
            f32x4 cb[2][2];
#pragma unroll
            for (int bj = 0; bj < 2; ++bj) { cb[bj][0] = nb[bj][0]; cb[bj][1] = nb[bj][1]; }
            if (it < 7) { const int rown = row0 + ((it + 1) >> 2) * HALF + ((it + 1) & 3) * 16;
#pragma unroll
                for (int bj = 0; bj < 2; ++bj) { const size_t off = (size_t)rown * 1024 + col0 + bj * HALF; nb[bj][0] = *(const f32x4*)(base + off); nb[bj][1] = *(const f32x4*)(base + off + 4); } }
#pragma unroll
            for (int bj = 0; bj < 2; ++bj) {
                const size_t off = (size_t)row * 1024 + col0 + bj * HALF;
                const f32x4 h0 = cb[bj][0] + acc[ai][bj][m][0] * scale, h1 = cb[bj][1] + acc[ai][bj][m][1] * scale;
                *(f32x4*)(out + off) = h0; *(f32x4*)(out + off + 4) = h1;
                if (xb) *(u32x4*)(xb + off) = pack8(h0, h1);
                s += (h0[0] * h0[0] + h0[1] * h0[1]) + (h0[2] * h0[2] + h0[3] * h0[3]) + (h1[0] * h1[0] + h1[1] * h1[1]) + (h1[2] * h1[2] + h1[3] * h1[3]);
            }
            s += __shfl_xor(s, 16); s += __shfl_xor(s, 32);
            if (fq == 0) ssq[(size_t)row * 16 + u.pn * 4 + wc] = s;
            asm volatile("" ::: "memory");
        }
    }
};

template <int PASS> struct EpiMerge {
    static constexpr bool PERM = true, AFTER_DRAIN = false;
    bf16_t* G; const bf16_t* G2;
    __device__ __forceinline__ void operator()(const f32x4 (&acc)[2][2][4][2], const Unit& u, int wr, int wc, int fr, int fq) const {
        asm volatile("" : "+v"(fr), "+v"(fq));
        const int row0 = u.pm * BM + wr * 64 + fr, col0 = u.pn * BM + wc * 32 + 8 * fq;
        unsigned ng[2][4]; u32x4 ng2[2];
#define EPM_LOAD(rw) do { _Pragma("unroll") for (int bj = 0; bj < 2; ++bj) { const size_t off_ = (size_t)(rw) * 1024 + col0 + bj * HALF; unsigned* gp_ = (unsigned*)(G + off_); \
            _Pragma("unroll") for (int q = 0; q < 4; ++q) ng[bj][q] = __hip_atomic_load(gp_ + q, __ATOMIC_RELAXED, __HIP_MEMORY_SCOPE_AGENT); \
            if (PASS == 2) ng2[bj] = *(const u32x4*)(G2 + off_); } } while (0)
        EPM_LOAD(row0);
#pragma unroll
        for (int it = 0; it < 8; ++it) {
            const int ai = it >> 2, m = it & 3;
            const int row = row0 + ai * HALF + m * 16;
            unsigned gw[2][4]; u32x4 g2[2];
#pragma unroll
            for (int bj = 0; bj < 2; ++bj) { g2[bj] = ng2[bj];
#pragma unroll
                for (int q = 0; q < 4; ++q) gw[bj][q] = ng[bj][q]; }
            if (it < 7) { const int rown = row0 + ((it + 1) >> 2) * HALF + ((it + 1) & 3) * 16; EPM_LOAD(rown); }
#pragma unroll
            for (int bj = 0; bj < 2; ++bj) {
                const size_t off = (size_t)row * 1024 + col0 + bj * HALF;
                f32x4 r0, r1;
#pragma unroll
                for (int q = 0; q < 2; ++q) {
                    const float glo = __uint_as_float(gw[bj][q] << 16), ghi = __uint_as_float(gw[bj][q] & 0xffff0000u), hlo = __uint_as_float(gw[bj][2 + q] << 16), hhi = __uint_as_float(gw[bj][2 + q] & 0xffff0000u);
                    if (PASS == 1) { r0[2 * q] = glo * acc[ai][bj][m][0][2 * q]; r0[2 * q + 1] = ghi * acc[ai][bj][m][0][2 * q + 1]; r1[2 * q] = hlo * acc[ai][bj][m][1][2 * q]; r1[2 * q + 1] = hhi * acc[ai][bj][m][1][2 * q + 1]; }
                    else { const unsigned a_ = g2[bj][q], b_ = g2[bj][2 + q];
                        r0[2 * q] = glo + __uint_as_float(a_ << 16) * acc[ai][bj][m][0][2 * q]; r0[2 * q + 1] = ghi + __uint_as_float(a_ & 0xffff0000u) * acc[ai][bj][m][0][2 * q + 1];
                        r1[2 * q] = hlo + __uint_as_float(b_ << 16) * acc[ai][bj][m][1][2 * q]; r1[2 * q + 1] = hhi + __uint_as_float(b_ & 0xffff0000u) * acc[ai][bj][m][1][2 * q + 1]; }
                }
                *(u32x4*)(G + off) = pack8(r0, r1);
            }
            asm volatile("" ::: "memory");
        }
#undef EPM_LOAD
    }
};

__device__ __forceinline__ void rope8(f32x4& v0, f32x4& v1, const f32x4 c, const f32x4 s) {
    f32x4 a, b;
    a[0] = v0[0] * c[0] - v0[1] * s[0]; a[1] = v0[1] * c[0] + v0[0] * s[0];
    a[2] = v0[2] * c[1] - v0[3] * s[1]; a[3] = v0[3] * c[1] + v0[2] * s[1];
    b[0] = v1[0] * c[2] - v1[1] * s[2]; b[1] = v1[1] * c[2] + v1[0] * s[2];
    b[2] = v1[2] * c[3] - v1[3] * s[3]; b[3] = v1[3] * c[3] + v1[2] * s[3];
    v0 = a; v1 = b;
}
__device__ __forceinline__ void store_t8(bf16_t* p, size_t stride, f32x4 v0, f32x4 v1) {
    const u32x4 w = pack8(v0, v1);
    p[0] = (bf16_t)(w.x & 0xffffu); p[stride] = (bf16_t)(w.x >> 16); p[2 * stride] = (bf16_t)(w.y & 0xffffu); p[3 * stride] = (bf16_t)(w.y >> 16);
    p[4 * stride] = (bf16_t)(w.z & 0xffffu); p[5 * stride] = (bf16_t)(w.z >> 16); p[6 * stride] = (bf16_t)(w.w & 0xffffu); p[7 * stride] = (bf16_t)(w.w >> 16);
}

struct EpiProj {
    static constexpr bool PERM = true, AFTER_DRAIN = false;
    const float* ssq; const float* ropeC; const float* ropeS;
    bf16_t *NQ, *KC, *VC, *KSL, *VSLT, *KWN, *VWNT, *SQ, *SK, *SVT, *GA, *GB; float* NG;
    __device__ __forceinline__ void operator()(const f32x4 (&acc)[2][2][4][2], const Unit& u, int wr, int wc, int fr, int fq) const {
        asm volatile("" : "+v"(fr), "+v"(fq));
        const int pn = u.pn;
        const int row0 = u.pm * BM + wr * 64 + fr;
        const int cw0 = wc * 32 + 8 * fq;
        float rsv[2][4]; wave_rstd8<false>(ssq, u.pm * BM + wr * 64, rsv);
        const bool need_rope = pn < 2 || (pn >= 3 && pn <= 6) || pn == 15;
        f32x4 ncs = {0.f, 0.f, 0.f, 0.f}, nsn = {0.f, 0.f, 0.f, 0.f};
        if (need_rope) { ncs = *(const f32x4*)(ropeC + (size_t)row0 * 32 + ((cw0 & 63) >> 1)); nsn = *(const f32x4*)(ropeS + (size_t)row0 * 32 + ((cw0 & 63) >> 1)); }
#pragma unroll
        for (int ai = 0; ai < 2; ++ai)
#pragma unroll
            for (int m = 0; m < 4; ++m) {
                const int row = row0 + ai * HALF + m * 16; const float rs = rsv[ai][m];
                const int b = row >> 13, s = row & 8191;
                const f32x4 cs = ncs, sn = nsn;
                if (need_rope && (ai * 4 + m) < 7) { const int rown = row0 + ((ai * 4 + m + 1) >> 2) * HALF + ((ai * 4 + m + 1) & 3) * 16;
                    ncs = *(const f32x4*)(ropeC + (size_t)rown * 32 + ((cw0 & 63) >> 1)); nsn = *(const f32x4*)(ropeS + (size_t)rown * 32 + ((cw0 & 63) >> 1)); }
#pragma unroll
                for (int bj = 0; bj < 2; ++bj) {
                    f32x4 v0 = acc[ai][bj][m][0] * rs, v1 = acc[ai][bj][m][1] * rs;
                    const int cw = bj * HALF + cw0;
                    if (pn < 2) { rope8(v0, v1, cs, sn); *(u32x4*)(NQ + (size_t)row * 512 + pn * 256 + cw) = pack8(v0, v1); }
                    else if (pn == 2) { bf16_t* dst = bj == 0 ? KC : VC; const int g = cw0 >> 6, d = cw0 & 63;
                        *(u32x4*)(dst + ((size_t)(b * 2 + g) * SEQ + s) * 64 + d) = pack8(v0, v1); }
                    else if (pn <= 4) { const int g = cw0 >> 6, d = cw0 & 63;
                        if (bj == 0) { rope8(v0, v1, cs, sn); bf16_t* dst = pn == 3 ? KSL : KWN; *(u32x4*)(dst + ((size_t)(b * 2 + g) * SEQ + s) * 64 + d) = pack8(v0, v1); }
                        else { bf16_t* dst = pn == 3 ? VSLT : VWNT; store_t8(dst + ((size_t)(b * 2 + g) * 64 + d) * SEQ + s, SEQ, v0, v1); } }
                    else if (pn <= 6) { rope8(v0, v1, cs, sn);
                        const u32x4 w = pack8(v0, v1); unsigned long long* qp = (unsigned long long*)(SQ + (size_t)row * 512 + (pn - 5) * 256 + cw);
                        __hip_atomic_store(qp, (unsigned long long)w.x | ((unsigned long long)w.y << 32), __ATOMIC_RELAXED, __HIP_MEMORY_SCOPE_AGENT);
                        __hip_atomic_store(qp + 1, (unsigned long long)w.z | ((unsigned long long)w.w << 32), __ATOMIC_RELAXED, __HIP_MEMORY_SCOPE_AGENT); }
                    else if (pn <= 14) { bf16_t* dst = pn <= 10 ? GA : GB; const int c = ((pn - 7) & 3) * 256 + cw;
#pragma unroll
                        for (int j = 0; j < 4; ++j) { v0[j] = sigmoidf_(v0[j]); v1[j] = sigmoidf_(v1[j]); }
                        *(u32x4*)(dst + (size_t)row * 1024 + c) = pack8(v0, v1); }
                    else {
                        if (bj == 0) {
                            if (cw0 < 64) { rope8(v0, v1, cs, sn); *(u32x4*)(SK + (size_t)row * 64 + cw0) = pack8(v0, v1); }
                            else store_t8(SVT + ((size_t)b * 64 + (cw0 - 64)) * SEQ + s, SEQ, v0, v1);
                        } else if (cw0 < 24) {
#pragma unroll
                            for (int j = 0; j < 4; ++j) { v0[j] = sigmoidf_(v0[j]); v1[j] = sigmoidf_(v1[j]); }
                            *(f32x4*)(NG + (size_t)row * 24 + cw0) = v0; *(f32x4*)(NG + (size_t)row * 24 + cw0 + 4) = v1;
                        }
                    }
                    asm volatile("" ::: "memory");
                }
            }
    }
};

struct EpiDry {
    static constexpr bool PERM = true, AFTER_DRAIN = false;
    float* sink; int flag;
    __device__ __forceinline__ void operator()(const f32x4 (&acc)[2][2][4][2], const Unit& u, int wr, int wc, int fr, int fq) const {
        if (flag) { f32x4 s = {0.f, 0.f, 0.f, 0.f};
#pragma unroll
            for (int ai = 0; ai < 2; ++ai)
#pragma unroll
                for (int bj = 0; bj < 2; ++bj)
#pragma unroll
                    for (int m = 0; m < 4; ++m) s += acc[ai][bj][m][0] + acc[ai][bj][m][1];
            *(f32x4*)(sink + (size_t)(u.pm * 4 + u.pn) * 4) = s; }
    }
};

struct EpiFinal {
    static constexpr bool PERM = true, AFTER_DRAIN = false;
    const float* base; float* out; float* ssq; const float* gain; unsigned* cnt; float scale;
    __device__ __forceinline__ void operator()(f32x4 (&acc)[2][2][4][2], const Unit& u, int wr, int wc, int fr, int fq) const {
        asm volatile("" : "+v"(fr), "+v"(fq));
        const int row0 = u.pm * BM + wr * 64 + fr, col0 = u.pn * BM + wc * 32 + 8 * fq;
        f32x4 nb[2][2];
#pragma unroll
        for (int bj = 0; bj < 2; ++bj) { const size_t off = (size_t)row0 * 1024 + col0 + bj * HALF; nb[bj][0] = *(const f32x4*)(base + off); nb[bj][1] = *(const f32x4*)(base + off + 4); }
#pragma unroll
        for (int it = 0; it < 8; ++it) {
            const int ai = it >> 2, m = it & 3;
            const int row = row0 + ai * HALF + m * 16; float s = 0.f;
            f32x4 cb[2][2];
#pragma unroll
            for (int bj = 0; bj < 2; ++bj) { cb[bj][0] = nb[bj][0]; cb[bj][1] = nb[bj][1]; }
            if (it < 7) { const int rown = row0 + ((it + 1) >> 2) * HALF + ((it + 1) & 3) * 16;
#pragma unroll
                for (int bj = 0; bj < 2; ++bj) { const size_t off = (size_t)rown * 1024 + col0 + bj * HALF; nb[bj][0] = *(const f32x4*)(base + off); nb[bj][1] = *(const f32x4*)(base + off + 4); } }
#pragma unroll
            for (int bj = 0; bj < 2; ++bj) {
                const f32x4 h0 = cb[bj][0] + acc[ai][bj][m][0] * scale, h1 = cb[bj][1] + acc[ai][bj][m][1] * scale;
                acc[ai][bj][m][0] = h0; acc[ai][bj][m][1] = h1;
                s += (h0[0] * h0[0] + h0[1] * h0[1]) + (h0[2] * h0[2] + h0[3] * h0[3]) + (h1[0] * h1[0] + h1[1] * h1[1]) + (h1[2] * h1[2] + h1[3] * h1[3]);
            }
            s += __shfl_xor(s, 16); s += __shfl_xor(s, 32);
            if (fq == 0) __hip_atomic_store(ssq + (size_t)row * 16 + u.pn * 4 + wc, s, __ATOMIC_RELAXED, __HIP_MEMORY_SCOPE_AGENT);
            asm volatile("" ::: "memory");
        }
        f32x4 gv[2][2];
#pragma unroll
        for (int bj = 0; bj < 2; ++bj) { gv[bj][0] = *(const f32x4*)(gain + col0 + bj * HALF); gv[bj][1] = *(const f32x4*)(gain + col0 + bj * HALF + 4); }
        asm volatile("s_waitcnt vmcnt(0)" ::: "memory");
        __syncthreads();
        if (threadIdx.x == 0) {
            __hip_atomic_fetch_add(cnt + u.pm, 1u, __ATOMIC_RELAXED, __HIP_MEMORY_SCOPE_AGENT);
            while (__hip_atomic_load(cnt + u.pm, __ATOMIC_RELAXED, __HIP_MEMORY_SCOPE_AGENT) < 4u) __builtin_amdgcn_s_sleep(1);
        }
        __syncthreads();
        float rsv[2][4]; wave_rstd8<true>(ssq, u.pm * BM + wr * 64, rsv);
#pragma unroll
        for (int ai = 0; ai < 2; ++ai)
#pragma unroll
            for (int m = 0; m < 4; ++m) {
                const int row = row0 + ai * HALF + m * 16; const float rs = rsv[ai][m];
#pragma unroll
                for (int bj = 0; bj < 2; ++bj) {
                    const size_t off = (size_t)row * 1024 + col0 + bj * HALF;
                    *(f32x4*)(out + off) = acc[ai][bj][m][0] * rs * gv[bj][0]; *(f32x4*)(out + off + 4) = acc[ai][bj][m][1] * rs * gv[bj][1];
                }
            }
    }
};
template <class Epi, class Sched, bool ALIGN_EPI = false, bool SP2 = false>
__device__ __forceinline__ void gemm_phase(PG8_LAS unsigned char* lds, const Gemm g, const Sched& S, const Epi& E) {
    const int tid = threadIdx.x, wid = __builtin_amdgcn_readfirstlane(tid >> 6), lane = tid & 63, wr = wid >> 2, wc = wid & 3, fr = lane & 15, fq = lane >> 4;
    const int K = g.K, nt = K / BK;
    unsigned voffA[2], voffB[2];
#pragma unroll
    for (int i = 0; i < 2; ++i) { int R, C; stage_rc(tid * 16 + i * 8192, R, C); const int Rb = Epi::PERM ? ((R & ~31) + perm32(R & 31)) : R;
        voffA[i] = (unsigned)(R * K + C) * 2u; voffB[i] = (unsigned)(Rb * K + C) * 2u; }
    const size_t kstep = (size_t)(BK * 2);
    const size_t hstep = (size_t)HALF * K * 2;
    const size_t tstep = 2 * hstep;
    const unsigned ldsw = (unsigned)wid * 1024u;
    const int aoff = lds_byte(wr * 64 + fr, fq * 8), boff = lds_byte(wc * 32 + fr, fq * 8);
#define PG8_SA(b, h) (((b) * 2 + (h)) * HTB)
#define PG8_SB(b, h) ((4 + (b) * 2 + (h)) * HTB)
#define PG8_STAGE(bufoff, gbase, voff) do { _Pragma("unroll") for (int _i = 0; _i < 2; ++_i) \
        __builtin_amdgcn_global_load_lds((const unsigned*)((const char*)(gbase) + (voff)[_i]), (PG8_LAS unsigned*)(lds + (bufoff) + ldsw + _i * 8192), 16, 0, 0); } while (0)
#define PG8_LDA(dst, b, h) do { _Pragma("unroll") for (int m = 0; m < 4; ++m) _Pragma("unroll") for (int k = 0; k < 2; ++k) dst[m][k] = *(const PG8_LAS bf16x8*)(lds + PG8_SA(b, h) + aoff + m * 2048 + k * 1024); } while (0)
#define PG8_LDB(dst, b, h) do { _Pragma("unroll") for (int n = 0; n < 2; ++n) _Pragma("unroll") for (int k = 0; k < 2; ++k) dst[n][k] = *(const PG8_LAS bf16x8*)(lds + PG8_SB(b, h) + boff + n * 2048 + k * 1024); } while (0)
#define PG8_MMA(ai, bj, At, Bt) do { __builtin_amdgcn_s_setprio(1); _Pragma("unroll") for (int m = 0; m < 4; ++m) _Pragma("unroll") for (int n = 0; n < 2; ++n) _Pragma("unroll") for (int k = 0; k < 2; ++k) \
        acc[ai][bj][m][n] = __builtin_amdgcn_mfma_f32_16x16x32_bf16(Bt[n][k], At[m][k], acc[ai][bj][m][n], 0, 0, 0); __builtin_amdgcn_s_setprio(0); } while (0)
#define PG8_WAIT_V(n) asm volatile("s_waitcnt vmcnt(" #n ")" ::: "memory")
#define PG8_WAIT_L(n) asm volatile("s_waitcnt lgkmcnt(" #n ")" ::: "memory")
#define PG8_BAR __builtin_amdgcn_s_barrier()
#define PG8_SCHED __builtin_amdgcn_sched_barrier(0)
    Unit cur, nxt; int ui = 0;
    if (!S.next(0, cur)) return;
    f32x4 acc[2][2][4][2];
#pragma unroll
    for (int a = 0; a < 2; ++a)
#pragma unroll
        for (int b = 0; b < 2; ++b)
#pragma unroll
            for (int m = 0; m < 4; ++m)
#pragma unroll
                for (int n = 0; n < 2; ++n) acc[a][b][m][n] = (f32x4){0.f, 0.f, 0.f, 0.f};
    bf16x8 At[4][2], B0[2][2], B1[2][2];
    const char* cA = (const char*)g.A + (size_t)cur.pm * tstep; const char* cB = (const char*)g.Bt + (size_t)cur.pn * tstep;
    S.a_ready(cur);
    if constexpr (SP2) {
        PG8_STAGE(PG8_SB(0, 0), cB, voffB); PG8_STAGE(PG8_SB(0, 1), cB + hstep, voffB); PG8_STAGE(PG8_SA(0, 0), cA, voffA); PG8_STAGE(PG8_SA(0, 1), cA + hstep, voffA);
        if (wr == 1) PG8_BAR;
        PG8_WAIT_V(2); PG8_BAR;
        PG8_STAGE(PG8_SB(1, 0), cB + kstep, voffB); PG8_STAGE(PG8_SA(1, 0), cA + kstep, voffA); PG8_STAGE(PG8_SB(1, 1), cB + hstep + kstep, voffB);
        PG8_WAIT_V(6); PG8_BAR;
    } else {
        PG8_STAGE(PG8_SB(0, 0), cB, voffB); PG8_STAGE(PG8_SA(0, 0), cA, voffA); PG8_STAGE(PG8_SB(0, 1), cB + hstep, voffB); PG8_STAGE(PG8_SA(0, 1), cA + hstep, voffA);
        if (wr == 1) PG8_BAR;
        PG8_WAIT_V(4); PG8_BAR;
        PG8_STAGE(PG8_SB(1, 0), cB + kstep, voffB); PG8_STAGE(PG8_SA(1, 0), cA + kstep, voffA); PG8_STAGE(PG8_SB(1, 1), cB + hstep + kstep, voffB);
        PG8_WAIT_V(6); PG8_BAR;
    }
    for (;;) {
        const bool has_next = S.next(ui + 1, nxt);
        const char* nA = has_next ? (const char*)g.A + (size_t)nxt.pm * tstep : cA; const char* nB = has_next ? (const char*)g.Bt + (size_t)nxt.pn * tstep : cB;
        for (int t = 0; t < nt; t += 2) {
            const bool last = (t == nt - 2);
            const char* a1 = cA + (size_t)(t + 1) * kstep;
            const char* a2 = last ? nA : cA + (size_t)(t + 2) * kstep; const char* b2 = last ? nB : cB + (size_t)(t + 2) * kstep;
            const char* a3 = a2 + kstep; const char* b3 = b2 + kstep;
            if (last && has_next) S.a_ready(nxt);
            if constexpr (SP2) {
            PG8_LDB(B0, 0, 0); PG8_LDB(B1, 0, 1); PG8_SCHED; PG8_LDA(At, 0, 0); PG8_STAGE(PG8_SA(1, 1), a1 + hstep, voffA);
            PG8_WAIT_V(8); PG8_WAIT_L(0); PG8_BAR; PG8_MMA(0, 0, At, B0); PG8_MMA(0, 1, At, B1); PG8_BAR; PG8_SCHED;
            PG8_LDA(At, 0, 1); PG8_STAGE(PG8_SB(0, 0), b2, voffB); PG8_STAGE(PG8_SB(0, 1), b2 + hstep, voffB); PG8_STAGE(PG8_SA(0, 0), a2, voffA);
            PG8_WAIT_V(8); PG8_WAIT_L(0); PG8_BAR; PG8_MMA(1, 0, At, B0); PG8_MMA(1, 1, At, B1); PG8_BAR; PG8_SCHED;
            PG8_LDB(B0, 1, 0); PG8_LDB(B1, 1, 1); PG8_SCHED; PG8_LDA(At, 1, 0); PG8_STAGE(PG8_SA(0, 1), a2 + hstep, voffA);
            PG8_WAIT_V(8); PG8_WAIT_L(0); PG8_BAR; PG8_MMA(0, 0, At, B0); PG8_MMA(0, 1, At, B1); PG8_BAR; PG8_SCHED;
            PG8_LDA(At, 1, 1); PG8_STAGE(PG8_SB(1, 0), b3, voffB); PG8_STAGE(PG8_SB(1, 1), b3 + hstep, voffB); PG8_STAGE(PG8_SA(1, 0), a3, voffA);
            PG8_WAIT_V(8); PG8_WAIT_L(0); PG8_BAR; PG8_MMA(1, 0, At, B0); PG8_MMA(1, 1, At, B1); PG8_BAR; PG8_SCHED;
            } else {
            PG8_LDB(B0, 0, 0); PG8_SCHED; PG8_LDA(At, 0, 0); PG8_STAGE(PG8_SA(1, 1), a1 + hstep, voffA);
            PG8_WAIT_L(8); PG8_BAR; PG8_WAIT_L(0); PG8_MMA(0, 0, At, B0); PG8_BAR; PG8_SCHED;
            PG8_LDB(B1, 0, 1); PG8_STAGE(PG8_SB(0, 0), b2, voffB);
            PG8_BAR; PG8_WAIT_L(0); PG8_MMA(0, 1, At, B1); PG8_BAR;
            PG8_LDA(At, 0, 1); PG8_STAGE(PG8_SA(0, 0), a2, voffA);
            PG8_BAR; PG8_WAIT_L(0); PG8_MMA(1, 0, At, B0); PG8_BAR; PG8_SCHED;
            PG8_STAGE(PG8_SB(0, 1), b2 + hstep, voffB);
            PG8_WAIT_V(6); PG8_BAR; PG8_MMA(1, 1, At, B1); PG8_BAR;
            PG8_LDB(B0, 1, 0); PG8_SCHED; PG8_LDA(At, 1, 0); PG8_STAGE(PG8_SA(0, 1), a2 + hstep, voffA);
            PG8_WAIT_L(8); PG8_BAR; PG8_WAIT_L(0); PG8_MMA(0, 0, At, B0); PG8_BAR; PG8_SCHED;
            PG8_LDB(B1, 1, 1); PG8_STAGE(PG8_SB(1, 0), b3, voffB);
            PG8_BAR; PG8_WAIT_L(0); PG8_MMA(0, 1, At, B1); PG8_BAR;
            PG8_LDA(At, 1, 1); PG8_STAGE(PG8_SA(1, 0), a3, voffA);
            PG8_BAR; PG8_WAIT_L(0); PG8_MMA(1, 0, At, B0); PG8_BAR; PG8_SCHED;
            PG8_STAGE(PG8_SB(1, 1), b3 + hstep, voffB);
            PG8_WAIT_V(6); PG8_BAR; PG8_MMA(1, 1, At, B1); PG8_BAR;
            }
        }
        if constexpr (ALIGN_EPI) { if (wr == 0) PG8_BAR; }
        if constexpr (!Epi::AFTER_DRAIN) { E(acc, cur, wr, wc, fr, fq); S.done(cur); }
        if (!has_next) break;
#pragma unroll
        for (int a = 0; a < 2; ++a)
#pragma unroll
            for (int b = 0; b < 2; ++b)
#pragma unroll
                for (int m = 0; m < 4; ++m)
#pragma unroll
                    for (int n = 0; n < 2; ++n) acc[a][b][m][n] = (f32x4){0.f, 0.f, 0.f, 0.f};
        cur = nxt; cA = nA; cB = nB; ++ui;
        if constexpr (ALIGN_EPI) { if (wr == 1) PG8_BAR; }
    }
    PG8_WAIT_V(0);
    if constexpr (!ALIGN_EPI) { if (wr == 0) PG8_BAR; }
    PG8_BAR;
    if constexpr (Epi::AFTER_DRAIN) { E.fused(acc, cur, wr, wc, fr, fq, lds, wid, lane); S.done(cur); }
#undef PG8_SA
#undef PG8_SB
#undef PG8_STAGE
#undef PG8_LDA
#undef PG8_LDB
#undef PG8_MMA
#undef PG8_WAIT_V
#undef PG8_WAIT_L
#undef PG8_BAR
#undef PG8_SCHED
}
}

using pg8::bf16_t; using pg8::bf16x8; using pg8::f32x4; using pg8::u32x4; using pg8::cvt_pk_bf16; using pg8::fast_exp2; using pg8::fast_rcp; using pg8::bf2f;
#define LAS __attribute__((address_space(3)))
constexpr int NWAVES = 8;
constexpr int LDS_BYTES = 131072 + 4096 + 1024;
constexpr size_t MiB = 1u << 20;
constexpr size_t WS_SEL = 0, WS_KCMP = 512 * 1024, WS_VCMPT = 768 * 1024;
constexpr size_t WS_W1GU = 1 * MiB, WS_W1D = 12 * MiB, WS_WIN = 18 * MiB, WS_CW1K = 26 * MiB, WS_CW1V = 27 * MiB, WS_CW2K = 28 * MiB, WS_CW2V = 28 * MiB + 65536;
constexpr size_t WS_WA = 29 * MiB, WS_WB = 30 * MiB, WS_WOUT = 31 * MiB, WS_W2GU = 33 * MiB, WS_W2D = 44 * MiB, WS_PEB = 49 * MiB + 512 * 1024;
constexpr size_t WS_BAR = 49 * MiB + 576 * 1024, BAR_BYTES = 16384;
constexpr size_t WS_ROPEC = 50 * MiB, WS_ROPES = 52 * MiB;
constexpr size_t WS_XB = 54 * MiB;
constexpr size_t WS_ACT = 86 * MiB;
constexpr size_t WS_GA = 86 * MiB, WS_GB = 118 * MiB;
constexpr size_t WS_SQ = 174 * MiB, WS_OCMP = 190 * MiB, WS_KC = 206 * MiB, WS_VC = 210 * MiB, WS_KSL = 214 * MiB, WS_VSLT = 218 * MiB, WS_KWN = 222 * MiB, WS_VWNT = 226 * MiB;
constexpr size_t WS_SK = 230 * MiB, WS_SVT = 232 * MiB;
constexpr size_t WS_SSQ0 = 234 * MiB, WS_SSQ1 = 235 * MiB, WS_SSQ2 = 236 * MiB, WS_SSQ3 = 237 * MiB;
constexpr size_t WS_NQ = 238 * MiB, WS_NG = 254 * MiB, WS_END = 255 * MiB + 512 * 1024;

__device__ const float INV_FREQ[32] = {1.f, 0.749894202f, 0.562341332f, 0.421696514f, 0.316227764f, 0.237137377f, 0.177827939f, 0.133352146f, 0.100000001f, 0.0749894232f, 0.0562341325f, 0.0421696492f, 0.0316227749f, 0.0237137377f, 0.0177827943f, 0.013335214f, 0.00999999978f, 0.00749894232f, 0.00562341325f, 0.00421696482f, 0.00316227763f, 0.00237137382f, 0.00177827943f, 0.00133352145f, 0.00100000005f, 0.000749894185f, 0.000562341302f, 0.000421696517f, 0.000316227757f, 0.00023713737f, 0.00017782794f, 0.00013335215f};

struct Args { const float* in[23]; float* out; unsigned char* ws; int rep[4]; };

#define LDS_WAIT() asm volatile("s_waitcnt lgkmcnt(0)" ::: "memory")
#define MFMA16(a, b, c) __builtin_amdgcn_mfma_f32_16x16x32_bf16(a, b, c, 0, 0, 0)

__device__ __forceinline__ float wave_sum(float v) {
#pragma unroll
    for (int o = 1; o < 64; o <<= 1) v += __shfl_xor(v, o);
    return v;
}
__device__ __forceinline__ unsigned f2bf(float f) { unsigned u = __builtin_bit_cast(unsigned, f); return (u + 0x7fffu + ((u >> 16) & 1u)) >> 16; }
__device__ __forceinline__ unsigned pk2(float lo, float hi) { return f2bf(lo) | (f2bf(hi) << 16); }

__device__ __forceinline__ int il_pos(int d) { return d < 32 ? 2 * d : 2 * (d - 32) + 1; }
__device__ __forceinline__ int win_dest(int c) {
    if (c < 512) return (c & ~63) + il_pos(c & 63);
    if (c < 768) return c;
    if (c < 896) return (c & ~63) + il_pos(c & 63);
    if (c < 1024) return c;
    if (c < 1152) return (c & ~63) + il_pos(c & 63);
    if (c < 1280) return c;
    if (c < 1304) return 3968 + (c - 1280);
    if (c < 1816) { const int q = c - 1304; return 1280 + (q & ~63) + il_pos(q & 63); }
    if (c < 1880) return 3840 + il_pos(c - 1816);
    if (c < 1944) return 3904 + (c - 1880);
    if (c < 2968) return 1792 + (c - 1944);
    return 2816 + (c - 2968);
}
__device__ __forceinline__ int dest_row(int mode, int row_off, int n) {
    if (mode == 0) return row_off + n;
    if (mode == 1) return (n >> 7) * 256 + (n & 127) + row_off;
    if (mode == 2) return win_dest(n);
    return il_pos(n);
}
__device__ __forceinline__ void transpose_item(const float* __restrict__ W, int K, int N, bf16_t* WT, int mode, int row_off, const float* __restrict__ gain, LAS float* scr, int item, int lane) {
    const int nblk = (N + 31) / 32, kb = item / nblk, nb = item % nblk, k0 = 64 * kb, n0 = 32 * nb;
    const int c4 = (lane & 7) * 4, nn = n0 + c4;
#pragma unroll
    for (int i = 0; i < 8; ++i) { const int kk = 8 * i + (lane >> 3);
        f32x4 v = nn < N ? *(const f32x4*)(W + (size_t)(k0 + kk) * N + nn) : (f32x4){0.f, 0.f, 0.f, 0.f};
        if (gain) v = v * gain[k0 + kk];
        scr[kk * 33 + c4] = v[0]; scr[kk * 33 + c4 + 1] = v[1]; scr[kk * 33 + c4 + 2] = v[2]; scr[kk * 33 + c4 + 3] = v[3]; }
    LDS_WAIT();
    const int c = lane & 7;
#pragma unroll
    for (int j = 0; j < 4; ++j) { const int nl = (lane >> 3) + 8 * j; const int n = n0 + nl;
        if (n < N) { const LAS float* s = scr + (8 * c) * 33 + nl;
            u32x4 o; o.x = pk2(s[0 * 33], s[1 * 33]); o.y = pk2(s[2 * 33], s[3 * 33]); o.z = pk2(s[4 * 33], s[5 * 33]); o.w = pk2(s[6 * 33], s[7 * 33]);
            *(u32x4*)(WT + (size_t)dest_row(mode, row_off, n) * K + k0 + 8 * c) = o; } }
    LDS_WAIT();
}

__device__ __forceinline__ void qk_pair(const bf16_t* __restrict__ K, int kbase, int lane, const bf16x8 (&qf)[2], f32x4& sA, f32x4& sB) {
    const int i = lane & 15, fq = lane >> 4;
    const bf16_t* pa = K + (size_t)(kbase + 8 * (i >> 2) + (i & 3)) * 64 + 8 * fq;
    const bf16x8 a0 = *(const bf16x8*)pa, a1 = *(const bf16x8*)(pa + 32), b0 = *(const bf16x8*)(pa + 256), b1 = *(const bf16x8*)(pa + 288);
    const f32x4 z = {0.f, 0.f, 0.f, 0.f};
    sA = MFMA16(a0, qf[0], z); sA = MFMA16(a1, qf[1], sA);
    sB = MFMA16(b0, qf[0], z); sB = MFMA16(b1, qf[1], sB);
}
__device__ __forceinline__ void pv_pair(const bf16_t* __restrict__ VT, int ldv, int kbase, int lane, bf16x8 pf, f32x4 (&o)[4]) {
    const int i = lane & 15, fq = lane >> 4;
#pragma unroll
    for (int nt = 0; nt < 4; ++nt) { const bf16x8 a = *(const bf16x8*)(VT + (size_t)(16 * nt + i) * ldv + kbase + 8 * fq); o[nt] = MFMA16(a, pf, o[nt]); }
}
__device__ __forceinline__ float rowmax4(float v) {
    const unsigned u = __float_as_uint(v); const auto r = __builtin_amdgcn_permlane16_swap(u, u, false, false);
    const float a = fmaxf(__uint_as_float(r[0]), __uint_as_float(r[1]));
    const unsigned ua = __float_as_uint(a); const auto r2 = __builtin_amdgcn_permlane32_swap(ua, ua, false, false);
    return fmaxf(__uint_as_float(r2[0]), __uint_as_float(r2[1])); }
__device__ __forceinline__ float rowsum4(float v) {
    const unsigned u = __float_as_uint(v); const auto r = __builtin_amdgcn_permlane16_swap(u, u, false, false);
    const float a = __uint_as_float(r[0]) + __uint_as_float(r[1]);
    const unsigned ua = __float_as_uint(a); const auto r2 = __builtin_amdgcn_permlane32_swap(ua, ua, false, false);
    return __uint_as_float(r2[0]) + __uint_as_float(r2[1]); }
constexpr float NEGBIG = -1e30f;
#define SCORES8(sA, sB, key0, lo, hi, s, v) \
    float s[8]; bool v[8]; \
    _Pragma("unroll") for (int e = 0; e < 8; ++e) { const int key_ = (key0) + e; v[e] = (key_ >= (lo)) && (key_ <= (hi)); const float x_ = (e < 4 ? sA[e & 3] : sB[e & 3]) * C2; s[e] = v[e] ? x_ : NEGBIG; }

__device__ __forceinline__ bf16x8 soft_step(f32x4 sA, f32x4 sB, int key0, int lo, int hi, float& m, float& l, f32x4 (&o)[4]) {
    SCORES8(sA, sB, key0, lo, hi, s, v)
    float mx = fmaxf(fmaxf(fmaxf(s[0], s[1]), fmaxf(s[2], s[3])), fmaxf(fmaxf(s[4], s[5]), fmaxf(s[6], s[7])));
    mx = rowmax4(mx);
    const float mn = fmaxf(m, mx), alpha = fast_exp2(m - mn);
    float p[8], sum = 0.f;
#pragma unroll
    for (int e = 0; e < 8; ++e) { p[e] = v[e] ? fast_exp2(s[e] - mn) : 0.f; sum += p[e]; }
    sum = rowsum4(sum);
    l = l * alpha + sum; m = mn;
#pragma unroll
    for (int nt = 0; nt < 4; ++nt) o[nt] = o[nt] * alpha;
    u32x4 w; w.x = cvt_pk_bf16(p[0], p[1]); w.y = cvt_pk_bf16(p[2], p[3]); w.z = cvt_pk_bf16(p[4], p[5]); w.w = cvt_pk_bf16(p[6], p[7]);
    return __builtin_bit_cast(bf16x8, w);
}

#define RLX_AGENT __ATOMIC_RELAXED, __HIP_MEMORY_SCOPE_AGENT
#define XB_TMO      128
#define XB_XCNT(j)  (256  + 64 * (j))
#define XB_XSUB(j)  (1280 + 64 * (j))
#define XB_XGEN(j)  (2304 + 64 * (j))
#define XB_TOP      3328
#define XB_TOPGEN   3392
#define XCD_BAR_WORDS 3456
#define XB_SPIN_CAP (1u << 18)

__device__ __forceinline__ unsigned xb_ld(unsigned* p)              { return __hip_atomic_load(p, __ATOMIC_RELAXED, __HIP_MEMORY_SCOPE_AGENT); }
__device__ __forceinline__ unsigned xb_add(unsigned* p, unsigned v) { return __hip_atomic_fetch_add(p, v, __ATOMIC_RELAXED, __HIP_MEMORY_SCOPE_AGENT); }
__device__ __forceinline__ unsigned xb_xcc_id() { return (unsigned)__builtin_amdgcn_s_getreg((3 << 11) | 20) & 0xFu; }
#define XB_SPIN(cond, bar) do { unsigned _sp = 0; while (cond) { __builtin_amdgcn_s_sleep(1); \
    if ((++_sp & 255u) == 0u) { if (xb_ld(&(bar)[XB_TMO])) break; if (_sp > XB_SPIN_CAP) { atomicAdd(&(bar)[XB_TMO], 1u); break; } } } } while (0)

struct XcdBarrier {
    unsigned* bar; unsigned x;
    volatile LAS unsigned* st;
};

__device__ __forceinline__ XcdBarrier xcd_barrier_post(unsigned* bar, volatile LAS unsigned* st) {
    XcdBarrier b; b.bar = bar; b.x = xb_xcc_id(); b.st = st;
    if (threadIdx.x == 0) (void)xb_add(&bar[XB_XCNT(b.x)], 1u);
    return b;
}
__device__ __forceinline__ void xcd_barrier_complete(unsigned* bar, unsigned x, unsigned& nloc, unsigned& nx) {
    const unsigned G = gridDim.x * gridDim.y * gridDim.z;
    unsigned sum, cnt, mine, sp = 0u;
    for (;;) {
        sum = 0u; cnt = 0u; mine = 0u;
#pragma unroll
        for (unsigned j = 0; j < 16; ++j) { const unsigned c = xb_ld(&bar[XB_XCNT(j)]); sum += c; cnt += (c > 0u) ? 1u : 0u; mine = (j == x) ? c : mine; }
        if (sum == G) break;
        __builtin_amdgcn_s_sleep(1);
        if ((++sp & 255u) == 0u) { if (xb_ld(&bar[XB_TMO])) break; if (sp > XB_SPIN_CAP) { atomicAdd(&bar[XB_TMO], 1u); break; } }
    }
    nloc = mine > 0u ? mine : 1u; nx = cnt > 0u ? cnt : 1u;
}

__device__ __forceinline__ void xcd_barrier(const XcdBarrier& b) {
    asm volatile("s_waitcnt vmcnt(0)" ::: "memory");
    __syncthreads();
    if (threadIdx.x == 0) {
        unsigned* bar = b.bar;
        __builtin_amdgcn_s_waitcnt(0);
        unsigned nloc = b.st[0], nx = b.st[1];
        if (nloc == 0u) { xcd_barrier_complete(bar, b.x, nloc, nx); b.st[0] = nloc; b.st[1] = nx; }
        const unsigned old = xb_add(&bar[XB_XSUB(b.x)], 1u);
        const unsigned gen = old / nloc;
        if (old + 1u == (gen + 1u) * nloc) {
            __builtin_amdgcn_fence(__ATOMIC_RELEASE, "agent");
            asm volatile("s_waitcnt vmcnt(0)" ::: "memory");
            const unsigned og = xb_add(&bar[XB_TOP], 1u);
            const unsigned tg = og / nx;
            if (og + 1u == (tg + 1u) * nx) xb_add(&bar[XB_TOPGEN], 1u);
            else XB_SPIN(xb_ld(&bar[XB_TOPGEN]) == tg, bar);
            __builtin_amdgcn_fence(__ATOMIC_ACQUIRE, "agent");
            xb_add(&bar[XB_XGEN(b.x)], 1u);
            asm volatile("s_waitcnt vmcnt(0)" ::: "memory");
        } else {
            XB_SPIN(xb_ld(&bar[XB_XGEN(b.x)]) == gen, bar);
            __builtin_amdgcn_fence(__ATOMIC_ACQUIRE, "agent");
            asm volatile("s_waitcnt vmcnt(0)" ::: "memory");
        }
    }
    __syncthreads();
}

struct Frag { bf16x8 k0, k1, k2, k3, v0, v1, v2, v3; };
template <bool WITH_V> __device__ __forceinline__ void load_frag(Frag& f, const bf16_t* __restrict__ K, const bf16_t* __restrict__ VT, int ldv, int kbase, int lane) {
    const int i = lane & 15, fq = lane >> 4;
    const bf16_t* pa = K + (size_t)(kbase + 8 * (i >> 2) + (i & 3)) * 64 + 8 * fq;
    f.k0 = *(const bf16x8*)pa; f.k1 = *(const bf16x8*)(pa + 32); f.k2 = *(const bf16x8*)(pa + 256); f.k3 = *(const bf16x8*)(pa + 288);
    if (WITH_V) { const bf16_t* pv = VT + (size_t)i * ldv + kbase + 8 * fq;
        f.v0 = *(const bf16x8*)pv; f.v1 = *(const bf16x8*)(pv + (size_t)16 * ldv); f.v2 = *(const bf16x8*)(pv + (size_t)32 * ldv); f.v3 = *(const bf16x8*)(pv + (size_t)48 * ldv); }
}
__device__ __forceinline__ void qk_frag(const Frag& f, const bf16x8 (&qf)[2], f32x4& sA, f32x4& sB) {
    const f32x4 z = {0.f, 0.f, 0.f, 0.f};
    sA = MFMA16(f.k0, qf[0], z); sA = MFMA16(f.k1, qf[1], sA);
    sB = MFMA16(f.k2, qf[0], z); sB = MFMA16(f.k3, qf[1], sB);
}
__device__ __forceinline__ void pv_frag(const Frag& f, bf16x8 pf, f32x4 (&o)[4]) {
    o[0] = MFMA16(f.v0, pf, o[0]); o[1] = MFMA16(f.v1, pf, o[1]); o[2] = MFMA16(f.v2, pf, o[2]); o[3] = MFMA16(f.v3, pf, o[3]);
}
__device__ __forceinline__ void glds16(const void* g, unsigned lds_base) {
    unsigned sv; asm volatile("s_mov_b32 %0, m0\n\ts_mov_b32 m0, %2\n\ts_nop 0\n\tglobal_load_lds_dwordx4 %1, off\n\ts_mov_b32 m0, %0" : "=&s"(sv) : "v"(g), "s"(lds_base) : "memory"); }
__device__ __forceinline__ void glds16s(const void* sbase, unsigned voff, unsigned lds_base) {
    unsigned sv; asm volatile("s_mov_b32 %0, m0\n\ts_mov_b32 m0, %3\n\ts_nop 0\n\tglobal_load_lds_dwordx4 %1, %2\n\ts_mov_b32 m0, %0" : "=&s"(sv) : "v"(voff), "s"(sbase), "s"(lds_base) : "memory"); }
#define RFL(x) __builtin_amdgcn_readfirstlane(x)
template <bool MASK> __device__ __forceinline__ void soft_step64(const f32x4 (&sc)[4], int key0, int lo, int hi, float rowbias, float& m, float& l, f32x4 (&o)[4], bf16x8& pf0, bf16x8& pf1) {
    float s[16];
#pragma unroll
    for (int e = 0; e < 16; ++e) { const float x = __builtin_fmaf(sc[e >> 2][e & 3], C2, rowbias);
        if (MASK) { const int key_ = key0 + 32 * (e >> 3) + (e & 7); s[e] = (key_ >= lo && key_ <= hi) ? x : NEGBIG; } else s[e] = x; }
    float mx = fmaxf(fmaxf(fmaxf(fmaxf(s[0], s[1]), fmaxf(s[2], s[3])), fmaxf(fmaxf(s[4], s[5]), fmaxf(s[6], s[7]))), fmaxf(fmaxf(fmaxf(s[8], s[9]), fmaxf(s[10], s[11])), fmaxf(fmaxf(s[12], s[13]), fmaxf(s[14], s[15]))));
    mx = rowmax4(mx);
    const float mn = fmaxf(m, mx), alpha = fast_exp2(m - mn);
    float p[16], sum = 0.f;
#pragma unroll
    for (int e = 0; e < 16; ++e) { p[e] = fast_exp2(s[e] - mn); sum += p[e]; }
    sum = rowsum4(sum);
    l = l * alpha + sum; m = mn;
#pragma unroll
    for (int nt = 0; nt < 4; ++nt) o[nt] = o[nt] * alpha;
    u32x4 w0, w1;
    w0.x = cvt_pk_bf16(p[0], p[1]); w0.y = cvt_pk_bf16(p[2], p[3]); w0.z = cvt_pk_bf16(p[4], p[5]); w0.w = cvt_pk_bf16(p[6], p[7]);
    w1.x = cvt_pk_bf16(p[8], p[9]); w1.y = cvt_pk_bf16(p[10], p[11]); w1.z = cvt_pk_bf16(p[12], p[13]); w1.w = cvt_pk_bf16(p[14], p[15]);
    pf0 = __builtin_bit_cast(bf16x8, w0); pf1 = __builtin_bit_cast(bf16x8, w1);
}


__global__ void __launch_bounds__(NWAVES * 64, 2) nsa_fwd(Args args) {
    extern __shared__ __attribute__((aligned(16))) unsigned char lds[];
    cg::grid_group grid = cg::this_grid();
    const int tid = threadIdx.x, lane = tid & 63, wave = __builtin_amdgcn_readfirstlane(tid >> 6);
    const int G = gridDim.x, gw = blockIdx.x * NWAVES + wave, NGW = G * NWAVES;
    unsigned char* ws = args.ws;
    LAS unsigned char* ldsl = (LAS unsigned char*)lds;

    const float* x = args.in[0]; const int* positions = (const int*)args.in[1];
    float* H = args.out;
    float* SSQ0 = (float*)(ws + WS_SSQ0); float* SSQ1 = (float*)(ws + WS_SSQ1); float* SSQ2 = (float*)(ws + WS_SSQ2); float* SSQ3 = (float*)(ws + WS_SSQ3);
    float* PEB = (float*)(ws + WS_PEB);
    bf16_t* W1GU = (bf16_t*)(ws + WS_W1GU); bf16_t* W1D = (bf16_t*)(ws + WS_W1D); bf16_t* WIN = (bf16_t*)(ws + WS_WIN);
    bf16_t* CW1K = (bf16_t*)(ws + WS_CW1K); bf16_t* CW1V = (bf16_t*)(ws + WS_CW1V); bf16_t* CW2K = (bf16_t*)(ws + WS_CW2K); bf16_t* CW2V = (bf16_t*)(ws + WS_CW2V);
    bf16_t* WA = (bf16_t*)(ws + WS_WA); bf16_t* WB = (bf16_t*)(ws + WS_WB); bf16_t* WOUT = (bf16_t*)(ws + WS_WOUT); bf16_t* W2GU = (bf16_t*)(ws + WS_W2GU); bf16_t* W2D = (bf16_t*)(ws + WS_W2D);
    float* ROPEC = (float*)(ws + WS_ROPEC); float* ROPES = (float*)(ws + WS_ROPES);
    bf16_t* XB = (bf16_t*)(ws + WS_XB); bf16_t* ACT = (bf16_t*)(ws + WS_ACT);
    bf16_t* GA = (bf16_t*)(ws + WS_GA); bf16_t* GB = (bf16_t*)(ws + WS_GB); bf16_t* NQ = (bf16_t*)(ws + WS_NQ);
    bf16_t* KCMP = (bf16_t*)(ws + WS_KCMP); bf16_t* VCMPT = (bf16_t*)(ws + WS_VCMPT); unsigned* SEL = (unsigned*)(ws + WS_SEL); float* NG = (float*)(ws + WS_NG);
    bf16_t* SQ = (bf16_t*)(ws + WS_SQ); bf16_t* OCMP = (bf16_t*)(ws + WS_OCMP); bf16_t* KC = (bf16_t*)(ws + WS_KC); bf16_t* VC = (bf16_t*)(ws + WS_VC);
    bf16_t* KSL = (bf16_t*)(ws + WS_KSL); bf16_t* VSLT = (bf16_t*)(ws + WS_VSLT); bf16_t* KWN = (bf16_t*)(ws + WS_KWN); bf16_t* VWNT = (bf16_t*)(ws + WS_VWNT);
    bf16_t* SK = (bf16_t*)(ws + WS_SK); bf16_t* SVT = (bf16_t*)(ws + WS_SVT);
#if defined(DBG_NOFFN1)
    bf16_t* OB = (bf16_t*)(ws + 150 * MiB);
#else
    bf16_t* OB = SQ;
#endif

    const int fr = lane & 15, fq = lane >> 4;
#define GRID_SYNC_CG() do { asm volatile("s_waitcnt vmcnt(0) lgkmcnt(0)" ::: "memory"); __syncthreads(); grid.sync(); \
        __builtin_amdgcn_fence(__ATOMIC_ACQUIRE, "agent"); asm volatile("s_waitcnt vmcnt(0)" ::: "memory"); __syncthreads(); } while (0)
#define GRID_SYNC() xcd_barrier(xbar)
    volatile LAS unsigned* MISC = (volatile LAS unsigned*)(ldsl + LDS_BYTES - 1024);
    if (tid < 16) MISC[tid] = 0u;
    __syncthreads();
    XcdBarrier xbar = xcd_barrier_post((unsigned*)(ws + WS_BAR), MISC + 8);

#ifndef DBG_STOP
#define DBG_STOP 0
#endif
#define DUMP_LOOP(expr) do { for (size_t i_ = (size_t)blockIdx.x * 512 + tid; i_ < (size_t)TOK * DM; i_ += (size_t)G * 512) { args.out[i_] = (expr); } return; } while (0)
    {
        LAS float* scr = (LAS float*)(ldsl + wave * 16384);
        constexpr int I_GU = 16 * 88, I_D = 44 * 32, I_IN = 16 * 125, I_C1 = 32 * 8, I_C2 = 4 * 2, I_AB = 8 * 32, I_O = 16 * 32;
        constexpr int NITEMS = 6 * I_GU + I_IN + 2 * I_C1 + 2 * I_C2 + 2 * I_AB + I_O;
        static_assert(I_GU == I_D, "items");
        for (int it = gw; it < 2 * I_GU + I_IN; it += NGW) {
            int r = it;
            if (r < I_GU) { transpose_item(args.in[3], 1024, 2816, W1GU, 1, 0, args.in[2], scr, r, lane); continue; } r -= I_GU;
            if (r < I_GU) { transpose_item(args.in[4], 1024, 2816, W1GU, 1, 128, args.in[2], scr, r, lane); continue; } r -= I_GU;
            transpose_item(args.in[7], 1024, 3992, WIN, 2, 0, args.in[6], scr, r, lane);
        }
        for (int mrow = gw; mrow < TOK; mrow += 2 * NGW) {
            const int mrow2 = mrow + NGW;
            const bool two = mrow2 < TOK;
            const f32x4* xr = (const f32x4*)(x + (size_t)mrow * DM) + lane; const f32x4* xr2 = (const f32x4*)(x + (size_t)(two ? mrow2 : mrow) * DM) + lane;
            f32x4 v[4], w[4];
#pragma unroll
            for (int j = 0; j < 4; ++j) { v[j] = xr[64 * j]; w[j] = xr2[64 * j]; }
            unsigned long long* o8 = (unsigned long long*)(XB + (size_t)mrow * DM) + lane; unsigned long long* p8 = (unsigned long long*)(XB + (size_t)mrow2 * DM) + lane;
            float s = 0.f, s2 = 0.f;
#pragma unroll
            for (int j = 0; j < 4; ++j) { s += (v[j][0] * v[j][0] + v[j][1] * v[j][1]) + (v[j][2] * v[j][2] + v[j][3] * v[j][3]);
                s2 += (w[j][0] * w[j][0] + w[j][1] * w[j][1]) + (w[j][2] * w[j][2] + w[j][3] * w[j][3]);
                o8[64 * j] = (unsigned long long)pk2(v[j][0], v[j][1]) | ((unsigned long long)pk2(v[j][2], v[j][3]) << 32);
                if (two) p8[64 * j] = (unsigned long long)pk2(w[j][0], w[j][1]) | ((unsigned long long)pk2(w[j][2], w[j][3]) << 32); }
            s = wave_sum(s); s2 = wave_sum(s2);
            if (lane < 16) { SSQ0[(size_t)mrow * 16 + lane] = lane == 0 ? s : 0.f; if (two) SSQ0[(size_t)mrow2 * 16 + lane] = lane == 0 ? s2 : 0.f; }
        }
        for (int idx = blockIdx.x * (NWAVES * 64) + tid; idx < TOK * 32; idx += G * NWAVES * 64) {
            const int trow = idx >> 5, i = idx & 31;
            const float ang = (float)positions[trow] * INV_FREQ[i];
            const double rev = (double)ang * 0.15915494309189535; const float frac = (float)(rev - __builtin_rint(rev));
            ROPEC[idx] = __builtin_amdgcn_cosf(frac); ROPES[idx] = __builtin_amdgcn_sinf(frac);
        }
        for (int o = gw; o < 2048; o += NGW) {
            const int part = o >> 9, oo = o & 511, z = oo >> 8, j = oo & 255; const float* pe = args.in[z ? 11 : 8]; const float* w1 = args.in[z ? 12 : 9];
            float s = 0.f;
#pragma unroll
            for (int i = 0; i < 8; ++i) { const int kk = 512 * part + 64 * i + lane; s += pe[kk] * w1[(size_t)kk * 256 + j]; }
            s = wave_sum(s);
            if (lane == 0) PEB[part * 512 + oo] = s;
        }
    }
    if (args.rep[3] == 77) GRID_SYNC_CG();
    GRID_SYNC();

#if !defined(DBG_NOFFN1)
    { pg8::Gemm g{XB, W1GU, TOK, 2 * DFF, DM}; pg8::StaticOrder S; S.init(TOK, 2 * DFF, G, (int)blockIdx.x);
      pg8::EpiSwiglu E{ACT, SSQ0};
      pg8::gemm_phase<pg8::EpiSwiglu, pg8::StaticOrder, true, true>(ldsl, g, S, E); }
    {
        constexpr int I_GU = 16 * 88, I_D = 44 * 32, I_C1 = 32 * 8, I_C2 = 4 * 2, I_AB = 8 * 32, I_O = 16 * 32;
        constexpr int NLATE = 2 * I_GU + 2 * I_D + 2 * I_C1 + 2 * I_C2 + 2 * I_AB + I_O, NUNITS = (TOK / 256) * (2 * DFF / 256);
        const int rem = NUNITS % G, first = rem ? rem : 0, np = rem ? G - rem : G;
        if ((int)blockIdx.x >= first) {
            LAS float* scr = (LAS float*)(ldsl + wave * 16384);
            for (int it = ((int)blockIdx.x - first) * NWAVES + wave; it < NLATE; it += np * NWAVES) {
                int r = it;
                if (r < I_D) { transpose_item(args.in[5], 2816, 1024, W1D, 0, 0, nullptr, scr, r, lane); continue; } r -= I_D;
                if (r < I_GU) { transpose_item(args.in[19], 1024, 2816, W2GU, 1, 0, args.in[18], scr, r, lane); continue; } r -= I_GU;
                if (r < I_GU) { transpose_item(args.in[20], 1024, 2816, W2GU, 1, 128, args.in[18], scr, r, lane); continue; } r -= I_GU;
                if (r < I_D) { transpose_item(args.in[21], 2816, 1024, W2D, 0, 0, nullptr, scr, r, lane); continue; } r -= I_D;
                if (r < I_C1) { transpose_item(args.in[9], 2048, 256, CW1K, 0, 0, nullptr, scr, r, lane); continue; } r -= I_C1;
                if (r < I_C1) { transpose_item(args.in[12], 2048, 256, CW1V, 0, 0, nullptr, scr, r, lane); continue; } r -= I_C1;
                if (r < I_C2) { transpose_item(args.in[10], 256, 64, CW2K, 3, 0, nullptr, scr, r, lane); continue; } r -= I_C2;
                if (r < I_C2) { transpose_item(args.in[13], 256, 64, CW2V, 0, 0, nullptr, scr, r, lane); continue; } r -= I_C2;
                if (r < I_AB) { transpose_item(args.in[15], 512, 1024, WA, 0, 0, nullptr, scr, r, lane); continue; } r -= I_AB;
                if (r < I_AB) { transpose_item(args.in[16], 512, 1024, WB, 0, 0, nullptr, scr, r, lane); continue; } r -= I_AB;
                transpose_item(args.in[17], 1024, 1024, WOUT, 0, 0, nullptr, scr, r, lane);
            }
        }
    }
    GRID_SYNC();
    if (DBG_STOP == 12) DUMP_LOOP(bf2f(ACT[i_]) + bf2f(ACT[i_ + 16777216]) + (i_ < 12582912 ? bf2f(ACT[i_ + 33554432]) : 0.f));
    if (args.rep[3] == 1) { pg8::Gemm g{XB, W1GU, TOK, 2 * DFF, DM}; pg8::StaticOrder S; S.init(TOK, 2 * DFF, G, (int)blockIdx.x); pg8::EpiDry E{PEB, args.rep[0] - 1};
      pg8::gemm_phase<pg8::EpiDry, pg8::StaticOrder, true, true>(ldsl, g, S, E); GRID_SYNC(); }
    if (args.rep[3] == 2) { pg8::Gemm g{ACT, W1D, TOK, DM, DFF}; pg8::StaticOrder S; S.init(TOK, DM, G, (int)blockIdx.x); pg8::EpiDry E{PEB, args.rep[0] - 1};
      pg8::gemm_phase<pg8::EpiDry, pg8::StaticOrder, true, true>(ldsl, g, S, E); GRID_SYNC(); }
    if (args.rep[3] == 3) { pg8::Gemm g{XB, WIN, TOK, 4096, DM}; pg8::StaticOrder S; S.init(TOK, 4096, G, (int)blockIdx.x); pg8::EpiDry E{PEB, args.rep[0] - 1};
      pg8::gemm_phase<pg8::EpiDry, pg8::StaticOrder, true, true>(ldsl, g, S, E); GRID_SYNC(); }
    if (args.rep[3] == 4) { pg8::Gemm g{XB, WA, TOK, DM, 512}; pg8::StaticOrder S; S.init(TOK, DM, G, (int)blockIdx.x); pg8::EpiDry E{PEB, args.rep[0] - 1};
      pg8::gemm_phase<pg8::EpiDry, pg8::StaticOrder, true, true>(ldsl, g, S, E); GRID_SYNC(); }
    if (args.rep[3] == 6) { GRID_SYNC(); GRID_SYNC(); GRID_SYNC(); GRID_SYNC(); GRID_SYNC(); GRID_SYNC(); GRID_SYNC(); GRID_SYNC(); GRID_SYNC(); GRID_SYNC(); }
    { pg8::Gemm g{ACT, W1D, TOK, DM, DFF}; pg8::StaticOrder S; S.init(TOK, DM, G, (int)blockIdx.x);
      pg8::EpiResid E{x, H, XB, SSQ1, 0.5f};
      pg8::gemm_phase<pg8::EpiResid, pg8::StaticOrder, true, true>(ldsl, g, S, E); }
    GRID_SYNC();
    if (DBG_STOP == 1) return;
#endif
    { pg8::Gemm g{XB, WIN, TOK, 4096, DM}; pg8::StaticOrder S; S.init(TOK, 4096, G, (int)blockIdx.x);
      pg8::EpiProj E{
#if defined(DBG_NOFFN1)
 SSQ0,
#else
 SSQ1,
#endif
 ROPEC, ROPES, NQ, KC, VC, KSL, VSLT, KWN, VWNT, SQ, SK, SVT, GA, GB, NG};
      pg8::gemm_phase<pg8::EpiProj, pg8::StaticOrder, true, true>(ldsl, g, S, E); }
    GRID_SYNC();
    if (DBG_STOP == 13) DUMP_LOOP(bf2f(NQ[i_ & 8388607]) + bf2f(SQ[i_ & 8388607]) + bf2f(KC[i_ & 2097151]) + bf2f(VC[i_ & 2097151]) + bf2f(KSL[i_ & 2097151]) + bf2f(VSLT[i_ & 2097151]) + bf2f(KWN[i_ & 2097151]) + bf2f(VWNT[i_ & 2097151]) + bf2f(SK[i_ & 1048575]) + bf2f(SVT[i_ & 1048575]) + NG[i_ % (TOK * 24)]);
    if (DBG_STOP == 11) DUMP_LOOP(bf2f(GA[i_]) + bf2f(GB[i_]));
    if (DBG_STOP == 2) DUMP_LOOP(bf2f(GA[i_]) + bf2f(GB[i_]) + bf2f(NQ[i_ & 8388607]) + bf2f(SQ[i_ & 8388607]) + bf2f(KC[i_ & 2097151]) + bf2f(VC[i_ & 2097151]) + bf2f(KSL[i_ & 2097151]) + bf2f(VSLT[i_ & 2097151]) + bf2f(KWN[i_ & 2097151]) + bf2f(VWNT[i_ & 2097151]) + bf2f(SK[i_ & 1048575]) + bf2f(SVT[i_ & 1048575]) + NG[i_ % (TOK * 24)]);

    for (int rep = 0; rep < args.rep[0]; ++rep)
    for (int u = blockIdx.x; u < 256; u += G) {
        const int z = u >> 7, r0 = (u & 127) * 16;
        const bf16_t* A = z ? VC : KC; const bf16_t* W1 = z ? CW1V : CW1K; const bf16_t* W2 = z ? CW2V : CW2K; const float* peb = PEB + z * 256;
        bf16_t* hid = (bf16_t*)lds;
        f32x4 acc0 = {0.f, 0.f, 0.f, 0.f}, acc1 = {0.f, 0.f, 0.f, 0.f};
        const bf16_t* ap = A + (size_t)(r0 + fr) * 1024 + 8 * fq;
        const bf16_t* bp0 = W1 + (size_t)(32 * wave + fr) * 2048 + 8 * fq; const bf16_t* bp1 = bp0 + 16 * 2048;
#pragma unroll 8
        for (int k0 = 0; k0 < 2048; k0 += 32) {
            const bf16x8 a = *(const bf16x8*)(ap + k0), b0 = *(const bf16x8*)(bp0 + k0), b1 = *(const bf16x8*)(bp1 + k0);
            acc0 = MFMA16(b0, a, acc0); acc1 = MFMA16(b1, a, acc1);
        }
#pragma unroll
        for (int nt = 0; nt < 2; ++nt) {
            const f32x4 a = nt ? acc1 : acc0; const int col = 32 * wave + 16 * nt + 4 * fq;
            float hv[4];
#pragma unroll
            for (int r = 0; r < 4; ++r) { const float h = a[r] + ((peb[col + r] + peb[512 + col + r]) + (peb[1024 + col + r] + peb[1536 + col + r])); const float uu = 0.7978845608028654f * (h + 0.044715f * h * h * h);
                const float th = 1.0f - 2.0f * fast_rcp(1.0f + fast_exp2(2.0f * LOG2E * uu)); hv[r] = 0.5f * h * (1.0f + th); }
            unsigned* hp = (unsigned*)(hid + fr * 264 + col); hp[0] = cvt_pk_bf16(hv[0], hv[1]); hp[1] = cvt_pk_bf16(hv[2], hv[3]);
        }
        __syncthreads();
        if (wave < 4) {
            f32x4 acc2 = {0.f, 0.f, 0.f, 0.f};
            const bf16_t* wp = W2 + (size_t)(16 * wave + fr) * 256 + 8 * fq;
#pragma unroll
            for (int k0 = 0; k0 < 256; k0 += 32) { const bf16x8 a = *(const bf16x8*)(wp + k0), bb = *(const bf16x8*)(hid + fr * 264 + k0 + 8 * fq); acc2 = MFMA16(a, bb, acc2); }
            const int r = r0 + fr, bg = r >> 9, i = r & 511, bb_ = bg >> 1;
            const bool ok = i < 511;
            if (z == 0) {
                const int trow = bb_ * SEQ + 16 * (ok ? i : 0) + 31, i0 = 8 * wave + 2 * fq;
                const float c0 = ROPEC[(size_t)trow * 32 + i0], s0 = ROPES[(size_t)trow * 32 + i0], c1 = ROPEC[(size_t)trow * 32 + i0 + 1], s1 = ROPES[(size_t)trow * 32 + i0 + 1];
                float o0 = acc2[0] * c0 - acc2[1] * s0, o1 = acc2[1] * c0 + acc2[0] * s0, o2 = acc2[2] * c1 - acc2[3] * s1, o3 = acc2[3] * c1 + acc2[2] * s1;
                if (!ok) { o0 = 0.f; o1 = 0.f; o2 = 0.f; o3 = 0.f; }
                unsigned* kp = (unsigned*)(KCMP + ((size_t)bg * 512 + i) * 64 + 16 * wave + 4 * fq); kp[0] = cvt_pk_bf16(o0, o1); kp[1] = cvt_pk_bf16(o2, o3);
            } else {
#pragma unroll
                for (int rr = 0; rr < 4; ++rr) VCMPT[((size_t)bg * 64 + 16 * wave + 4 * fq + rr) * 512 + i] = (bf16_t)f2bf(ok ? acc2[rr] : 0.f);
            }
        }
        __syncthreads();
    }
    GRID_SYNC();
    if (DBG_STOP == 3) DUMP_LOOP(bf2f(KCMP[i_ & 131071]) + bf2f(VCMPT[i_ & 131071]));

    {
        constexpr int RS = 72;
        bf16_t* Kb = (bf16_t*)lds;
        bf16_t* Vb = (bf16_t*)(lds + 2 * 64 * RS * 2);
        float* Pl = (float*)(lds + 40960 + wave * 10240);
        unsigned long long* KEY = (unsigned long long*)(Pl + 2048);
        const int skr = tid >> 3, sc8 = (tid & 7) * 8;
        const int krow = (skr & 32) + (((skr & 7) < 4) ? (4 * ((skr & 31) >> 3) + (skr & 7)) : (16 + 4 * ((skr & 31) >> 3) + (skr & 7) - 4));
        for (int rep = 0; rep < args.rep[1]; ++rep)
        for (int wu = blockIdx.x; wu < 1024; wu += G) {
            const int bg = wu >> 8, tl0 = wu & 255, tile = (bg & 1) ? 255 - tl0 : tl0, t0w = tile * 32, t0 = t0w + 4 * wave, b = bg >> 1, g = bg & 1;
            const int tl = fr >> 2, hh = fr & 3, t = t0 + tl, head = g * 4 + hh;
            const size_t qrow = (size_t)(b * SEQ + t);
            bf16x8 qf[2]; qf[0] = *(const bf16x8*)(NQ + qrow * 512 + head * 64 + 8 * fq); qf[1] = *(const bf16x8*)(NQ + qrow * 512 + head * 64 + 32 + 8 * fq);
            const bf16_t* Kc = KCMP + (size_t)bg * 512 * 64; const bf16_t* Vc = VCMPT + (size_t)bg * 64 * 512;
            const int hi = (t >= 31) ? ((t - 31) >> 4) : -1;
            const int hiw = (t0 + 3 >= 31) ? ((t0 + 3 - 31) >> 4) : -1;
            const int nst = (2 * tile + 64) >> 6;
            u32x4 kreg, vreg;
#define C_LOADK(s_) do { kreg = *(const u32x4*)(Kc + (size_t)(64 * (s_) + skr) * 64 + sc8); } while (0)
#define C_LOADV(s_) do { vreg = *(const u32x4*)(Vc + (size_t)skr * 512 + 64 * (s_) + sc8); } while (0)
#define C_WRITEK(bufi) do { *(u32x4*)(Kb + (bufi) * 64 * RS + krow * RS + sc8) = kreg; } while (0)
#define C_WRITEV(bufi) do { *(u32x4*)(Vb + (bufi) * 64 * RS + skr * RS + sc8) = vreg; } while (0)
#define C_FRAGK(F, Kt, half) do { const bf16_t* ka = (Kt) + (32 * (half) + fr) * RS + 8 * fq; \
                F.k0 = *(const bf16x8*)ka; F.k1 = *(const bf16x8*)(ka + 32); F.k2 = *(const bf16x8*)(ka + 16 * RS); F.k3 = *(const bf16x8*)(ka + 16 * RS + 32); } while (0)
#define C_FRAGV(F, Vt, half) do { const bf16_t* va = (Vt) + fr * RS + 32 * (half) + 8 * fq; \
                F.v0 = *(const bf16x8*)va; F.v1 = *(const bf16x8*)(va + 16 * RS); F.v2 = *(const bf16x8*)(va + 32 * RS); F.v3 = *(const bf16x8*)(va + 48 * RS); } while (0)
            float m = NEGBIG, l = 0.f;
            C_LOADK(0); C_WRITEK(0);
            __syncthreads();
            for (int s = 0; s < nst; ++s) {
                if (s + 1 < nst) C_LOADK(s + 1);
                const bf16_t* Kt = Kb + (s & 1) * 64 * RS;
#pragma unroll
                for (int half = 0; half < 2; ++half) {
                    const int kbase = 64 * s + 32 * half;
                    if (kbase <= hiw) {
                        Frag F; C_FRAGK(F, Kt, half);
                        f32x4 sA, sB; qk_frag(F, qf, sA, sB);
                        SCORES8(sA, sB, kbase + 8 * fq, 0, hi, sc_, v)
                        float mx = fmaxf(fmaxf(fmaxf(sc_[0], sc_[1]), fmaxf(sc_[2], sc_[3])), fmaxf(fmaxf(sc_[4], sc_[5]), fmaxf(sc_[6], sc_[7])));
                        mx = rowmax4(mx);
                        const float mn = fmaxf(m, mx), alpha = fast_exp2(m - mn);
                        float sum = 0.f;
#pragma unroll
                        for (int e = 0; e < 8; ++e) sum += v[e] ? fast_exp2(sc_[e] - mn) : 0.f;
                        sum = rowsum4(sum);
                        l = l * alpha + sum; m = mn;
                    }
                }
                if (s + 1 < nst) C_WRITEK((s + 1) & 1);
                __syncthreads();
            }
            const float inv_l = l > 0.f ? 1.0f / l : 0.f;
#pragma unroll
            for (int q = 0; q < 8; ++q) ((f32x4*)Pl)[lane + 64 * q] = (f32x4){0.f, 0.f, 0.f, 0.f};
            f32x4 o[4];
#pragma unroll
            for (int nt = 0; nt < 4; ++nt) o[nt] = (f32x4){0.f, 0.f, 0.f, 0.f};
            C_LOADK(0); C_LOADV(0); C_WRITEK(0); C_WRITEV(0);
            __syncthreads();
            for (int s = 0; s < nst; ++s) {
                if (s + 1 < nst) { C_LOADK(s + 1); C_LOADV(s + 1); }
                const bf16_t* Kt = Kb + (s & 1) * 64 * RS; const bf16_t* Vt = Vb + (s & 1) * 64 * RS;
#pragma unroll
                for (int half = 0; half < 2; ++half) {
                    const int kbase = 64 * s + 32 * half;
                    if (kbase <= hiw) {
                        Frag F; C_FRAGK(F, Kt, half); C_FRAGV(F, Vt, half);
                        f32x4 sA, sB; qk_frag(F, qf, sA, sB);
                        SCORES8(sA, sB, kbase + 8 * fq, 0, hi, sc_, v)
                        float p[8], ps[8];
#pragma unroll
                        for (int e = 0; e < 8; ++e) { p[e] = v[e] ? fast_exp2(sc_[e] - m) * inv_l : 0.f; float q_ = p[e] + __shfl_xor(p[e], 1); ps[e] = q_ + __shfl_xor(q_, 2); }
                        if (hh == 0) { f32x4* pp = (f32x4*)(Pl + tl * 512 + kbase + 8 * fq); pp[0] = (f32x4){ps[0], ps[1], ps[2], ps[3]}; pp[1] = (f32x4){ps[4], ps[5], ps[6], ps[7]}; }
                        u32x4 w; w.x = cvt_pk_bf16(p[0], p[1]); w.y = cvt_pk_bf16(p[2], p[3]); w.z = cvt_pk_bf16(p[4], p[5]); w.w = cvt_pk_bf16(p[6], p[7]);
                        pv_frag(F, __builtin_bit_cast(bf16x8, w), o);
                    }
                }
                if (s + 1 < nst) { C_WRITEK((s + 1) & 1); C_WRITEV((s + 1) & 1); }
                __syncthreads();
            }
            {
                const float gc = NG[qrow * 24 + head];
#pragma unroll
                for (int nt = 0; nt < 4; ++nt) { unsigned* op = (unsigned*)(OCMP + qrow * 512 + head * 64 + 16 * nt + 4 * fq);
                    op[0] = cvt_pk_bf16(o[nt][0] * gc, o[nt][1] * gc); op[1] = cvt_pk_bf16(o[nt][2] * gc, o[nt][3] * gc); }
            }
            LDS_WAIT();
            for (int tk = 0; tk < 4; ++tk) {
                const int tt = t0 + tk, tb = tt >> 6;
                const float* P = Pl + tk * 512;
                unsigned hv[2];
#pragma unroll
                for (int q = 0; q < 2; ++q) { const int j = lane + 64 * q;
                    const float a = (j > 0 ? 0.5f * P[4 * j - 1] : 0.f) + P[4 * j] + P[4 * j + 1] + P[4 * j + 2] + 0.5f * P[4 * j + 3];
                    const bool forced = (j == 0) || (j <= tb && tb - j < 2);
                    hv[q] = j > tb ? 0u : (forced ? 0x7f000000u : __float_as_uint(a) + 1u); }
                unsigned T = 0u;
                for (int bit = 30; bit >= 0; --bit) {
                    const unsigned cand = T | (1u << bit);
                    const int cnt = __builtin_popcountll(__ballot(hv[0] >= cand)) + __builtin_popcountll(__ballot(hv[1] >= cand));
                    T = cnt >= 16 ? cand : T;
                }
                const unsigned long long g0 = __ballot(hv[0] > T), g1 = __ballot(hv[1] > T), e0 = __ballot(hv[0] == T), e1 = __ballot(hv[1] == T);
                const int need = 16 - (__builtin_popcountll(g0) + __builtin_popcountll(g1));
                const unsigned long long below = (1ull << lane) - 1ull;
                const bool s0 = (hv[0] > T) || ((hv[0] == T) && __builtin_popcountll(e0 & below) < need);
                const bool s1 = (hv[1] > T) || ((hv[1] == T) && (__builtin_popcountll(e0) + __builtin_popcountll(e1 & below)) < need);
                const unsigned long long b0 = __ballot(s0 && lane <= tb), b1 = __ballot(s1 && lane + 64 <= tb);
                if (lane == 0) { u32x4 w; w.x = (unsigned)b0; w.y = (unsigned)(b0 >> 32); w.z = (unsigned)b1; w.w = (unsigned)(b1 >> 32); *(u32x4*)(SEL + ((size_t)bg * SEQ + tt) * 4) = w; }
            }
            LDS_WAIT();
        }
    }
    GRID_SYNC();
    if (DBG_STOP == 4) DUMP_LOOP(bf2f(OCMP[i_ & 8388607]) + (float)(SEL[i_ & 131071] & 0xffffu));

    {
        constexpr int RB = 4, SLOTB = 32768;
        const unsigned ring_base = (unsigned)(size_t)ldsl;
        const unsigned char* ring = (const unsigned char*)lds;
        unsigned* Usc = (unsigned*)(lds + RB * SLOTB);
        int* lst = (int*)(lds + RB * SLOTB + 128);
        int* nls = (int*)(lds + RB * SLOTB + 128 + 1024);
        int* flg = (int*)(lds + RB * SLOTB + 128 + 1024 + 128);
        const int dl_r = lane >> 3, dl_c = lane & 7;
        const unsigned voffK = (unsigned)((8 * (dl_r >> 2) + (dl_r & 3)) * 128 + ((dl_c ^ dl_r) << 4)), voffV = (unsigned)(dl_r * SEQ * 2 + ((dl_c ^ dl_r) << 4));
        const int offA = fr * 128 + ((fq ^ (fr & 7)) << 4), offB = fr * 128 + (((fq ^ (fr & 7)) ^ 4) << 4);
        for (int rep = 0; rep < args.rep[2]; ++rep)
        for (int wu = blockIdx.x; wu < 512; wu += G) {
            const int k_ = wu >> 8, bb_ = wu & 255, bg = 2 * k_ + (bb_ >> 7), tau = (bb_ & 128) ? 127 - (bb_ & 127) : (bb_ & 127), tile = k_ ? 127 - tau : tau;
            const int t0w = tile * 64, t0 = t0w + 8 * wave, b = bg >> 1, g = bg & 1;
            const int tl = fr >> 2, hh = fr & 3, head = g * 4 + hh;
            const bf16_t* Ks = KSL + (size_t)bg * SEQ * 64; const bf16_t* Vs = VSLT + (size_t)bg * 64 * SEQ;
            const bf16_t* Kw = KWN + (size_t)bg * SEQ * 64; const bf16_t* Vw = VWNT + (size_t)bg * 64 * SEQ;
            bf16x8 qf[2][2]; u32x4 mym[2]; unsigned Uw[2][4]; int tr[2];
#pragma unroll
            for (int rg = 0; rg < 2; ++rg) {
                tr[rg] = t0 + 4 * rg + tl;
                const size_t qrow = (size_t)(b * SEQ + tr[rg]);
                qf[rg][0] = *(const bf16x8*)(NQ + qrow * 512 + head * 64 + 8 * fq); qf[rg][1] = *(const bf16x8*)(NQ + qrow * 512 + head * 64 + 32 + 8 * fq);
                mym[rg] = *(const u32x4*)(SEL + ((size_t)bg * SEQ + tr[rg]) * 4);
#pragma unroll
                for (int w = 0; w < 4; ++w) { const unsigned mw = mym[rg][w];
                    Uw[rg][w] = (unsigned)__builtin_amdgcn_readlane((int)mw, 0) | (unsigned)__builtin_amdgcn_readlane((int)mw, 4) | (unsigned)__builtin_amdgcn_readlane((int)mw, 8) | (unsigned)__builtin_amdgcn_readlane((int)mw, 12); }
            }
            if (lane == 0) { Usc[wave * 4 + 0] = Uw[0][0] | Uw[1][0]; Usc[wave * 4 + 1] = Uw[0][1] | Uw[1][1]; Usc[wave * 4 + 2] = Uw[0][2] | Uw[1][2]; Usc[wave * 4 + 3] = Uw[0][3] | Uw[1][3]; }
            __syncthreads();
            if (wave == 0) {
                int n0 = 0;
#pragma unroll
                for (int q = 0; q < 2; ++q) { const int j = lane + 64 * q; unsigned ug = 0u;
#pragma unroll
                    for (int ww = 0; ww < 8; ++ww) ug |= Usc[ww * 4 + (j >> 5)];
                    const bool in = ((ug >> (j & 31)) & 1u) && (64 * j <= t0w + 63);
                    const unsigned long long bal = __ballot(in);
                    const int pos = n0 + __builtin_popcountll(bal & ((1ull << lane) - 1ull));
                    if (in) lst[pos] = j;
                    n0 += __builtin_popcountll(bal); }
                if (n0 & 1) { if (lane == 0) lst[n0] = 0x100; ++n0; }
                const int jw0 = (t0w - 511 > 0 ? t0w - 511 : 0) >> 6, nw = ((t0w + 63) >> 6) - jw0 + 1;
                if (lane < nw) lst[n0 + lane] = (jw0 + lane) | 0x80;
                if ((nw & 1) && lane == 0) lst[n0 + nw] = 0x180;
                if (lane == 0) nls[0] = n0 + ((nw + 1) & ~1);
                if (lane < 16) flg[lane] = 0;
            }
            __syncthreads();
            const int n = RFL(nls[0]);
            float mS[2], lS[2]; f32x4 oS[2][4];
#pragma unroll
            for (int rg = 0; rg < 2; ++rg) { mS[rg] = NEGBIG; lS[rg] = 0.f;
#pragma unroll
                for (int nt = 0; nt < 4; ++nt) oS[rg][nt] = (f32x4){0.f, 0.f, 0.f, 0.f}; }
            int nslc_ = 0;
            { int c_ = 0; for (int i_ = lane; i_ < n; i_ += 64) c_ += (lst[i_] & 0x80) ? 0 : 1; c_ = (int)wave_sum((float)c_); nslc_ = RFL(c_); }
#define RG_WAIT(ptr, target) do { while (__hip_atomic_load((ptr), __ATOMIC_RELAXED, __HIP_MEMORY_SCOPE_WORKGROUP) < (target)) __builtin_amdgcn_s_sleep(1); asm volatile("" ::: "memory"); } while (0)
#define RG_SIGNAL(ptr) do { LDS_WAIT(); if (lane == 0) __hip_atomic_fetch_add((ptr), 1, __ATOMIC_RELAXED, __HIP_MEMORY_SCOPE_WORKGROUP); } while (0)
#define DMA_ISSUE(k_) do { const int slot_ = (k_) % RB; RG_WAIT(flg + 8 + slot_, 8 * ((k_) / RB)); \
                for (int sub_ = 0; sub_ < 2; ++sub_) { const int e_ = RFL(lst[2 * (k_) + sub_]); \
                  if (!(e_ & 0x100)) { \
                    const int j_ = e_ & 127; const bf16_t* Kg_ = (e_ & 0x80) ? Kw : Ks; const bf16_t* Vg_ = (e_ & 0x80) ? Vw : Vs; const unsigned sb_ = ring_base + slot_ * SLOTB + sub_ * 16384; \
                    _Pragma("unroll") for (int q_ = 0; q_ < 8; ++q_) { constexpr int RC_[4] = {0, 16, 4, 20}; \
                        glds16s(Kg_ + (size_t)(64 * j_ + 32 * (q_ >> 2) + RC_[q_ & 3]) * 64, voffK, sb_ + q_ * 1024); } \
                    _Pragma("unroll") for (int q_ = 0; q_ < 8; ++q_) glds16s(Vg_ + (size_t)(8 * q_) * SEQ + 64 * j_, voffV, sb_ + 8192 + q_ * 1024); } } \
                } while (0)
#define DMA_PUBLISH(k_) do { asm volatile("s_waitcnt vmcnt(0)" ::: "memory"); if (lane == 0) __hip_atomic_store(flg + ((k_) % RB), (k_) / RB + 1, __ATOMIC_RELAXED, __HIP_MEMORY_SCOPE_WORKGROUP); } while (0)
#define ST_COMPUTE(s_, WIN) do { const int slot = (s_) % RB; \
                RG_WAIT(flg + slot, (s_) / RB + 1); \
                for (int sub = 0; sub < 2; ++sub) { const int e = RFL(lst[2 * (s_) + sub]); if (e & 0x100) continue; const int j = e & 127; \
                const unsigned char* Kt = ring + slot * SLOTB + sub * 16384; const unsigned char* Vt = Kt + 8192; \
                bool act[2], inter[2]; float rb[2]; \
                _Pragma("unroll") for (int rg = 0; rg < 2; ++rg) { const int t0g = t0 + 4 * rg; \
                    if (WIN) { act[rg] = (64 * j + 63 >= t0g - 511) && (64 * j <= t0g + 3); inter[rg] = (64 * j >= t0g + 3 - 511) && (64 * j + 63 <= t0g); rb[rg] = 0.f; } \
                    else { const unsigned uw = j < 32 ? Uw[rg][0] : j < 64 ? Uw[rg][1] : j < 96 ? Uw[rg][2] : Uw[rg][3]; act[rg] = (((uw >> (j & 31)) & 1u) != 0u) && (64 * j <= t0g + 3); \
                           const unsigned mw_ = j < 32 ? mym[rg].x : j < 64 ? mym[rg].y : j < 96 ? mym[rg].z : mym[rg].w; rb[rg] = ((mw_ >> (j & 31)) & 1u) ? 0.f : NEGBIG; inter[rg] = (64 * j + 63 <= t0g); } } \
                _Pragma("unroll") for (int rg = 0; rg < 2; ++rg) if (act[rg]) { \
                    const int t = tr[rg]; f32x4 sc[4]; bf16x8 pf0, pf1; bf16x8 kf[8], vf[8]; \
                    _Pragma("unroll") for (int q_ = 0; q_ < 4; ++q_) { kf[2 * q_] = *(const bf16x8*)(Kt + offA + q_ * 2048); kf[2 * q_ + 1] = *(const bf16x8*)(Kt + offB + q_ * 2048); } \
                    __builtin_amdgcn_sched_barrier(0);     \
                    { const f32x4 z_ = {0.f, 0.f, 0.f, 0.f}; \
                      _Pragma("unroll") for (int q_ = 0; q_ < 4; ++q_) { sc[q_] = MFMA16(kf[2 * q_], qf[rg][0], z_); sc[q_] = MFMA16(kf[2 * q_ + 1], qf[rg][1], sc[q_]); } } \
                    vf[0] = *(const bf16x8*)(Vt + offA); vf[1] = *(const bf16x8*)(Vt + offB); \
                    __builtin_amdgcn_sched_barrier(0);     \
                    if (inter[rg]) soft_step64<false>(sc, 64 * j + 8 * fq, (WIN) ? t - 511 : 0, t, rb[rg], mS[rg], lS[rg], oS[rg], pf0, pf1); \
                    else soft_step64<true>(sc, 64 * j + 8 * fq, (WIN) ? t - 511 : 0, t, rb[rg], mS[rg], lS[rg], oS[rg], pf0, pf1); \
                    __builtin_amdgcn_sched_barrier(0); \
                    _Pragma("unroll") for (int nt = 1; nt < 4; ++nt) { vf[2 * nt] = *(const bf16x8*)(Vt + offA + nt * 2048); vf[2 * nt + 1] = *(const bf16x8*)(Vt + offB + nt * 2048); } \
                    __builtin_amdgcn_sched_barrier(0); \
                    _Pragma("unroll") for (int nt = 0; nt < 4; ++nt) { oS[rg][nt] = MFMA16(vf[2 * nt], pf0, oS[rg][nt]); oS[rg][nt] = MFMA16(vf[2 * nt + 1], pf1, oS[rg][nt]); } \
                } } \
                RG_SIGNAL(flg + 8 + slot); } while (0)
#define ST_STAGE(s_, WIN) do { \
                if ((((s_) + 1) & 7) == wave && (s_) >= 1 && (s_) + 1 < np_) DMA_PUBLISH((s_) + 1);            \
                if ((((s_) + 2) & 7) == wave && (s_) + 2 < np_) DMA_ISSUE((s_) + 2); \
                ST_COMPUTE(s_, WIN); } while (0)
            const int np_ = n >> 1, nps_ = nslc_ >> 1;
            if (wave < 2 && wave < np_) { DMA_ISSUE(wave); DMA_PUBLISH(wave); }
            for (int s = 0; s < nps_; ++s) ST_STAGE(s, false);
#pragma unroll
            for (int rg = 0; rg < 2; ++rg) {
                const size_t qrow = (size_t)(b * SEQ + tr[rg]);
                const float a1 = NG[qrow * 24 + 8 + head] / lS[rg];
#pragma unroll
                for (int nt = 0; nt < 4; ++nt) { unsigned* op = (unsigned*)(OCMP + qrow * 512 + head * 64 + 16 * nt + 4 * fq);
                    const unsigned w0 = op[0], w1 = op[1];
                    const float r0 = __uint_as_float(w0 << 16) + a1 * oS[rg][nt][0], r1 = __uint_as_float(w0 & 0xffff0000u) + a1 * oS[rg][nt][1];
                    const float r2 = __uint_as_float(w1 << 16) + a1 * oS[rg][nt][2], r3 = __uint_as_float(w1 & 0xffff0000u) + a1 * oS[rg][nt][3];
                    if (rep == args.rep[2] - 1) { op[0] = cvt_pk_bf16(r0, r1); op[1] = cvt_pk_bf16(r2, r3); }
                    oS[rg][nt] = (f32x4){0.f, 0.f, 0.f, 0.f}; }
                mS[rg] = NEGBIG; lS[rg] = 0.f;
            }
            asm volatile("s_waitcnt vmcnt(0)" ::: "memory");
            for (int s = nps_; s < np_; ++s) ST_STAGE(s, true);
#pragma unroll
            for (int rg = 0; rg < 2; ++rg) {
                const size_t qrow = (size_t)(b * SEQ + tr[rg]);
                const float a2 = NG[qrow * 24 + 16 + head] / lS[rg];
#pragma unroll
                for (int nt = 0; nt < 4; ++nt) { unsigned* op = (unsigned*)(OCMP + qrow * 512 + head * 64 + 16 * nt + 4 * fq);
                    const unsigned w0 = op[0], w1 = op[1];
                    const float r0 = __uint_as_float(w0 << 16) + a2 * oS[rg][nt][0], r1 = __uint_as_float(w0 & 0xffff0000u) + a2 * oS[rg][nt][1];
                    const float r2 = __uint_as_float(w1 << 16) + a2 * oS[rg][nt][2], r3 = __uint_as_float(w1 & 0xffff0000u) + a2 * oS[rg][nt][3];
                    if (rep == args.rep[2] - 1) { op[0] = cvt_pk_bf16(r0, r1); op[1] = cvt_pk_bf16(r2, r3); } }
            }
            LDS_WAIT();
        }
    }
    __syncthreads();
#ifndef SWA_MUL
#define SWA_MUL 1
#endif
    {
        constexpr int RS = 72;
        bf16_t* Kb = (bf16_t*)lds; bf16_t* Vb = (bf16_t*)(lds + 2 * 64 * RS * 2);
        const int skr = tid >> 3, sc8 = (tid & 7) * 8;
        const int krow = (skr & 32) + (((skr & 7) < 4) ? (4 * ((skr & 31) >> 3) + (skr & 7)) : (16 + 4 * ((skr & 31) >> 3) + (skr & 7) - 4));
        for (int rep = 0, nrepS = args.rep[2] * SWA_MUL; rep < nrepS; ++rep)
        for (int wu = blockIdx.x; wu < 512; wu += G) {
            const int b = wu >> 8, t0w = (wu & 255) * 32, t0 = t0w + 4 * wave;
            const int tl = fr >> 3, h = fr & 7;
            const bf16_t* Kp = SK + (size_t)b * SEQ * 64; const bf16_t* Vp = SVT + (size_t)b * 64 * SEQ;
            bf16x8 qf[2][2]; int tr[2]; float mS[2], lS[2]; f32x4 oS[2][4];
#pragma unroll
            for (int rg = 0; rg < 2; ++rg) { tr[rg] = t0 + 2 * rg + tl; const size_t qrow = (size_t)(b * SEQ + tr[rg]);
                qf[rg][0] = *(const bf16x8*)(SQ + qrow * 512 + h * 64 + 8 * fq); qf[rg][1] = *(const bf16x8*)(SQ + qrow * 512 + h * 64 + 32 + 8 * fq);
                mS[rg] = NEGBIG; lS[rg] = 0.f;
#pragma unroll
                for (int nt = 0; nt < 4; ++nt) oS[rg][nt] = (f32x4){0.f, 0.f, 0.f, 0.f}; }
            const int jlo = (t0w - 127 > 0 ? t0w - 127 : 0) >> 6, n = ((t0w + 31) >> 6) - jlo + 1;
            u32x4 kreg, vreg;
#define SW_LOAD(j_) do { kreg = *(const u32x4*)(Kp + (size_t)(64 * (j_) + skr) * 64 + sc8); vreg = *(const u32x4*)(Vp + (size_t)skr * SEQ + 64 * (j_) + sc8); } while (0)
#define SW_WRITE(bufi) do { *(u32x4*)(Kb + (bufi) * 64 * RS + krow * RS + sc8) = kreg; *(u32x4*)(Vb + (bufi) * 64 * RS + skr * RS + sc8) = vreg; } while (0)
            SW_LOAD(jlo); SW_WRITE(0);
            __syncthreads();
            for (int s = 0; s < n; ++s) {
                const int j = jlo + s;
                if (s + 1 < n) SW_LOAD(j + 1);
                const bf16_t* Kt = Kb + (s & 1) * 64 * RS; const bf16_t* Vt = Vb + (s & 1) * 64 * RS;
#pragma unroll
                for (int rg = 0; rg < 2; ++rg) {
                    const int t0g = t0 + 2 * rg, t = tr[rg];
                    const bool act = (64 * j + 63 >= t0g - 127) && (64 * j <= t0g + 1), inter = (64 * j >= t0g + 1 - 127) && (64 * j + 63 <= t0g);
                    if (act) {
                        f32x4 sc[4]; bf16x8 pf0, pf1;
                        { const bf16_t* ka = Kt + fr * RS + 8 * fq; const f32x4 z_ = {0.f, 0.f, 0.f, 0.f};
#pragma unroll
                          for (int q_ = 0; q_ < 4; ++q_) { const bf16x8 ka0 = *(const bf16x8*)(ka + 16 * q_ * RS), ka1 = *(const bf16x8*)(ka + 16 * q_ * RS + 32);
                              sc[q_] = MFMA16(ka0, qf[rg][0], z_); sc[q_] = MFMA16(ka1, qf[rg][1], sc[q_]); } }
                        if (inter) soft_step64<false>(sc, 64 * j + 8 * fq, t - 127, t, 0.f, mS[rg], lS[rg], oS[rg], pf0, pf1);
                        else soft_step64<true>(sc, 64 * j + 8 * fq, t - 127, t, 0.f, mS[rg], lS[rg], oS[rg], pf0, pf1);
                        { const bf16_t* va = Vt + fr * RS + 8 * fq;
#pragma unroll
                          for (int nt = 0; nt < 4; ++nt) { const bf16x8 va0 = *(const bf16x8*)(va + 16 * nt * RS), va1 = *(const bf16x8*)(va + 16 * nt * RS + 32);
                              oS[rg][nt] = MFMA16(va0, pf0, oS[rg][nt]); oS[rg][nt] = MFMA16(va1, pf1, oS[rg][nt]); } }
                    }
                }
                if (s + 1 < n) SW_WRITE((s + 1) & 1);
                __syncthreads();
            }
#pragma unroll
            for (int rg = 0; rg < 2; ++rg) {
                const size_t qrow = (size_t)(b * SEQ + tr[rg]);
                const float sink2 = args.in[14][h] * LOG2E, mf = fmaxf(mS[rg], sink2), aa = fast_exp2(mS[rg] - mf), lt = lS[rg] * aa + fast_exp2(sink2 - mf), scl = aa / lt;
#pragma unroll
                for (int nt = 0; nt < 4; ++nt) { unsigned* op = (unsigned*)(OB + qrow * 512 + h * 64 + 16 * nt + 4 * fq);
                    if (rep == nrepS - 1) { op[0] = cvt_pk_bf16(oS[rg][nt][0] * scl, oS[rg][nt][1] * scl); op[1] = cvt_pk_bf16(oS[rg][nt][2] * scl, oS[rg][nt][3] * scl); } }
            }
        }
    }
    GRID_SYNC();
    if (DBG_STOP == 5) DUMP_LOOP(bf2f(OCMP[i_ & 8388607]) + bf2f(SQ[i_ & 8388607]));
    if (DBG_STOP == 10) DUMP_LOOP(bf2f(GA[i_]) + bf2f(GB[i_]));

#if !defined(DBG_SKIP_PASS1)
    { pg8::Gemm g{OCMP, WA, TOK, DM, 512}; pg8::StaticOrder S; S.init(TOK, DM, G, (int)blockIdx.x);
      pg8::EpiMerge<1> E{GA, nullptr};
      pg8::gemm_phase<pg8::EpiMerge<1>, pg8::StaticOrder, true, true>(ldsl, g, S, E); }
    if (DBG_STOP == 8) { GRID_SYNC(); DUMP_LOOP(bf2f(GA[i_])); }
    if (DBG_STOP == 9) GRID_SYNC();
#endif
#if !defined(DBG_SKIP_PASS2)
    { pg8::Gemm g{OB, WB, TOK, DM, 512}; pg8::StaticOrder S; S.init(TOK, DM, G, (int)blockIdx.x);
      pg8::EpiMerge<2> E{GA, GB};
      pg8::gemm_phase<pg8::EpiMerge<2>, pg8::StaticOrder, true, true>(ldsl, g, S, E); }
#endif
    GRID_SYNC();
    if (DBG_STOP == 6) DUMP_LOOP(bf2f(GA[i_]));
    { pg8::Gemm g{GA, WOUT, TOK, DM, DM}; pg8::StaticOrder S; S.init(TOK, DM, G, (int)blockIdx.x);
#if defined(DBG_NOFFN1)
      pg8::EpiResid E{x, H, XB, SSQ2, 1.0f};
#else
      pg8::EpiResid E{H, H, XB, SSQ2, 1.0f};
#endif
      pg8::gemm_phase<pg8::EpiResid, pg8::StaticOrder, true, true>(ldsl, g, S, E); }
    GRID_SYNC();
    if (DBG_STOP == 7) return;
    { pg8::Gemm g{XB, W2GU, TOK, 2 * DFF, DM}; pg8::StaticOrder S; S.init(TOK, 2 * DFF, G, (int)blockIdx.x);
      pg8::EpiSwiglu E{ACT, SSQ2};
      pg8::gemm_phase<pg8::EpiSwiglu, pg8::StaticOrder, true, true>(ldsl, g, S, E); }
    GRID_SYNC();
    if (G == 256) {
        pg8::Gemm g{ACT, W2D, TOK, DM, DFF}; pg8::StaticOrder S; S.init(TOK, DM, G, (int)blockIdx.x);
        pg8::EpiFinal E{H, H, SSQ3, args.in[22], (unsigned*)(ws + WS_BAR) + 3520, 0.5f};
        pg8::gemm_phase<pg8::EpiFinal, pg8::StaticOrder, true, true>(ldsl, g, S, E);
    } else {
        { pg8::Gemm g{ACT, W2D, TOK, DM, DFF}; pg8::StaticOrder S; S.init(TOK, DM, G, (int)blockIdx.x);
          pg8::EpiResid E{H, H, nullptr, SSQ3, 0.5f};
          pg8::gemm_phase<pg8::EpiResid, pg8::StaticOrder, true, true>(ldsl, g, S, E); }
        GRID_SYNC();
        const float* gf = args.in[22];
        for (int mrow = gw; mrow < TOK; mrow += NGW) {
            const float rs = pg8::rstd_of(SSQ3, mrow);
            f32x4* hr = (f32x4*)(H + (size_t)mrow * DM) + lane; const f32x4* gr = (const f32x4*)gf + lane;
#pragma unroll
            for (int j = 0; j < 4; ++j) { const f32x4 v = hr[64 * j], gg = gr[64 * j]; hr[64 * j] = v * rs * gg; }
        }
    }
}

extern "C" void kernel_launch(void* const* d_in, const int* in_sizes, int n_in, void* d_out, int out_size, void* d_ws, size_t ws_size, hipStream_t stream) {
    static int grid = 0;
    if (grid == 0) {
        int dev = 0, cus = 0, per_cu = 0;
        hipGetDevice(&dev);
        hipDeviceGetAttribute(&cus, hipDeviceAttributeMultiprocessorCount, dev);
        hipFuncSetAttribute((const void*)nsa_fwd, hipFuncAttributeMaxDynamicSharedMemorySize, LDS_BYTES);
        hipOccupancyMaxActiveBlocksPerMultiprocessor(&per_cu, (const void*)nsa_fwd, NWAVES * 64, LDS_BYTES);
        (void)hipGetLastError();
        if (per_cu < 1) per_cu = 1;
        grid = cus;
        if (n_in != 23 || ws_size < WS_END) { fprintf(stderr, "kernel_launch: unexpected n_in %d / ws %zu\n", n_in, ws_size); }
    }
    if (hipMemsetAsync((char*)d_ws + WS_BAR, 0, BAR_BYTES, stream) != hipSuccess) fprintf(stderr, "kernel_launch: memset of barrier words failed\n");
    Args a{};
    for (int i = 0; i < 23; ++i) a.in[i] = (const float*)d_in[i];
    a.out = (float*)d_out; a.ws = (unsigned char*)d_ws;
#ifndef REP4
#define REP4 1
#endif
#ifndef REP5
#define REP5 1
#endif
#ifndef REP6
#define REP6 1
#endif
#ifndef REPG
#define REPG 0
#endif
    a.rep[0] = REP4; a.rep[1] = REP5; a.rep[2] = REP6; a.rep[3] = REPG;
    void* kargs[] = {&a};
    hipError_t e = hipLaunchCooperativeKernel((const void*)nsa_fwd, dim3(grid), dim3(NWAVES * 64), kargs, LDS_BYTES, stream);
    if (e != hipSuccess) fprintf(stderr, "cooperative launch failed: %s (grid %d)\n", hipGetErrorString(e), grid);
}
```

```cpp
#include <hip/hip_runtime.h>
#include <hip/hip_cooperative_groups.h>
#include <cstdio>
#include <cstdint>
namespace cg = cooperative_groups;

constexpr int SEQ = 8192, NB = 2, TOK = NB * SEQ, DM = 1024, DFF = 2816;
constexpr float RMS_EPS = 1e-6f;
constexpr float LOG2E = 1.4426950408889634f;
constexpr float C2 = 0.125f * 1.4426950408889634f;
namespace pg8 {
#define PG8_LAS __attribute__((address_space(3)))
typedef unsigned short bf16_t;
typedef short bf16x8 __attribute__((ext_vector_type(8)));
typedef float f32x4 __attribute__((ext_vector_type(4)));
typedef unsigned u32x4 __attribute__((ext_vector_type(4)));
constexpr int BM = 256, BK = 64, HALF = 128, HTB = HALF * BK * 2  , STAGE_BYTES = 8 * HTB, NXCD = 8, WGM = 8;

__host__ __device__ __forceinline__ int lds_byte(int r, int c) { const int st = (r >> 4) * 2 + (c >> 5), rr = r & 15, cc = c & 31, ob = rr * 64 + cc * 2; return st * 1024 + (ob ^ (((ob >> 9) & 1) << 5)); }
__host__ __device__ __forceinline__ void stage_rc(int b, int& R, int& C) { const int st = b / 1024, sb = b % 1024, swz = sb ^ (((sb >> 9) & 1) << 5); R = (st >> 1) * 16 + swz / 64; C = (st & 1) * 32 + (swz % 64) / 2; }
__host__ __device__ __forceinline__ int perm32(int rho) { const int n = rho >> 4, i = rho & 15; return 8 * (i >> 2) + 4 * n + (i & 3); }

struct Unit { int pm, pn; };
struct Gemm { const bf16_t* A; const bf16_t* Bt; int M, N, K; };

struct StaticOrder {
    int nM, nN, nwg, G, c;
    __host__ __device__ void init(int M, int N, int G_, int c_) { nM = M / BM; nN = N / BM; nwg = nM * nN; G = G_; c = c_; }
    __host__ __device__ bool next(int i, Unit& u) const {
        const long L = (long)i * G + c; if (L >= nwg) return false;
        int wgid = (int)L; { const int q = nwg / NXCD, r = nwg % NXCD, xcd = wgid % NXCD, off = wgid / NXCD; wgid = (xcd < r ? xcd * (q + 1) : r * (q + 1) + (xcd - r) * q) + off; }
        const int nig = WGM * nN, gid = wgid / nig, fm = gid * WGM, gsz = (nM - fm) < WGM ? (nM - fm) : WGM;
        u.pm = fm + ((wgid % nig) % gsz); u.pn = (wgid % nig) / gsz; return true;
    }
    __device__ __forceinline__ void a_ready(const Unit&) const {}
    __device__ __forceinline__ void done(const Unit&) const {}
};

typedef __bf16 bf16x2n __attribute__((ext_vector_type(2)));
typedef float f32x2n __attribute__((ext_vector_type(2)));
__device__ __forceinline__ unsigned cvt_pk_bf16(float lo, float hi) { const f32x2n v = {lo, hi}; return __builtin_bit_cast(unsigned, __builtin_convertvector(v, bf16x2n)); }
typedef float f32x2 __attribute__((ext_vector_type(2)));
__device__ __forceinline__ float fast_rcp(float x) { return __builtin_amdgcn_rcpf(x); }
__device__ __forceinline__ float fast_exp2(float x) { return __builtin_amdgcn_exp2f(x); }
__device__ __forceinline__ float sigmoidf_(float x) { return fast_rcp(1.0f + fast_exp2(-x * 1.4426950408889634f)); }
__device__ __forceinline__ float bf2f(unsigned short b) { return __uint_as_float(((unsigned)b) << 16); }
__device__ __forceinline__ u32x4 pack8(f32x4 a, f32x4 b) { u32x4 w; w.x = cvt_pk_bf16(a[0], a[1]); w.y = cvt_pk_bf16(a[2], a[3]); w.z = cvt_pk_bf16(b[0], b[1]); w.w = cvt_pk_bf16(b[2], b[3]); return w; }
__device__ __forceinline__ float rstd_of(const float* ssq, int row) {
    const f32x4* p = (const f32x4*)(ssq + (size_t)row * 16); const f32x4 a = p[0], b = p[1], c = p[2], d = p[3];
    const float s = (((a[0] + a[1]) + (a[2] + a[3])) + ((b[0] + b[1]) + (b[2] + b[3]))) + (((c[0] + c[1]) + (c[2] + c[3])) + ((d[0] + d[1]) + (d[2] + d[3])));
    return 1.0f / sqrtf(s * (1.0f / 1024.0f) + 1e-6f); }

template <bool NT> __device__ __forceinline__ float rstd_row(const float* ssq, int row) {
    const f32x4* p = (const f32x4*)(ssq + (size_t)row * 16);
    const f32x4 a = NT ? __builtin_nontemporal_load(p) : p[0], b = NT ? __builtin_nontemporal_load(p + 1) : p[1], c = NT ? __builtin_nontemporal_load(p + 2) : p[2], d = NT ? __builtin_nontemporal_load(p + 3) : p[3];
    const float s = (((a[0] + a[1]) + (a[2] + a[3])) + ((b[0] + b[1]) + (b[2] + b[3]))) + (((c[0] + c[1]) + (c[2] + c[3])) + ((d[0] + d[1]) + (d[2] + d[3])));
    return 1.0f / sqrtf(s * (1.0f / 1024.0f) + 1e-6f); }
template <bool NT> __device__ __forceinline__ void wave_rstd8(const float* ssq, int rowbase, float (&rs)[2][4]) {
    const int lane = threadIdx.x & 63;
    const float v0 = rstd_row<NT>(ssq, rowbase + lane), v1 = rstd_row<NT>(ssq, rowbase + HALF + lane);
#pragma unroll
    for (int m = 0; m < 4; ++m) { rs[0][m] = __shfl(v0, m * 16 + (lane & 15)); rs[1][m] = __shfl(v1, m * 16 + (lane & 15)); }
}

struct EpiSwiglu {
    static constexpr bool PERM = true, AFTER_DRAIN = false;
    bf16_t* O; const float* ssq;
    __device__ __forceinline__ void operator()(const f32x4 (&acc)[2][2][4][2], const Unit& u, int wr, int wc, int fr, int fq) const {
        asm volatile("" : "+v"(fr), "+v"(fq));
        const int row0 = u.pm * BM + wr * 64 + fr, col0 = u.pn * 128 + wc * 32 + 8 * fq;
        float rsv[2][4]; wave_rstd8<false>(ssq, u.pm * BM + wr * 64, rsv);
#pragma unroll
        for (int ai = 0; ai < 2; ++ai)
#pragma unroll
            for (int m = 0; m < 4; ++m) {
                const int row = row0 + ai * HALF + m * 16; const float rs = rsv[ai][m];
                f32x4 o[2];
#pragma unroll
                for (int n = 0; n < 2; ++n) {
                    const f32x4 g = acc[ai][0][m][n] * rs, up = acc[ai][1][m][n] * rs;
#pragma unroll
                    for (int j = 0; j < 4; ++j) o[n][j] = g[j] * sigmoidf_(g[j]) * up[j];
                }
                *(u32x4*)(O + (size_t)row * 2816 + col0) = pack8(o[0], o[1]);
            }
    }
};

struct EpiResid {
    static constexpr bool PERM = true, AFTER_DRAIN = false;
    const float* base; float* out; bf16_t* xb; float* ssq; float scale;
    __device__ __forceinline__ void operator()(const f32x4 (&acc)[2][2][4][2], const Unit& u, int wr, int wc, int fr, int fq) const {
        asm volatile("" : "+v"(fr), "+v"(fq));
        const int row0 = u.pm * BM + wr * 64 + fr, col0 = u.pn * BM + wc * 32 + 8 * fq;
        f32x4 nb[2][2];
#pragma unroll
        for (int bj = 0; bj < 2; ++bj) { const size_t off = (size_t)row0 * 1024 + col0 + bj * HALF; nb[bj][0] = *(const f32x4*)(base + off); nb[bj][1] = *(const f32x4*)(base + off + 4); }
#pragma unroll
        for (int it = 0; it < 8; ++it) {
            const int ai = it >> 2, m = it & 3;
            const int row = row0 + ai * HALF + m * 16; float s = 0.f;
            f32x4 cb[2][2];
#pragma unroll
            for (int bj = 0; bj < 2; ++bj) { cb[bj][0] = nb[bj][0]; cb[bj][1] = nb[bj][1]; }
            if (it < 7) { const int rown = row0 + ((it + 1) >> 2) * HALF + ((it + 1) & 3) * 16;
#pragma unroll
                for (int bj = 0; bj < 2; ++bj) { const size_t off = (size_t)rown * 1024 + col0 + bj * HALF; nb[bj][0] = *(const f32x4*)(base + off); nb[bj][1] = *(const f32x4*)(base + off + 4); } }
#pragma unroll
            for (int bj = 0; bj < 2; ++bj) {
                const size_t off = (size_t)row * 1024 + col0 + bj * HALF;
                const f32x4 h0 = cb[bj][0] + acc[ai][bj][m][0] * scale, h1 = cb[bj][1] + acc[ai][bj][m][1] * scale;
                *(f32x4*)(out + off) = h0; *(f32x4*)(out + off + 4) = h1;
                if (xb) *(u32x4*)(xb + off) = pack8(h0, h1);
                s += (h0[0] * h0[0] + h0[1] * h0[1]) + (h0[2] * h0[2] + h0[3] * h0[3]) + (h1[0] * h1[0] + h1[1] * h1[1]) + (h1[2] * h1[2] + h1[3] * h1[3]);
            }
            s += __shfl_xor(s, 16); s += __shfl_xor(s, 32);
            if (fq == 0) ssq[(size_t)row * 16 + u.pn * 4 + wc] = s;
            asm volatile("" ::: "memory");
        }
    }
};

template <int PASS> struct EpiMerge {
    static constexpr bool PERM = true, AFTER_DRAIN = false;
    bf16_t* G; const bf16_t* G2;
    __device__ __forceinline__ void operator()(const f32x4 (&acc)[2][2][4][2], const Unit& u, int wr, int wc, int fr, int fq) const {
        asm volatile("" : "+v"(fr), "+v"(fq));
        const int row0 = u.pm * BM + wr * 64 + fr, col0 = u.pn * BM + wc * 32 + 8 * fq;
        unsigned ng[2][4]; u32x4 ng2[2];
#define EPM_LOAD(rw) do { _Pragma("unroll") for (int bj = 0; bj < 2; ++bj) { const size_t off_ = (size_t)(rw) * 1024 + col0 + bj * HALF; unsigned* gp_ = (unsigned*)(G + off_); \
            _Pragma("unroll") for (int q = 0; q < 4; ++q) ng[bj][q] = __hip_atomic_load(gp_ + q, __ATOMIC_RELAXED, __HIP_MEMORY_SCOPE_AGENT); \
            if (PASS == 2) ng2[bj] = *(const u32x4*)(G2 + off_); } } while (0)
        EPM_LOAD(row0);
#pragma unroll
        for (int it = 0; it < 8; ++it) {
            const int ai = it >> 2, m = it & 3;
            const int row = row0 + ai * HALF + m * 16;
            unsigned gw[2][4]; u32x4 g2[2];
#pragma unroll
            for (int bj = 0; bj < 2; ++bj) { g2[bj] = ng2[bj];
#pragma unroll
                for (int q = 0; q < 4; ++q) gw[bj][q] = ng[bj][q]; }
            if (it < 7) { const int rown = row0 + ((it + 1) >> 2) * HALF + ((it + 1) & 3) * 16; EPM_LOAD(rown); }
#pragma unroll
            for (int bj = 0; bj < 2; ++bj) {
                const size_t off = (size_t)row * 1024 + col0 + bj * HALF;
                f32x4 r0, r1;
#pragma unroll
                for (int q = 0; q < 2; ++q) {
                    const float glo = __uint_as_float(gw[bj][q] << 16), ghi = __uint_as_float(gw[bj][q] & 0xffff0000u), hlo = __uint_as_float(gw[bj][2 + q] << 16), hhi = __uint_as_float(gw[bj][2 + q] & 0xffff0000u);
                    if (PASS == 1) { r0[2 * q] = glo * acc[ai][bj][m][0][2 * q]; r0[2 * q + 1] = ghi * acc[ai][bj][m][0][2 * q + 1]; r1[2 * q] = hlo * acc[ai][bj][m][1][2 * q]; r1[2 * q + 1] = hhi * acc[ai][bj][m][1][2 * q + 1]; }
                    else { const unsigned a_ = g2[bj][q], b_ = g2[bj][2 + q];
                        r0[2 * q] = glo + __uint_as_float(a_ << 16) * acc[ai][bj][m][0][2 * q]; r0[2 * q + 1] = ghi + __uint_as_float(a_ & 0xffff0000u) * acc[ai][bj][m][0][2 * q + 1];
                        r1[2 * q] = hlo + __uint_as_float(b_ << 16) * acc[ai][bj][m][1][2 * q]; r1[2 * q + 1] = hhi + __uint_as_float(b_ & 0xffff0000u) * acc[ai][bj][m][1][2 * q + 1]; }
                }
                *(u32x4*)(G + off) = pack8(r0, r1);
            }
            asm volatile("" ::: "memory");
        }
#undef EPM_LOAD
    }
};

__device__ __forceinline__ void rope8(f32x4& v0, f32x4& v1, const f32x4 c, const f32x4 s) {
    f32x4 a, b;
    a[0] = v0[0] * c[0] - v0[1] * s[0]; a[1] = v0[1] * c[0] + v0[0] * s[0];
    a[2] = v0[2] * c[1] - v0[3] * s[1]; a[3] = v0[3] * c[1] + v0[2] * s[1];
    b[0] = v1[0] * c[2] - v1[1] * s[2]; b[1] = v1[1] * c[2] + v1[0] * s[2];
    b[2] = v1[2] * c[3] - v1[3] * s[3]; b[3] = v1[3] * c[3] + v1[2] * s[3];
    v0 = a; v1 = b;
}
__device__ __forceinline__ void store_t8(bf16_t* p, size_t stride, f32x4 v0, f32x4 v1) {
    const u32x4 w = pack8(v0, v1);
    p[0] = (bf16_t)(w.x & 0xffffu); p[stride] = (bf16_t)(w.x >> 16); p[2 * stride] = (bf16_t)(w.y & 0xffffu); p[3 * stride] = (bf16_t)(w.y >> 16);
    p[4 * stride] = (bf16_t)(w.z & 0xffffu); p[5 * stride] = (bf16_t)(w.z >> 16); p[6 * stride] = (bf16_t)(w.w & 0xffffu); p[7 * stride] = (bf16_t)(w.w >> 16);
}

struct EpiProj {
    static constexpr bool PERM = true, AFTER_DRAIN = false;
    const float* ssq; const float* ropeC; const float* ropeS;
    bf16_t *NQ, *KC, *VC, *KSL, *VSLT, *KWN, *VWNT, *SQ, *SK, *SVT, *GA, *GB; float* NG;
    __device__ __forceinline__ void operator()(const f32x4 (&acc)[2][2][4][2], const Unit& u, int wr, int wc, int fr, int fq) const {
        asm volatile("" : "+v"(fr), "+v"(fq));
        const int pn = u.pn;
        const int row0 = u.pm * BM + wr * 64 + fr;
        const int cw0 = wc * 32 + 8 * fq;
        float rsv[2][4]; wave_rstd8<false>(ssq, u.pm * BM + wr * 64, rsv);
        const bool need_rope = pn < 2 || (pn >= 3 && pn <= 6) || pn == 15;
        f32x4 ncs = {0.f, 0.f, 0.f, 0.f}, nsn = {0.f, 0.f, 0.f, 0.f};
        if (need_rope) { ncs = *(const f32x4*)(ropeC + (size_t)row0 * 32 + ((cw0 & 63) >> 1)); nsn = *(const f32x4*)(ropeS + (size_t)row0 * 32 + ((cw0 & 63) >> 1)); }
#pragma unroll
        for (int ai = 0; ai < 2; ++ai)
#pragma unroll
            for (int m = 0; m < 4; ++m) {
                const int row = row0 + ai * HALF + m * 16; const float rs = rsv[ai][m];
                const int b = row >> 13, s = row & 8191;
                const f32x4 cs = ncs, sn = nsn;
                if (need_rope && (ai * 4 + m) < 7) { const int rown = row0 + ((ai * 4 + m + 1) >> 2) * HALF + ((ai * 4 + m + 1) & 3) * 16;
                    ncs = *(const f32x4*)(ropeC + (size_t)rown * 32 + ((cw0 & 63) >> 1)); nsn = *(const f32x4*)(ropeS + (size_t)rown * 32 + ((cw0 & 63) >> 1)); }
#pragma unroll
                for (int bj = 0; bj < 2; ++bj) {
                    f32x4 v0 = acc[ai][bj][m][0] * rs, v1 = acc[ai][bj][m][1] * rs;
                    const int cw = bj * HALF + cw0;
                    if (pn < 2) { rope8(v0, v1, cs, sn); *(u32x4*)(NQ + (size_t)row * 512 + pn * 256 + cw) = pack8(v0, v1); }
                    else if (pn == 2) { bf16_t* dst = bj == 0 ? KC : VC; const int g = cw0 >> 6, d = cw0 & 63;
                        *(u32x4*)(dst + ((size_t)(b * 2 + g) * SEQ + s) * 64 + d) = pack8(v0, v1); }
                    else if (pn <= 4) { const int g = cw0 >> 6, d = cw0 & 63;
                        if (bj == 0) { rope8(v0, v1, cs, sn); bf16_t* dst = pn == 3 ? KSL : KWN; *(u32x4*)(dst + ((size_t)(b * 2 + g) * SEQ + s) * 64 + d) = pack8(v0, v1); }
                        else { bf16_t* dst = pn == 3 ? VSLT : VWNT; store_t8(dst + ((size_t)(b * 2 + g) * 64 + d) * SEQ + s, SEQ, v0, v1); } }
                    else if (pn <= 6) { rope8(v0, v1, cs, sn);
                        const u32x4 w = pack8(v0, v1); unsigned long long* qp = (unsigned long long*)(SQ + (size_t)row * 512 + (pn - 5) * 256 + cw);
                        __hip_atomic_store(qp, (unsigned long long)w.x | ((unsigned long long)w.y << 32), __ATOMIC_RELAXED, __HIP_MEMORY_SCOPE_AGENT);
                        __hip_atomic_store(qp + 1, (unsigned long long)w.z | ((unsigned long long)w.w << 32), __ATOMIC_RELAXED, __HIP_MEMORY_SCOPE_AGENT); }
                    else if (pn <= 14) { bf16_t* dst = pn <= 10 ? GA : GB; const int c = ((pn - 7) & 3) * 256 + cw;
#pragma unroll
                        for (int j = 0; j < 4; ++j) { v0[j] = sigmoidf_(v0[j]); v1[j] = sigmoidf_(v1[j]); }
                        *(u32x4*)(dst + (size_t)row * 1024 + c) = pack8(v0, v1); }
                    else {
                        if (bj == 0) {
                            if (cw0 < 64) { rope8(v0, v1, cs, sn); *(u32x4*)(SK + (size_t)row * 64 + cw0) = pack8(v0, v1); }
                            else store_t8(SVT + ((size_t)b * 64 + (cw0 - 64)) * SEQ + s, SEQ, v0, v1);
                        } else if (cw0 < 24) {
#pragma unroll
                            for (int j = 0; j < 4; ++j) { v0[j] = sigmoidf_(v0[j]); v1[j] = sigmoidf_(v1[j]); }
                            *(f32x4*)(NG + (size_t)row * 24 + cw0) = v0; *(f32x4*)(NG + (size_t)row * 24 + cw0 + 4) = v1;
                        }
                    }
                    asm volatile("" ::: "memory");
                }
            }
    }
};

struct EpiDry {
    static constexpr bool PERM = true, AFTER_DRAIN = false;
    float* sink; int flag;
    __device__ __forceinline__ void operator()(const f32x4 (&acc)[2][2][4][2], const Unit& u, int wr, int wc, int fr, int fq) const {
        if (flag) { f32x4 s = {0.f, 0.f, 0.f, 0.f};
#pragma unroll
            for (int ai = 0; ai < 2; ++ai)
#pragma unroll
                for (int bj = 0; bj < 2; ++bj)
#pragma unroll
                    for (int m = 0; m < 4; ++m) s += acc[ai][bj][m][0] + acc[ai][bj][m][1];
            *(f32x4*)(sink + (size_t)(u.pm * 4 + u.pn) * 4) = s; }
    }
};

struct EpiFinal {
    static constexpr bool PERM = true, AFTER_DRAIN = false;
    const float* base; float* out; float* ssq; const float* gain; unsigned* cnt; float scale;
    __device__ __forceinline__ void operator()(f32x4 (&acc)[2][2][4][2], const Unit& u, int wr, int wc, int fr, int fq) const {
        asm volatile("" : "+v"(fr), "+v"(fq));
        const int row0 = u.pm * BM + wr * 64 + fr, col0 = u.pn * BM + wc * 32 + 8 * fq;
        f32x4 nb[2][2];
#pragma unroll
        for (int bj = 0; bj < 2; ++bj) { const size_t off = (size_t)row0 * 1024 + col0 + bj * HALF; nb[bj][0] = *(const f32x4*)(base + off); nb[bj][1] = *(const f32x4*)(base + off + 4); }
#pragma unroll
        for (int it = 0; it < 8; ++it) {
            const int ai = it >> 2, m = it & 3;
            const int row = row0 + ai * HALF + m * 16; float s = 0.f;
            f32x4 cb[2][2];
#pragma unroll
            for (int bj = 0; bj < 2; ++bj) { cb[bj][0] = nb[bj][0]; cb[bj][1] = nb[bj][1]; }
            if (it < 7) { const int rown = row0 + ((it + 1) >> 2) * HALF + ((it + 1) & 3) * 16;
#pragma unroll
                for (int bj = 0; bj < 2; ++bj) { const size_t off = (size_t)rown * 1024 + col0 + bj * HALF; nb[bj][0] = *(const f32x4*)(base + off); nb[bj][1] = *(const f32x4*)(base + off + 4); } }
#pragma unroll
            for (int bj = 0; bj < 2; ++bj) {
                const f32x4 h0 = cb[bj][0] + acc[ai][bj][m][0] * scale, h1 = cb[bj][1] + acc[ai][bj][m][1] * scale;
                acc[ai][bj][m][0] = h0; acc[ai][bj][m][1] = h1;
                s += (h0[0] * h0[0] + h0[1] * h0[1]) + (h0[2] * h0[2] + h0[3] * h0[3]) + (h1[0] * h1[0] + h1[1] * h1[1]) + (h1[2] * h1[2] + h1[3] * h1[3]);
            }
            s += __shfl_xor(s, 16); s += __shfl_xor(s, 32);
            if (fq == 0) __hip_atomic_store(ssq + (size_t)row * 16 + u.pn * 4 + wc, s, __ATOMIC_RELAXED, __HIP_MEMORY_SCOPE_AGENT);
            asm volatile("" ::: "memory");
        }
        f32x4 gv[2][2];
#pragma unroll
        for (int bj = 0; bj < 2; ++bj) { gv[bj][0] = *(const f32x4*)(gain + col0 + bj * HALF); gv[bj][1] = *(const f32x4*)(gain + col0 + bj * HALF + 4); }
        asm volatile("s_waitcnt vmcnt(0)" ::: "memory");
        __syncthreads();
        if (threadIdx.x == 0) {
            __hip_atomic_fetch_add(cnt + u.pm, 1u, __ATOMIC_RELAXED, __HIP_MEMORY_SCOPE_AGENT);
            while (__hip_atomic_load(cnt + u.pm, __ATOMIC_RELAXED, __HIP_MEMORY_SCOPE_AGENT) < 4u) __builtin_amdgcn_s_sleep(1);
        }
        __syncthreads();
        float rsv[2][4]; wave_rstd8<true>(ssq, u.pm * BM + wr * 64, rsv);
#pragma unroll
        for (int ai = 0; ai < 2; ++ai)
#pragma unroll
            for (int m = 0; m < 4; ++m) {
                const int row = row0 + ai * HALF + m * 16; const float rs = rsv[ai][m];
#pragma unroll
                for (int bj = 0; bj < 2; ++bj) {
                    const size_t off = (size_t)row * 1024 + col0 + bj * HALF;
                    *(f32x4*)(out + off) = acc[ai][bj][m][0] * rs * gv[bj][0]; *(f32x4*)(out + off + 4) = acc[ai][bj][m][1] * rs * gv[bj][1];
                }
            }
    }
};
template <class Epi, class Sched, bool ALIGN_EPI = false, bool SP2 = false>
__device__ __forceinline__ void gemm_phase(PG8_LAS unsigned char* lds, const Gemm g, const Sched& S, const Epi& E) {
    const int tid = threadIdx.x, wid = __builtin_amdgcn_readfirstlane(tid >> 6), lane = tid & 63, wr = wid >> 2, wc = wid & 3, fr = lane & 15, fq = lane >> 4;
    const int K = g.K, nt = K / BK;
    unsigned voffA[2], voffB[2];
#pragma unroll
    for (int i = 0; i < 2; ++i) { int R, C; stage_rc(tid * 16 + i * 8192, R, C); const int Rb = Epi::PERM ? ((R & ~31) + perm32(R & 31)) : R;
        voffA[i] = (unsigned)(R * K + C) * 2u; voffB[i] = (unsigned)(Rb * K + C) * 2u; }
    const size_t kstep = (size_t)(BK * 2);
    const size_t hstep = (size_t)HALF * K * 2;
    const size_t tstep = 2 * hstep;
    const unsigned ldsw = (unsigned)wid * 1024u;
    const int aoff = lds_byte(wr * 64 + fr, fq * 8), boff = lds_byte(wc * 32 + fr, fq * 8);
#define PG8_SA(b, h) (((b) * 2 + (h)) * HTB)
#define PG8_SB(b, h) ((4 + (b) * 2 + (h)) * HTB)
#define PG8_STAGE(bufoff, gbase, voff) do { _Pragma("unroll") for (int _i = 0; _i < 2; ++_i) \
        __builtin_amdgcn_global_load_lds((const unsigned*)((const char*)(gbase) + (voff)[_i]), (PG8_LAS unsigned*)(lds + (bufoff) + ldsw + _i * 8192), 16, 0, 0); } while (0)
#define PG8_LDA(dst, b, h) do { _Pragma("unroll") for (int m = 0; m < 4; ++m) _Pragma("unroll") for (int k = 0; k < 2; ++k) dst[m][k] = *(const PG8_LAS bf16x8*)(lds + PG8_SA(b, h) + aoff + m * 2048 + k * 1024); } while (0)
#define PG8_LDB(dst, b, h) do { _Pragma("unroll") for (int n = 0; n < 2; ++n) _Pragma("unroll") for (int k = 0; k < 2; ++k) dst[n][k] = *(const PG8_LAS bf16x8*)(lds + PG8_SB(b, h) + boff + n * 2048 + k * 1024); } while (0)
#define PG8_MMA(ai, bj, At, Bt) do { __builtin_amdgcn_s_setprio(1); _Pragma("unroll") for (int m = 0; m < 4; ++m) _Pragma("unroll") for (int n = 0; n < 2; ++n) _Pragma("unroll") for (int k = 0; k < 2; ++k) \
        acc[ai][bj][m][n] = __builtin_amdgcn_mfma_f32_16x16x32_bf16(Bt[n][k], At[m][k], acc[ai][bj][m][n], 0, 0, 0); __builtin_amdgcn_s_setprio(0); } while (0)
#define PG8_WAIT_V(n) asm volatile("s_waitcnt vmcnt(" #n ")" ::: "memory")
#define PG8_WAIT_L(n) asm volatile("s_waitcnt lgkmcnt(" #n ")" ::: "memory")
#define PG8_BAR __builtin_amdgcn_s_barrier()
#define PG8_SCHED __builtin_amdgcn_sched_barrier(0)
    Unit cur, nxt; int ui = 0;
    if (!S.next(0, cur)) return;
    f32x4 acc[2][2][4][2];
#pragma unroll
    for (int a = 0; a < 2; ++a)
#pragma unroll
        for (int b = 0; b < 2; ++b)
#pragma unroll
            for (int m = 0; m < 4; ++m)
#pragma unroll
                for (int n = 0; n < 2; ++n) acc[a][b][m][n] = (f32x4){0.f, 0.f, 0.f, 0.f};
    bf16x8 At[4][2], B0[2][2], B1[2][2];
    const char* cA = (const char*)g.A + (size_t)cur.pm * tstep; const char* cB = (const char*)g.Bt + (size_t)cur.pn * tstep;
    S.a_ready(cur);
    if constexpr (SP2) {
        PG8_STAGE(PG8_SB(0, 0), cB, voffB); PG8_STAGE(PG8_SB(0, 1), cB + hstep, voffB); PG8_STAGE(PG8_SA(0, 0), cA, voffA); PG8_STAGE(PG8_SA(0, 1), cA + hstep, voffA);
        if (wr == 1) PG8_BAR;
        PG8_WAIT_V(2); PG8_BAR;
        PG8_STAGE(PG8_SB(1, 0), cB + kstep, voffB); PG8_STAGE(PG8_SA(1, 0), cA + kstep, voffA); PG8_STAGE(PG8_SB(1, 1), cB + hstep + kstep, voffB);
        PG8_WAIT_V(6); PG8_BAR;
    } else {
        PG8_STAGE(PG8_SB(0, 0), cB, voffB); PG8_STAGE(PG8_SA(0, 0), cA, voffA); PG8_STAGE(PG8_SB(0, 1), cB + hstep, voffB); PG8_STAGE(PG8_SA(0, 1), cA + hstep, voffA);
        if (wr == 1) PG8_BAR;
        PG8_WAIT_V(4); PG8_BAR;
        PG8_STAGE(PG8_SB(1, 0), cB + kstep, voffB); PG8_STAGE(PG8_SA(1, 0), cA + kstep, voffA); PG8_STAGE(PG8_SB(1, 1), cB + hstep + kstep, voffB);
        PG8_WAIT_V(6); PG8_BAR;
    }
    for (;;) {
        const bool has_next = S.next(ui + 1, nxt);
        const char* nA = has_next ? (const char*)g.A + (size_t)nxt.pm * tstep : cA; const char* nB = has_next ? (const char*)g.Bt + (size_t)nxt.pn * tstep : cB;
        for (int t = 0; t < nt; t += 2) {
            const bool last = (t == nt - 2);
            const char* a1 = cA + (size_t)(t + 1) * kstep;
            const char* a2 = last ? nA : cA + (size_t)(t + 2) * kstep; const char* b2 = last ? nB : cB + (size_t)(t + 2) * kstep;
            const char* a3 = a2 + kstep; const char* b3 = b2 + kstep;
            if (last && has_next) S.a_ready(nxt);
            if constexpr (SP2) {
            PG8_LDB(B0, 0, 0); PG8_LDB(B1, 0, 1); PG8_SCHED; PG8_LDA(At, 0, 0); PG8_STAGE(PG8_SA(1, 1), a1 + hstep, voffA);
            PG8_WAIT_V(8); PG8_WAIT_L(0); PG8_BAR; PG8_MMA(0, 0, At, B0); PG8_MMA(0, 1, At, B1); PG8_BAR; PG8_SCHED;
            PG8_LDA(At, 0, 1); PG8_STAGE(PG8_SB(0, 0), b2, voffB); PG8_STAGE(PG8_SB(0, 1), b2 + hstep, voffB); PG8_STAGE(PG8_SA(0, 0), a2, voffA);
            PG8_WAIT_V(8); PG8_WAIT_L(0); PG8_BAR; PG8_MMA(1, 0, At, B0); PG8_MMA(1, 1, At, B1); PG8_BAR; PG8_SCHED;
            PG8_LDB(B0, 1, 0); PG8_LDB(B1, 1, 1); PG8_SCHED; PG8_LDA(At, 1, 0); PG8_STAGE(PG8_SA(0, 1), a2 + hstep, voffA);
            PG8_WAIT_V(8); PG8_WAIT_L(0); PG8_BAR; PG8_MMA(0, 0, At, B0); PG8_MMA(0, 1, At, B1); PG8_BAR; PG8_SCHED;
            PG8_LDA(At, 1, 1); PG8_STAGE(PG8_SB(1, 0), b3, voffB); PG8_STAGE(PG8_SB(1, 1), b3 + hstep, voffB); PG8_STAGE(PG8_SA(1, 0), a3, voffA);
            PG8_WAIT_V(8); PG8_WAIT_L(0); PG8_BAR; PG8_MMA(1, 0, At, B0); PG8_MMA(1, 1, At, B1); PG8_BAR; PG8_SCHED;
            } else {
            PG8_LDB(B0, 0, 0); PG8_SCHED; PG8_LDA(At, 0, 0); PG8_STAGE(PG8_SA(1, 1), a1 + hstep, voffA);
            PG8_WAIT_L(8); PG8_BAR; PG8_WAIT_L(0); PG8_MMA(0, 0, At, B0); PG8_BAR; PG8_SCHED;
            PG8_LDB(B1, 0, 1); PG8_STAGE(PG8_SB(0, 0), b2, voffB);
            PG8_BAR; PG8_WAIT_L(0); PG8_MMA(0, 1, At, B1); PG8_BAR;
            PG8_LDA(At, 0, 1); PG8_STAGE(PG8_SA(0, 0), a2, voffA);
            PG8_BAR; PG8_WAIT_L(0); PG8_MMA(1, 0, At, B0); PG8_BAR; PG8_SCHED;
            PG8_STAGE(PG8_SB(0, 1), b2 + hstep, voffB);
            PG8_WAIT_V(6); PG8_BAR; PG8_MMA(1, 1, At, B1); PG8_BAR;
            PG8_LDB(B0, 1, 0); PG8_SCHED; PG8_LDA(At, 1, 0); PG8_STAGE(PG8_SA(0, 1), a2 + hstep, voffA);
            PG8_WAIT_L(8); PG8_BAR; PG8_WAIT_L(0); PG8_MMA(0, 0, At, B0); PG8_BAR; PG8_SCHED;
            PG8_LDB(B1, 1, 1); PG8_STAGE(PG8_SB(1, 0), b3, voffB);
            PG8_BAR; PG8_WAIT_L(0); PG8_MMA(0, 1, At, B1); PG8_BAR;
            PG8_LDA(At, 1, 1); PG8_STAGE(PG8_SA(1, 0), a3, voffA);
            PG8_BAR; PG8_WAIT_L(0); PG8_MMA(1, 0, At, B0); PG8_BAR; PG8_SCHED;
            PG8_STAGE(PG8_SB(1, 1), b3 + hstep, voffB);
            PG8_WAIT_V(6); PG8_BAR; PG8_MMA(1, 1, At, B1); PG8_BAR;
            }
        }
        if constexpr (ALIGN_EPI) { if (wr == 0) PG8_BAR; }
        if constexpr (!Epi::AFTER_DRAIN) { E(acc, cur, wr, wc, fr, fq); S.done(cur); }
        if (!has_next) break;
#pragma unroll
        for (int a = 0; a < 2; ++a)
#pragma unroll
            for (int b = 0; b < 2; ++b)
#pragma unroll
                for (int m = 0; m < 4; ++m)
#pragma unroll
                    for (int n = 0; n < 2; ++n) acc[a][b][m][n] = (f32x4){0.f, 0.f, 0.f, 0.f};
        cur = nxt; cA = nA; cB = nB; ++ui;
        if constexpr (ALIGN_EPI) { if (wr == 1) PG8_BAR; }
    }
    PG8_WAIT_V(0);
    if constexpr (!ALIGN_EPI) { if (wr == 0) PG8_BAR; }
    PG8_BAR;
    if constexpr (Epi::AFTER_DRAIN) { E.fused(acc, cur, wr, wc, fr, fq, lds, wid, lane); S.done(cur); }
#undef PG8_SA
#undef PG8_SB
#undef PG8_STAGE
#undef PG8_LDA
#undef PG8_LDB
#undef PG8_MMA
#undef PG8_WAIT_V
#undef PG8_WAIT_L
#undef PG8_BAR
#undef PG8_SCHED
}
}

using pg8::bf16_t; using pg8::bf16x8; using pg8::f32x4; using pg8::u32x4; using pg8::cvt_pk_bf16; using pg8::fast_exp2; using pg8::fast_rcp; using pg8::bf2f;
#define LAS __attribute__((address_space(3)))
constexpr int NWAVES = 8;
constexpr int LDS_BYTES = 131072 + 4096 + 1024;
constexpr size_t MiB = 1u << 20;
constexpr size_t WS_SEL = 0, WS_KCMP = 512 * 1024, WS_VCMPT = 768 * 1024;
constexpr size_t WS_W1GU = 1 * MiB, WS_W1D = 12 * MiB, WS_WIN = 18 * MiB, WS_CW1K = 26 * MiB, WS_CW1V = 27 * MiB, WS_CW2K = 28 * MiB, WS_CW2V = 28 * MiB + 65536;
constexpr size_t WS_WA = 29 * MiB, WS_WB = 30 * MiB, WS_WOUT = 31 * MiB, WS_W2GU = 33 * MiB, WS_W2D = 44 * MiB, WS_PEB = 49 * MiB + 512 * 1024;
constexpr size_t WS_BAR = 49 * MiB + 576 * 1024, BAR_BYTES = 16384;
constexpr size_t WS_ROPEC = 50 * MiB, WS_ROPES = 52 * MiB;
constexpr size_t WS_XB = 54 * MiB;
constexpr size_t WS_ACT = 86 * MiB;
constexpr size_t WS_GA = 86 * MiB, WS_GB = 118 * MiB;
constexpr size_t WS_SQ = 174 * MiB, WS_OCMP = 190 * MiB, WS_KC = 206 * MiB, WS_VC = 210 * MiB, WS_KSL = 214 * MiB, WS_VSLT = 218 * MiB, WS_KWN = 222 * MiB, WS_VWNT = 226 * MiB;
constexpr size_t WS_SK = 230 * MiB, WS_SVT = 232 * MiB;
constexpr size_t WS_SSQ0 = 234 * MiB, WS_SSQ1 = 235 * MiB, WS_SSQ2 = 236 * MiB, WS_SSQ3 = 237 * MiB;
constexpr size_t WS_NQ = 238 * MiB, WS_NG = 254 * MiB, WS_END = 255 * MiB + 512 * 1024;

__device__ const float INV_FREQ[32] = {1.f, 0.749894202f, 0.562341332f, 0.421696514f, 0.316227764f, 0.237137377f, 0.177827939f, 0.133352146f, 0.100000001f, 0.0749894232f, 0.0562341325f, 0.0421696492f, 0.0316227749f, 0.0237137377f, 0.0177827943f, 0.013335214f, 0.00999999978f, 0.00749894232f, 0.00562341325f, 0.00421696482f, 0.00316227763f, 0.00237137382f, 0.00177827943f, 0.00133352145f, 0.00100000005f, 0.000749894185f, 0.000562341302f, 0.000421696517f, 0.000316227757f, 0.00023713737f, 0.00017782794f, 0.00013335215f};

struct Args { const float* in[23]; float* out; unsigned char* ws; int rep[4]; };

#define LDS_WAIT() asm volatile("s_waitcnt lgkmcnt(0)" ::: "memory")
#define MFMA16(a, b, c) __builtin_amdgcn_mfma_f32_16x16x32_bf16(a, b, c, 0, 0, 0)

__device__ __forceinline__ float wave_sum(float v) {
#pragma unroll
    for (int o = 1; o < 64; o <<= 1) v += __shfl_xor(v, o);
    return v;
}
__device__ __forceinline__ unsigned f2bf(float f) { unsigned u = __builtin_bit_cast(unsigned, f); return (u + 0x7fffu + ((u >> 16) & 1u)) >> 16; }
__device__ __forceinline__ unsigned pk2(float lo, float hi) { return f2bf(lo) | (f2bf(hi) << 16); }

__device__ __forceinline__ int il_pos(int d) { return d < 32 ? 2 * d : 2 * (d - 32) + 1; }
__device__ __forceinline__ int win_dest(int c) {
    if (c < 512) return (c & ~63) + il_pos(c & 63);
    if (c < 768) return c;
    if (c < 896) return (c & ~63) + il_pos(c & 63);
    if (c < 1024) return c;
    if (c < 1152) return (c & ~63) + il_pos(c & 63);
    if (c < 1280) return c;
    if (c < 1304) return 3968 + (c - 1280);
    if (c < 1816) { const int q = c - 1304; return 1280 + (q & ~63) + il_pos(q & 63); }
    if (c < 1880) return 3840 + il_pos(c - 1816);
    if (c < 1944) return 3904 + (c - 1880);
    if (c < 2968) return 1792 + (c - 1944);
    return 2816 + (c - 2968);
}
__device__ __forceinline__ int dest_row(int mode, int row_off, int n) {
    if (mode == 0) return row_off + n;
    if (mode == 1) return (n >> 7) * 256 + (n & 127) + row_off;
    if (mode == 2) return win_dest(n);
    return il_pos(n);
}
__device__ __forceinline__ void transpose_item(const float* __restrict__ W, int K, int N, bf16_t* WT, int mode, int row_off, const float* __restrict__ gain, LAS float* scr, int item, int lane) {
    const int nblk = (N + 31) / 32, kb = item / nblk, nb = item % nblk, k0 = 64 * kb, n0 = 32 * nb;
    const int c4 = (lane & 7) * 4, nn = n0 + c4;
#pragma unroll
    for (int i = 0; i < 8; ++i) { const int kk = 8 * i + (lane >> 3);
        f32x4 v = nn < N ? *(const f32x4*)(W + (size_t)(k0 + kk) * N + nn) : (f32x4){0.f, 0.f, 0.f, 0.f};
        if (gain) v = v * gain[k0 + kk];
        scr[kk * 33 + c4] = v[0]; scr[kk * 33 + c4 + 1] = v[1]; scr[kk * 33 + c4 + 2] = v[2]; scr[kk * 33 + c4 + 3] = v[3]; }
    LDS_WAIT();
    const int c = lane & 7;
#pragma unroll
    for (int j = 0; j < 4; ++j) { const int nl = (lane >> 3) + 8 * j; const int n = n0 + nl;
        if (n < N) { const LAS float* s = scr + (8 * c) * 33 + nl;
            u32x4 o; o.x = pk2(s[0 * 33], s[1 * 33]); o.y = pk2(s[2 * 33], s[3 * 33]); o.z = pk2(s[4 * 33], s[5 * 33]); o.w = pk2(s[6 * 33], s[7 * 33]);
            *(u32x4*)(WT + (size_t)dest_row(mode, row_off, n) * K + k0 + 8 * c) = o; } }
    LDS_WAIT();
}

__device__ __forceinline__ void qk_pair(const bf16_t* __restrict__ K, int kbase, int lane, const bf16x8 (&qf)[2], f32x4& sA, f32x4& sB) {
    const int i = lane & 15, fq = lane >> 4;
    const bf16_t* pa = K + (size_t)(kbase + 8 * (i >> 2) + (i & 3)) * 64 + 8 * fq;
    const bf16x8 a0 = *(const bf16x8*)pa, a1 = *(const bf16x8*)(pa + 32), b0 = *(const bf16x8*)(pa + 256), b1 = *(const bf16x8*)(pa + 288);
    const f32x4 z = {0.f, 0.f, 0.f, 0.f};
    sA = MFMA16(a0, qf[0], z); sA = MFMA16(a1, qf[1], sA);
    sB = MFMA16(b0, qf[0], z); sB = MFMA16(b1, qf[1], sB);
}
__device__ __forceinline__ void pv_pair(const bf16_t* __restrict__ VT, int ldv, int kbase, int lane, bf16x8 pf, f32x4 (&o)[4]) {
    const int i = lane & 15, fq = lane >> 4;
#pragma unroll
    for (int nt = 0; nt < 4; ++nt) { const bf16x8 a = *(const bf16x8*)(VT + (size_t)(16 * nt + i) * ldv + kbase + 8 * fq); o[nt] = MFMA16(a, pf, o[nt]); }
}
__device__ __forceinline__ float rowmax4(float v) {
    const unsigned u = __float_as_uint(v); const auto r = __builtin_amdgcn_permlane16_swap(u, u, false, false);
    const float a = fmaxf(__uint_as_float(r[0]), __uint_as_float(r[1]));
    const unsigned ua = __float_as_uint(a); const auto r2 = __builtin_amdgcn_permlane32_swap(ua, ua, false, false);
    return fmaxf(__uint_as_float(r2[0]), __uint_as_float(r2[1])); }
__device__ __forceinline__ float rowsum4(float v) {
    const unsigned u = __float_as_uint(v); const auto r = __builtin_amdgcn_permlane16_swap(u, u, false, false);
    const float a = __uint_as_float(r[0]) + __uint_as_float(r[1]);
    const unsigned ua = __float_as_uint(a); const auto r2 = __builtin_amdgcn_permlane32_swap(ua, ua, false, false);
    return __uint_as_float(r2[0]) + __uint_as_float(r2[1]); }
constexpr float NEGBIG = -1e30f;
#define SCORES8(sA, sB, key0, lo, hi, s, v) \
    float s[8]; bool v[8]; \
    _Pragma("unroll") for (int e = 0; e < 8; ++e) { const int key_ = (key0) + e; v[e] = (key_ >= (lo)) && (key_ <= (hi)); const float x_ = (e < 4 ? sA[e & 3] : sB[e & 3]) * C2; s[e] = v[e] ? x_ : NEGBIG; }

__device__ __forceinline__ bf16x8 soft_step(f32x4 sA, f32x4 sB, int key0, int lo, int hi, float& m, float& l, f32x4 (&o)[4]) {
    SCORES8(sA, sB, key0, lo, hi, s, v)
    float mx = fmaxf(fmaxf(fmaxf(s[0], s[1]), fmaxf(s[2], s[3])), fmaxf(fmaxf(s[4], s[5]), fmaxf(s[6], s[7])));
    mx = rowmax4(mx);
    const float mn = fmaxf(m, mx), alpha = fast_exp2(m - mn);
    float p[8], sum = 0.f;
#pragma unroll
    for (int e = 0; e < 8; ++e) { p[e] = v[e] ? fast_exp2(s[e] - mn) : 0.f; sum += p[e]; }
    sum = rowsum4(sum);
    l = l * alpha + sum; m = mn;
#pragma unroll
    for (int nt = 0; nt < 4; ++nt) o[nt] = o[nt] * alpha;
    u32x4 w; w.x = cvt_pk_bf16(p[0], p[1]); w.y = cvt_pk_bf16(p[2], p[3]); w.z = cvt_pk_bf16(p[4], p[5]); w.w = cvt_pk_bf16(p[6], p[7]);
    return __builtin_bit_cast(bf16x8, w);
}

#define RLX_AGENT __ATOMIC_RELAXED, __HIP_MEMORY_SCOPE_AGENT
#define XB_TMO      128
#define XB_XCNT(j)  (256  + 64 * (j))
#define XB_XSUB(j)  (1280 + 64 * (j))
#define XB_XGEN(j)  (2304 + 64 * (j))
#define XB_TOP      3328
#define XB_TOPGEN   3392
#define XCD_BAR_WORDS 3456
#define XB_SPIN_CAP (1u << 18)

__device__ __forceinline__ unsigned xb_ld(unsigned* p)              { return __hip_atomic_load(p, __ATOMIC_RELAXED, __HIP_MEMORY_SCOPE_AGENT); }
__device__ __forceinline__ unsigned xb_add(unsigned* p, unsigned v) { return __hip_atomic_fetch_add(p, v, __ATOMIC_RELAXED, __HIP_MEMORY_SCOPE_AGENT); }
__device__ __forceinline__ unsigned xb_xcc_id() { return (unsigned)__builtin_amdgcn_s_getreg((3 << 11) | 20) & 0xFu; }
#define XB_SPIN(cond, bar) do { unsigned _sp = 0; while (cond) { __builtin_amdgcn_s_sleep(1); \
    if ((++_sp & 255u) == 0u) { if (xb_ld(&(bar)[XB_TMO])) break; if (_sp > XB_SPIN_CAP) { atomicAdd(&(bar)[XB_TMO], 1u); break; } } } } while (0)

struct XcdBarrier {
    unsigned* bar; unsigned x;
    volatile LAS unsigned* st;
};

__device__ __forceinline__ XcdBarrier xcd_barrier_post(unsigned* bar, volatile LAS unsigned* st) {
    XcdBarrier b; b.bar = bar; b.x = xb_xcc_id(); b.st = st;
    if (threadIdx.x == 0) (void)xb_add(&bar[XB_XCNT(b.x)], 1u);
    return b;
}
__device__ __forceinline__ void xcd_barrier_complete(unsigned* bar, unsigned x, unsigned& nloc, unsigned& nx) {
    const unsigned G = gridDim.x * gridDim.y * gridDim.z;
    unsigned sum, cnt, mine, sp = 0u;
    for (;;) {
        sum = 0u; cnt = 0u; mine = 0u;
#pragma unroll
        for (unsigned j = 0; j < 16; ++j) { const unsigned c = xb_ld(&bar[XB_XCNT(j)]); sum += c; cnt += (c > 0u) ? 1u : 0u; mine = (j == x) ? c : mine; }
        if (sum == G) break;
        __builtin_amdgcn_s_sleep(1);
        if ((++sp & 255u) == 0u) { if (xb_ld(&bar[XB_TMO])) break; if (sp > XB_SPIN_CAP) { atomicAdd(&bar[XB_TMO], 1u); break; } }
    }
    nloc = mine > 0u ? mine : 1u; nx = cnt > 0u ? cnt : 1u;
}

__device__ __forceinline__ void xcd_barrier(const XcdBarrier& b) {
    asm volatile("s_waitcnt vmcnt(0)" ::: "memory");
    __syncthreads();
    if (threadIdx.x == 0) {
        unsigned* bar = b.bar;
        __builtin_amdgcn_s_waitcnt(0);
        unsigned nloc = b.st[0], nx = b.st[1];
        if (nloc == 0u) { xcd_barrier_complete(bar, b.x, nloc, nx); b.st[0] = nloc; b.st[1] = nx; }
        const unsigned old = xb_add(&bar[XB_XSUB(b.x)], 1u);
        const unsigned gen = old / nloc;
        if (old + 1u == (gen + 1u) * nloc) {
            __builtin_amdgcn_fence(__ATOMIC_RELEASE, "agent");
            asm volatile("s_waitcnt vmcnt(0)" ::: "memory");
            const unsigned og = xb_add(&bar[XB_TOP], 1u);
            const unsigned tg = og / nx;
            if (og + 1u == (tg + 1u) * nx) xb_add(&bar[XB_TOPGEN], 1u);
            else XB_SPIN(xb_ld(&bar[XB_TOPGEN]) == tg, bar);
            __builtin_amdgcn_fence(__ATOMIC_ACQUIRE, "agent");
            xb_add(&bar[XB_XGEN(b.x)], 1u);
            asm volatile("s_waitcnt vmcnt(0)" ::: "memory");
        } else {
            XB_SPIN(xb_ld(&bar[XB_XGEN(b.x)]) == gen, bar);
            __builtin_amdgcn_fence(__ATOMIC_ACQUIRE, "agent");
            asm volatile("s_waitcnt vmcnt(0)" ::: "memory");
        }
    }
    __syncthreads();
}

struct Frag { bf16x8 k0, k1, k2, k3, v0, v1, v2, v3; };
template <bool WITH_V> __device__ __forceinline__ void load_frag(Frag& f, const bf16_t* __restrict__ K, const bf16_t* __restrict__ VT, int ldv, int kbase, int lane) {
    const int i = lane & 15, fq = lane >> 4;
    const bf16_t* pa = K + (size_t)(kbase + 8 * (i >> 2) + (i & 3)) * 64 + 8 * fq;
    f.k0 = *(const bf16x8*)pa; f.k1 = *(const bf16x8*)(pa + 32); f.k2 = *(const bf16x8*)(pa + 256); f.k3 = *(const bf16x8*)(pa + 288);
    if (WITH_V) { const bf16_t* pv = VT + (size_t)i * ldv + kbase + 8 * fq;
        f.v0 = *(const bf16x8*)pv; f.v1 = *(const bf16x8*)(pv + (size_t)16 * ldv); f.v2 = *(const bf16x8*)(pv + (size_t)32 * ldv); f.v3 = *(const bf16x8*)(pv + (size_t)48 * ldv); }
}
__device__ __forceinline__ void qk_frag(const Frag& f, const bf16x8 (&qf)[2], f32x4& sA, f32x4& sB) {
    const f32x4 z = {0.f, 0.f, 0.f, 0.f};
    sA = MFMA16(f.k0, qf[0], z); sA = MFMA16(f.k1, qf[1], sA);
    sB = MFMA16(f.k2, qf[0], z); sB = MFMA16(f.k3, qf[1], sB);
}
__device__ __forceinline__ void pv_frag(const Frag& f, bf16x8 pf, f32x4 (&o)[4]) {
    o[0] = MFMA16(f.v0, pf, o[0]); o[1] = MFMA16(f.v1, pf, o[1]); o[2] = MFMA16(f.v2, pf, o[2]); o[3] = MFMA16(f.v3, pf, o[3]);
}
__device__ __forceinline__ void glds16(const void* g, unsigned lds_base) {
    unsigned sv; asm volatile("s_mov_b32 %0, m0\n\ts_mov_b32 m0, %2\n\ts_nop 0\n\tglobal_load_lds_dwordx4 %1, off\n\ts_mov_b32 m0, %0" : "=&s"(sv) : "v"(g), "s"(lds_base) : "memory"); }
__device__ __forceinline__ void glds16s(const void* sbase, unsigned voff, unsigned lds_base) {
    unsigned sv; asm volatile("s_mov_b32 %0, m0\n\ts_mov_b32 m0, %3\n\ts_nop 0\n\tglobal_load_lds_dwordx4 %1, %2\n\ts_mov_b32 m0, %0" : "=&s"(sv) : "v"(voff), "s"(sbase), "s"(lds_base) : "memory"); }
#define RFL(x) __builtin_amdgcn_readfirstlane(x)
template <bool MASK> __device__ __forceinline__ void soft_step64(const f32x4 (&sc)[4], int key0, int lo, int hi, float rowbias, float& m, float& l, f32x4 (&o)[4], bf16x8& pf0, bf16x8& pf1) {
    float s[16];
#pragma unroll
    for (int e = 0; e < 16; ++e) { const float x = __builtin_fmaf(sc[e >> 2][e & 3], C2, rowbias);
        if (MASK) { const int key_ = key0 + 32 * (e >> 3) + (e & 7); s[e] = (key_ >= lo && key_ <= hi) ? x : NEGBIG; } else s[e] = x; }
    float mx = fmaxf(fmaxf(fmaxf(fmaxf(s[0], s[1]), fmaxf(s[2], s[3])), fmaxf(fmaxf(s[4], s[5]), fmaxf(s[6], s[7]))), fmaxf(fmaxf(fmaxf(s[8], s[9]), fmaxf(s[10], s[11])), fmaxf(fmaxf(s[12], s[13]), fmaxf(s[14], s[15]))));
    mx = rowmax4(mx);
    const float mn = fmaxf(m, mx), alpha = fast_exp2(m - mn);
    float p[16], sum = 0.f;
#pragma unroll
    for (int e = 0; e < 16; ++e) { p[e] = fast_exp2(s[e] - mn); sum += p[e]; }
    sum = rowsum4(sum);
    l = l * alpha + sum; m = mn;
#pragma unroll
    for (int nt = 0; nt < 4; ++nt) o[nt] = o[nt] * alpha;
    u32x4 w0, w1;
    w0.x = cvt_pk_bf16(p[0], p[1]); w0.y = cvt_pk_bf16(p[2], p[3]); w0.z = cvt_pk_bf16(p[4], p[5]); w0.w = cvt_pk_bf16(p[6], p[7]);
    w1.x = cvt_pk_bf16(p[8], p[9]); w1.y = cvt_pk_bf16(p[10], p[11]); w1.z = cvt_pk_bf16(p[12], p[13]); w1.w = cvt_pk_bf16(p[14], p[15]);
    pf0 = __builtin_bit_cast(bf16x8, w0); pf1 = __builtin_bit_cast(bf16x8, w1);
}


__global__ void __launch_bounds__(NWAVES * 64, 2) nsa_fwd(Args args) {
    extern __shared__ __attribute__((aligned(16))) unsigned char lds[];
    cg::grid_group grid = cg::this_grid();
    const int tid = threadIdx.x, lane = tid & 63, wave = __builtin_amdgcn_readfirstlane(tid >> 6);
    const int G = gridDim.x, gw = blockIdx.x * NWAVES + wave, NGW = G * NWAVES;
    unsigned char* ws = args.ws;
    LAS unsigned char* ldsl = (LAS unsigned char*)lds;

    const float* x = args.in[0]; const int* positions = (const int*)args.in[1];
    float* H = args.out;
    float* SSQ0 = (float*)(ws + WS_SSQ0); float* SSQ1 = (float*)(ws + WS_SSQ1); float* SSQ2 = (float*)(ws + WS_SSQ2); float* SSQ3 = (float*)(ws + WS_SSQ3);
    float* PEB = (float*)(ws + WS_PEB);
    bf16_t* W1GU = (bf16_t*)(ws + WS_W1GU); bf16_t* W1D = (bf16_t*)(ws + WS_W1D); bf16_t* WIN = (bf16_t*)(ws + WS_WIN);
    bf16_t* CW1K = (bf16_t*)(ws + WS_CW1K); bf16_t* CW1V = (bf16_t*)(ws + WS_CW1V); bf16_t* CW2K = (bf16_t*)(ws + WS_CW2K); bf16_t* CW2V = (bf16_t*)(ws + WS_CW2V);
    bf16_t* WA = (bf16_t*)(ws + WS_WA); bf16_t* WB = (bf16_t*)(ws + WS_WB); bf16_t* WOUT = (bf16_t*)(ws + WS_WOUT); bf16_t* W2GU = (bf16_t*)(ws + WS_W2GU); bf16_t* W2D = (bf16_t*)(ws + WS_W2D);
    float* ROPEC = (float*)(ws + WS_ROPEC); float* ROPES = (float*)(ws + WS_ROPES);
    bf16_t* XB = (bf16_t*)(ws + WS_XB); bf16_t* ACT = (bf16_t*)(ws + WS_ACT);
    bf16_t* GA = (bf16_t*)(ws + WS_GA); bf16_t* GB = (bf16_t*)(ws + WS_GB); bf16_t* NQ = (bf16_t*)(ws + WS_NQ);
    bf16_t* KCMP = (bf16_t*)(ws + WS_KCMP); bf16_t* VCMPT = (bf16_t*)(ws + WS_VCMPT); unsigned* SEL = (unsigned*)(ws + WS_SEL); float* NG = (float*)(ws + WS_NG);
    bf16_t* SQ = (bf16_t*)(ws + WS_SQ); bf16_t* OCMP = (bf16_t*)(ws + WS_OCMP); bf16_t* KC = (bf16_t*)(ws + WS_KC); bf16_t* VC = (bf16_t*)(ws + WS_VC);
    bf16_t* KSL = (bf16_t*)(ws + WS_KSL); bf16_t* VSLT = (bf16_t*)(ws + WS_VSLT); bf16_t* KWN = (bf16_t*)(ws + WS_KWN); bf16_t* VWNT = (bf16_t*)(ws + WS_VWNT);
    bf16_t* SK = (bf16_t*)(ws + WS_SK); bf16_t* SVT = (bf16_t*)(ws + WS_SVT);
#if defined(DBG_NOFFN1)
    bf16_t* OB = (bf16_t*)(ws + 150 * MiB);
#else
    bf16_t* OB = SQ;
#endif

    const int fr = lane & 15, fq = lane >> 4;
#define GRID_SYNC_CG() do { asm volatile("s_waitcnt vmcnt(0) lgkmcnt(0)" ::: "memory"); __syncthreads(); grid.sync(); \
        __builtin_amdgcn_fence(__ATOMIC_ACQUIRE, "agent"); asm volatile("s_waitcnt vmcnt(0)" ::: "memory"); __syncthreads(); } while (0)
#define GRID_SYNC() xcd_barrier(xbar)
    volatile LAS unsigned* MISC = (volatile LAS unsigned*)(ldsl + LDS_BYTES - 1024);
    if (tid < 16) MISC[tid] = 0u;
    __syncthreads();
    XcdBarrier xbar = xcd_barrier_post((unsigned*)(ws + WS_BAR), MISC + 8);

#ifndef DBG_STOP
#define DBG_STOP 0
#endif
#define DUMP_LOOP(expr) do { for (size_t i_ = (size_t)blockIdx.x * 512 + tid; i_ < (size_t)TOK * DM; i_ += (size_t)G * 512) { args.out[i_] = (expr); } return; } while (0)
    {
        LAS float* scr = (LAS float*)(ldsl + wave * 16384);
        constexpr int I_GU = 16 * 88, I_D = 44 * 32, I_IN = 16 * 125, I_C1 = 32 * 8, I_C2 = 4 * 2, I_AB = 8 * 32, I_O = 16 * 32;
        constexpr int NITEMS = 6 * I_GU + I_IN + 2 * I_C1 + 2 * I_C2 + 2 * I_AB + I_O;
        static_assert(I_GU == I_D, "items");
        for (int it = gw; it < 2 * I_GU + I_IN; it += NGW) {
            int r = it;
            if (r < I_GU) { transpose_item(args.in[3], 1024, 2816, W1GU, 1, 0, args.in[2], scr, r, lane); continue; } r -= I_GU;
            if (r < I_GU) { transpose_item(args.in[4], 1024, 2816, W1GU, 1, 128, args.in[2], scr, r, lane); continue; } r -= I_GU;
            transpose_item(args.in[7], 1024, 3992, WIN, 2, 0, args.in[6], scr, r, lane);
        }
        for (int mrow = gw; mrow < TOK; mrow += 2 * NGW) {
            const int mrow2 = mrow + NGW;
            const bool two = mrow2 < TOK;
            const f32x4* xr = (const f32x4*)(x + (size_t)mrow * DM) + lane; const f32x4* xr2 = (const f32x4*)(x + (size_t)(two ? mrow2 : mrow) * DM) + lane;
            f32x4 v[4], w[4];
#pragma unroll
            for (int j = 0; j < 4; ++j) { v[j] = xr[64 * j]; w[j] = xr2[64 * j]; }
            unsigned long long* o8 = (unsigned long long*)(XB + (size_t)mrow * DM) + lane; unsigned long long* p8 = (unsigned long long*)(XB + (size_t)mrow2 * DM) + lane;
            float s = 0.f, s2 = 0.f;
#pragma unroll
            for (int j = 0; j < 4; ++j) { s += (v[j][0] * v[j][0] + v[j][1] * v[j][1]) + (v[j][2] * v[j][2] + v[j][3] * v[j][3]);
                s2 += (w[j][0] * w[j][0] + w[j][1] * w[j][1]) + (w[j][2] * w[j][2] + w[j][3] * w[j][3]);
                o8[64 * j] = (unsigned long long)pk2(v[j][0], v[j][1]) | ((unsigned long long)pk2(v[j][2], v[j][3]) << 32);
                if (two) p8[64 * j] = (unsigned long long)pk2(w[j][0], w[j][1]) | ((unsigned long long)pk2(w[j][2], w[j][3]) << 32); }
            s = wave_sum(s); s2 = wave_sum(s2);
            if (lane < 16) { SSQ0[(size_t)mrow * 16 + lane] = lane == 0 ? s : 0.f; if (two) SSQ0[(size_t)mrow2 * 16 + lane] = lane == 0 ? s2 : 0.f; }
        }
        for (int idx = blockIdx.x * (NWAVES * 64) + tid; idx < TOK * 32; idx += G * NWAVES * 64) {
            const int trow = idx >> 5, i = idx & 31;
            const float ang = (float)positions[trow] * INV_FREQ[i];
            const double rev = (double)ang * 0.15915494309189535; const float frac = (float)(rev - __builtin_rint(rev));
            ROPEC[idx] = __builtin_amdgcn_cosf(frac); ROPES[idx] = __builtin_amdgcn_sinf(frac);
        }
        for (int o = gw; o < 2048; o += NGW) {
            const int part = o >> 9, oo = o & 511, z = oo >> 8, j = oo & 255; const float* pe = args.in[z ? 11 : 8]; const float* w1 = args.in[z ? 12 : 9];
            float s = 0.f;
#pragma unroll
            for (int i = 0; i < 8; ++i) { const int kk = 512 * part + 64 * i + lane; s += pe[kk] * w1[(size_t)kk * 256 + j]; }
            s = wave_sum(s);
            if (lane == 0) PEB[part * 512 + oo] = s;
        }
    }
    if (args.rep[3] == 77) GRID_SYNC_CG();
    GRID_SYNC();

#if !defined(DBG_NOFFN1)
    { pg8::Gemm g{XB, W1GU, TOK, 2 * DFF, DM}; pg8::StaticOrder S; S.init(TOK, 2 * DFF, G, (int)blockIdx.x);
      pg8::EpiSwiglu E{ACT, SSQ0};
      pg8::gemm_phase<pg8::EpiSwiglu, pg8::StaticOrder, true, true>(ldsl, g, S, E); }
    {
        constexpr int I_GU = 16 * 88, I_D = 44 * 32, I_C1 = 32 * 8, I_C2 = 4 * 2, I_AB = 8 * 32, I_O = 16 * 32;
        constexpr int NLATE = 2 * I_GU + 2 * I_D + 2 * I_C1 + 2 * I_C2 + 2 * I_AB + I_O, NUNITS = (TOK / 256) * (2 * DFF / 256);
        const int rem = NUNITS % G, first = rem ? rem : 0, np = rem ? G - rem : G;
        if ((int)blockIdx.x >= first) {
            LAS float* scr = (LAS float*)(ldsl + wave * 16384);
            for (int it = ((int)blockIdx.x - first) * NWAVES + wave; it < NLATE; it += np * NWAVES) {
                int r = it;
                if (r < I_D) { transpose_item(args.in[5], 2816, 1024, W1D, 0, 0, nullptr, scr, r, lane); continue; } r -= I_D;
                if (r < I_GU) { transpose_item(args.in[19], 1024, 2816, W2GU, 1, 0, args.in[18], scr, r, lane); continue; } r -= I_GU;
                if (r < I_GU) { transpose_item(args.in[20], 1024, 2816, W2GU, 1, 128, args.in[18], scr, r, lane); continue; } r -= I_GU;
                if (r < I_D) { transpose_item(args.in[21], 2816, 1024, W2D, 0, 0, nullptr, scr, r, lane); continue; } r -= I_D;
                if (r < I_C1) { transpose_item(args.in[9], 2048, 256, CW1K, 0, 0, nullptr, scr, r, lane); continue; } r -= I_C1;
                if (r < I_C1) { transpose_item(args.in[12], 2048, 256, CW1V, 0, 0, nullptr, scr, r, lane); continue; } r -= I_C1;
                if (r < I_C2) { transpose_item(args.in[10], 256, 64, CW2K, 3, 0, nullptr, scr, r, lane); continue; } r -= I_C2;
                if (r < I_C2) { transpose_item(args.in[13], 256, 64, CW2V, 0, 0, nullptr, scr, r, lane); continue; } r -= I_C2;
                if (r < I_AB) { transpose_item(args.in[15], 512, 1024, WA, 0, 0, nullptr, scr, r, lane); continue; } r -= I_AB;
                if (r < I_AB) { transpose_item(args.in[16], 512, 1024, WB, 0, 0, nullptr, scr, r, lane); continue; } r -= I_AB;
                transpose_item(args.in[17], 1024, 1024, WOUT, 0, 0, nullptr, scr, r, lane);
            }
        }
    }
    GRID_SYNC();
    if (DBG_STOP == 12) DUMP_LOOP(bf2f(ACT[i_]) + bf2f(ACT[i_ + 16777216]) + (i_ < 12582912 ? bf2f(ACT[i_ + 33554432]) : 0.f));
    if (args.rep[3] == 1) { pg8::Gemm g{XB, W1GU, TOK, 2 * DFF, DM}; pg8::StaticOrder S; S.init(TOK, 2 * DFF, G, (int)blockIdx.x); pg8::EpiDry E{PEB, args.rep[0] - 1};
      pg8::gemm_phase<pg8::EpiDry, pg8::StaticOrder, true, true>(ldsl, g, S, E); GRID_SYNC(); }
    if (args.rep[3] == 2) { pg8::Gemm g{ACT, W1D, TOK, DM, DFF}; pg8::StaticOrder S; S.init(TOK, DM, G, (int)blockIdx.x); pg8::EpiDry E{PEB, args.rep[0] - 1};
      pg8::gemm_phase<pg8::EpiDry, pg8::StaticOrder, true, true>(ldsl, g, S, E); GRID_SYNC(); }
    if (args.rep[3] == 3) { pg8::Gemm g{XB, WIN, TOK, 4096, DM}; pg8::StaticOrder S; S.init(TOK, 4096, G, (int)blockIdx.x); pg8::EpiDry E{PEB, args.rep[0] - 1};
      pg8::gemm_phase<pg8::EpiDry, pg8::StaticOrder, true, true>(ldsl, g, S, E); GRID_SYNC(); }
    if (args.rep[3] == 4) { pg8::Gemm g{XB, WA, TOK, DM, 512}; pg8::StaticOrder S; S.init(TOK, DM, G, (int)blockIdx.x); pg8::EpiDry E{PEB, args.rep[0] - 1};
      pg8::gemm_phase<pg8::EpiDry, pg8::StaticOrder, true, true>(ldsl, g, S, E); GRID_SYNC(); }
    if (args.rep[3] == 6) { GRID_SYNC(); GRID_SYNC(); GRID_SYNC(); GRID_SYNC(); GRID_SYNC(); GRID_SYNC(); GRID_SYNC(); GRID_SYNC(); GRID_SYNC(); GRID_SYNC(); }
    { pg8::Gemm g{ACT, W1D, TOK, DM, DFF}; pg8::StaticOrder S; S.init(TOK, DM, G, (int)blockIdx.x);
      pg8::EpiResid E{x, H, XB, SSQ1, 0.5f};
      pg8::gemm_phase<pg8::EpiResid, pg8::StaticOrder, true, true>(ldsl, g, S, E); }
    GRID_SYNC();
    if (DBG_STOP == 1) return;
#endif
    { pg8::Gemm g{XB, WIN, TOK, 4096, DM}; pg8::StaticOrder S; S.init(TOK, 4096, G, (int)blockIdx.x);
      pg8::EpiProj E{
#if defined(DBG_NOFFN1)
 SSQ0,
#else
 SSQ1,
#endif
 ROPEC, ROPES, NQ, KC, VC, KSL, VSLT, KWN, VWNT, SQ, SK, SVT, GA, GB, NG};
      pg8::gemm_phase<pg8::EpiProj, pg8::StaticOrder, true, true>(ldsl, g, S, E); }
    GRID_SYNC();
    if (DBG_STOP == 13) DUMP_LOOP(bf2f(NQ[i_ & 8388607]) + bf2f(SQ[i_ & 8388607]) + bf2f(KC[i_ & 2097151]) + bf2f(VC[i_ & 2097151]) + bf2f(KSL[i_ & 2097151]) + bf2f(VSLT[i_ & 2097151]) + bf2f(KWN[i_ & 2097151]) + bf2f(VWNT[i_ & 2097151]) + bf2f(SK[i_ & 1048575]) + bf2f(SVT[i_ & 1048575]) + NG[i_ % (TOK * 24)]);
    if (DBG_STOP == 11) DUMP_LOOP(bf2f(GA[i_]) + bf2f(GB[i_]));
    if (DBG_STOP == 2) DUMP_LOOP(bf2f(GA[i_]) + bf2f(GB[i_]) + bf2f(NQ[i_ & 8388607]) + bf2f(SQ[i_ & 8388607]) + bf2f(KC[i_ & 2097151]) + bf2f(VC[i_ & 2097151]) + bf2f(KSL[i_ & 2097151]) + bf2f(VSLT[i_ & 2097151]) + bf2f(KWN[i_ & 2097151]) + bf2f(VWNT[i_ & 2097151]) + bf2f(SK[i_ & 1048575]) + bf2f(SVT[i_ & 1048575]) + NG[i_ % (TOK * 24)]);

    for (int rep = 0; rep < args.rep[0]; ++rep)
    for (int u = blockIdx.x; u < 256; u += G) {
        const int z = u >> 7, r0 = (u & 127) * 16;
        const bf16_t* A = z ? VC : KC; const bf16_t* W1 = z ? CW1V : CW1K; const bf16_t* W2 = z ? CW2V : CW2K; const float* peb = PEB + z * 256;
        constexpr int AS = 2048 + 8;
        bf16_t* As_ = (bf16_t*)lds;
        bf16_t* hid = (bf16_t*)(lds + 16 * AS * 2);
        {
            u32x4 av[8];
#pragma unroll
            for (int i = 0; i < 8; ++i) { const int c = tid + 512 * i, row = c >> 8, ch = c & 255; av[i] = *(const u32x4*)(A + (size_t)(r0 + row) * 1024 + ch * 8); }
#pragma unroll
            for (int i = 0; i < 8; ++i) { const int c = tid + 512 * i, row = c >> 8, ch = c & 255; *(u32x4*)(As_ + row * AS + ch * 8) = av[i]; }
        }
        __syncthreads();
        f32x4 acc0 = {0.f, 0.f, 0.f, 0.f}, acc1 = {0.f, 0.f, 0.f, 0.f};
        const bf16_t* ap = As_ + fr * AS + 8 * fq;
        const bf16_t* bp0 = W1 + (size_t)(32 * wave + fr) * 2048 + 8 * fq; const bf16_t* bp1 = bp0 + 16 * 2048;
#pragma unroll 16
        for (int k0 = 0; k0 < 2048; k0 += 32) {
            const bf16x8 a = *(const bf16x8*)(ap + k0), b0 = *(const bf16x8*)(bp0 + k0), b1 = *(const bf16x8*)(bp1 + k0);
            acc0 = MFMA16(b0, a, acc0); acc1 = MFMA16(b1, a, acc1);
        }
#pragma unroll
        for (int nt = 0; nt < 2; ++nt) {
            const f32x4 a = nt ? acc1 : acc0; const int col = 32 * wave + 16 * nt + 4 * fq;
            float hv[4];
#pragma unroll
            for (int r = 0; r < 4; ++r) { const float h = a[r] + ((peb[col + r] + peb[512 + col + r]) + (peb[1024 + col + r] + peb[1536 + col + r])); const float uu = 0.7978845608028654f * (h + 0.044715f * h * h * h);
                const float th = 1.0f - 2.0f * fast_rcp(1.0f + fast_exp2(2.0f * LOG2E * uu)); hv[r] = 0.5f * h * (1.0f + th); }
            unsigned* hp = (unsigned*)(hid + fr * 264 + col); hp[0] = cvt_pk_bf16(hv[0], hv[1]); hp[1] = cvt_pk_bf16(hv[2], hv[3]);
        }
        __syncthreads();
        if (wave < 4) {
            f32x4 acc2 = {0.f, 0.f, 0.f, 0.f};
            const bf16_t* wp = W2 + (size_t)(16 * wave + fr) * 256 + 8 * fq;
#pragma unroll
            for (int k0 = 0; k0 < 256; k0 += 32) { const bf16x8 a = *(const bf16x8*)(wp + k0), bb = *(const bf16x8*)(hid + fr * 264 + k0 + 8 * fq); acc2 = MFMA16(a, bb, acc2); }
            const int r = r0 + fr, bg = r >> 9, i = r & 511, bb_ = bg >> 1;
            const bool ok = i < 511;
            if (z == 0) {
                const int trow = bb_ * SEQ + 16 * (ok ? i : 0) + 31, i0 = 8 * wave + 2 * fq;
                const float c0 = ROPEC[(size_t)trow * 32 + i0], s0 = ROPES[(size_t)trow * 32 + i0], c1 = ROPEC[(size_t)trow * 32 + i0 + 1], s1 = ROPES[(size_t)trow * 32 + i0 + 1];
                float o0 = acc2[0] * c0 - acc2[1] * s0, o1 = acc2[1] * c0 + acc2[0] * s0, o2 = acc2[2] * c1 - acc2[3] * s1, o3 = acc2[3] * c1 + acc2[2] * s1;
                if (!ok) { o0 = 0.f; o1 = 0.f; o2 = 0.f; o3 = 0.f; }
                unsigned* kp = (unsigned*)(KCMP + ((size_t)bg * 512 + i) * 64 + 16 * wave + 4 * fq); kp[0] = cvt_pk_bf16(o0, o1); kp[1] = cvt_pk_bf16(o2, o3);
            } else {
#pragma unroll
                for (int rr = 0; rr < 4; ++rr) VCMPT[((size_t)bg * 64 + 16 * wave + 4 * fq + rr) * 512 + i] = (bf16_t)f2bf(ok ? acc2[rr] : 0.f);
            }
        }
        __syncthreads();
    }
    GRID_SYNC();
    if (DBG_STOP == 3) DUMP_LOOP(bf2f(KCMP[i_ & 131071]) + bf2f(VCMPT[i_ & 131071]));

    {
        constexpr int RS = 72;
        bf16_t* Kb = (bf16_t*)lds;
        bf16_t* Vb = (bf16_t*)(lds + 2 * 64 * RS * 2);
        float* Pl = (float*)(lds + 40960 + wave * 10240);
        unsigned long long* KEY = (unsigned long long*)(Pl + 2048);
        const int skr = tid >> 3, sc8 = (tid & 7) * 8;
        const int krow = (skr & 32) + (((skr & 7) < 4) ? (4 * ((skr & 31) >> 3) + (skr & 7)) : (16 + 4 * ((skr & 31) >> 3) + (skr & 7) - 4));
        for (int rep = 0; rep < args.rep[1]; ++rep)
        for (int wu = blockIdx.x; wu < 1024; wu += G) {
            const int bg = wu >> 8, tl0 = wu & 255, tile = (bg & 1) ? 255 - tl0 : tl0, t0w = tile * 32, t0 = t0w + 4 * wave, b = bg >> 1, g = bg & 1;
            const int tl = fr >> 2, hh = fr & 3, t = t0 + tl, head = g * 4 + hh;
            const size_t qrow = (size_t)(b * SEQ + t);
            bf16x8 qf[2]; qf[0] = *(const bf16x8*)(NQ + qrow * 512 + head * 64 + 8 * fq); qf[1] = *(const bf16x8*)(NQ + qrow * 512 + head * 64 + 32 + 8 * fq);
            const bf16_t* Kc = KCMP + (size_t)bg * 512 * 64; const bf16_t* Vc = VCMPT + (size_t)bg * 64 * 512;
            const int hi = (t >= 31) ? ((t - 31) >> 4) : -1;
            const int hiw = (t0 + 3 >= 31) ? ((t0 + 3 - 31) >> 4) : -1;
            const int nst = (2 * tile + 64) >> 6;
            u32x4 kreg, vreg;
#define C_LOADK(s_) do { kreg = *(const u32x4*)(Kc + (size_t)(64 * (s_) + skr) * 64 + sc8); } while (0)
#define C_LOADV(s_) do { vreg = *(const u32x4*)(Vc + (size_t)skr * 512 + 64 * (s_) + sc8); } while (0)
#define C_WRITEK(bufi) do { *(u32x4*)(Kb + (bufi) * 64 * RS + krow * RS + sc8) = kreg; } while (0)
#define C_WRITEV(bufi) do { *(u32x4*)(Vb + (bufi) * 64 * RS + skr * RS + sc8) = vreg; } while (0)
#define C_FRAGK(F, Kt, half) do { const bf16_t* ka = (Kt) + (32 * (half) + fr) * RS + 8 * fq; \
                F.k0 = *(const bf16x8*)ka; F.k1 = *(const bf16x8*)(ka + 32); F.k2 = *(const bf16x8*)(ka + 16 * RS); F.k3 = *(const bf16x8*)(ka + 16 * RS + 32); } while (0)
#define C_FRAGV(F, Vt, half) do { const bf16_t* va = (Vt) + fr * RS + 32 * (half) + 8 * fq; \
                F.v0 = *(const bf16x8*)va; F.v1 = *(const bf16x8*)(va + 16 * RS); F.v2 = *(const bf16x8*)(va + 32 * RS); F.v3 = *(const bf16x8*)(va + 48 * RS); } while (0)
            float m = NEGBIG, l = 0.f;
            C_LOADK(0); C_WRITEK(0);
            __syncthreads();
            for (int s = 0; s < nst; ++s) {
                if (s + 1 < nst) C_LOADK(s + 1);
                const bf16_t* Kt = Kb + (s & 1) * 64 * RS;
#pragma unroll
                for (int half = 0; half < 2; ++half) {
                    const int kbase = 64 * s + 32 * half;
                    if (kbase <= hiw) {
                        Frag F; C_FRAGK(F, Kt, half);
                        f32x4 sA, sB; qk_frag(F, qf, sA, sB);
                        SCORES8(sA, sB, kbase + 8 * fq, 0, hi, sc_, v)
                        float mx = fmaxf(fmaxf(fmaxf(sc_[0], sc_[1]), fmaxf(sc_[2], sc_[3])), fmaxf(fmaxf(sc_[4], sc_[5]), fmaxf(sc_[6], sc_[7])));
                        mx = rowmax4(mx);
                        const float mn = fmaxf(m, mx), alpha = fast_exp2(m - mn);
                        float sum = 0.f;
#pragma unroll
                        for (int e = 0; e < 8; ++e) sum += v[e] ? fast_exp2(sc_[e] - mn) : 0.f;
                        sum = rowsum4(sum);
                        l = l * alpha + sum; m = mn;
                    }
                }
                if (s + 1 < nst) C_WRITEK((s + 1) & 1);
                __syncthreads();
            }
            const float inv_l = l > 0.f ? 1.0f / l : 0.f;
#pragma unroll
            for (int q = 0; q < 8; ++q) ((f32x4*)Pl)[lane + 64 * q] = (f32x4){0.f, 0.f, 0.f, 0.f};
            f32x4 o[4];
#pragma unroll
            for (int nt = 0; nt < 4; ++nt) o[nt] = (f32x4){0.f, 0.f, 0.f, 0.f};
            C_LOADK(0); C_LOADV(0); C_WRITEK(0); C_WRITEV(0);
            __syncthreads();
            for (int s = 0; s < nst; ++s) {
                if (s + 1 < nst) { C_LOADK(s + 1); C_LOADV(s + 1); }
                const bf16_t* Kt = Kb + (s & 1) * 64 * RS; const bf16_t* Vt = Vb + (s & 1) * 64 * RS;
#pragma unroll
                for (int half = 0; half < 2; ++half) {
                    const int kbase = 64 * s + 32 * half;
                    if (kbase <= hiw) {
                        Frag F; C_FRAGK(F, Kt, half); C_FRAGV(F, Vt, half);
                        f32x4 sA, sB; qk_frag(F, qf, sA, sB);
                        SCORES8(sA, sB, kbase + 8 * fq, 0, hi, sc_, v)
                        float p[8], ps[8];
#pragma unroll
                        for (int e = 0; e < 8; ++e) { p[e] = v[e] ? fast_exp2(sc_[e] - m) * inv_l : 0.f; float q_ = p[e] + __shfl_xor(p[e], 1); ps[e] = q_ + __shfl_xor(q_, 2); }
                        if (hh == 0) { f32x4* pp = (f32x4*)(Pl + tl * 512 + kbase + 8 * fq); pp[0] = (f32x4){ps[0], ps[1], ps[2], ps[3]}; pp[1] = (f32x4){ps[4], ps[5], ps[6], ps[7]}; }
                        u32x4 w; w.x = cvt_pk_bf16(p[0], p[1]); w.y = cvt_pk_bf16(p[2], p[3]); w.z = cvt_pk_bf16(p[4], p[5]); w.w = cvt_pk_bf16(p[6], p[7]);
                        pv_frag(F, __builtin_bit_cast(bf16x8, w), o);
                    }
                }
                if (s + 1 < nst) { C_WRITEK((s + 1) & 1); C_WRITEV((s + 1) & 1); }
                __syncthreads();
            }
            {
                const float gc = NG[qrow * 24 + head];
#pragma unroll
                for (int nt = 0; nt < 4; ++nt) { unsigned* op = (unsigned*)(OCMP + qrow * 512 + head * 64 + 16 * nt + 4 * fq);
                    op[0] = cvt_pk_bf16(o[nt][0] * gc, o[nt][1] * gc); op[1] = cvt_pk_bf16(o[nt][2] * gc, o[nt][3] * gc); }
            }
            LDS_WAIT();
            for (int tk = 0; tk < 4; ++tk) {
                const int tt = t0 + tk, tb = tt >> 6;
                const float* P = Pl + tk * 512;
                unsigned hv[2];
#pragma unroll
                for (int q = 0; q < 2; ++q) { const int j = lane + 64 * q;
                    const float a = (j > 0 ? 0.5f * P[4 * j - 1] : 0.f) + P[4 * j] + P[4 * j + 1] + P[4 * j + 2] + 0.5f * P[4 * j + 3];
                    const bool forced = (j == 0) || (j <= tb && tb - j < 2);
                    hv[q] = j > tb ? 0u : (forced ? 0x7f000000u : __float_as_uint(a) + 1u); }
                unsigned T = 0u;
                for (int bit = 30; bit >= 0; --bit) {
                    const unsigned cand = T | (1u << bit);
                    const int cnt = __builtin_popcountll(__ballot(hv[0] >= cand)) + __builtin_popcountll(__ballot(hv[1] >= cand));
                    T = cnt >= 16 ? cand : T;
                }
                const unsigned long long g0 = __ballot(hv[0] > T), g1 = __ballot(hv[1] > T), e0 = __ballot(hv[0] == T), e1 = __ballot(hv[1] == T);
                const int need = 16 - (__builtin_popcountll(g0) + __builtin_popcountll(g1));
                const unsigned long long below = (1ull << lane) - 1ull;
                const bool s0 = (hv[0] > T) || ((hv[0] == T) && __builtin_popcountll(e0 & below) < need);
                const bool s1 = (hv[1] > T) || ((hv[1] == T) && (__builtin_popcountll(e0) + __builtin_popcountll(e1 & below)) < need);
                const unsigned long long b0 = __ballot(s0 && lane <= tb), b1 = __ballot(s1 && lane + 64 <= tb);
                if (lane == 0) { u32x4 w; w.x = (unsigned)b0; w.y = (unsigned)(b0 >> 32); w.z = (unsigned)b1; w.w = (unsigned)(b1 >> 32); *(u32x4*)(SEL + ((size_t)bg * SEQ + tt) * 4) = w; }
            }
            LDS_WAIT();
        }
    }
    GRID_SYNC();
    if (DBG_STOP == 4) DUMP_LOOP(bf2f(OCMP[i_ & 8388607]) + (float)(SEL[i_ & 131071] & 0xffffu));

    {
        constexpr int RB = 4, SLOTB = 32768;
        const unsigned ring_base = (unsigned)(size_t)ldsl;
        const unsigned char* ring = (const unsigned char*)lds;
        unsigned* Usc = (unsigned*)(lds + RB * SLOTB);
        int* lst = (int*)(lds + RB * SLOTB + 128);
        int* nls = (int*)(lds + RB * SLOTB + 128 + 1024);
        int* flg = (int*)(lds + RB * SLOTB + 128 + 1024 + 128);
        const int dl_r = lane >> 3, dl_c = lane & 7;
        const unsigned voffK = (unsigned)((8 * (dl_r >> 2) + (dl_r & 3)) * 128 + ((dl_c ^ dl_r) << 4)), voffV = (unsigned)(dl_r * SEQ * 2 + ((dl_c ^ dl_r) << 4));
        const int offA = fr * 128 + ((fq ^ (fr & 7)) << 4), offB = fr * 128 + (((fq ^ (fr & 7)) ^ 4) << 4);
        for (int rep = 0; rep < args.rep[2]; ++rep)
        for (int wu = blockIdx.x; wu < 512; wu += G) {
            const int k_ = wu >> 8, bb_ = wu & 255, bg = 2 * k_ + (bb_ >> 7), tau = (bb_ & 128) ? 127 - (bb_ & 127) : (bb_ & 127), tile = k_ ? 127 - tau : tau;
            const int t0w = tile * 64, t0 = t0w + 8 * wave, b = bg >> 1, g = bg & 1;
            const int tl = fr >> 2, hh = fr & 3, head = g * 4 + hh;
            const bf16_t* Ks = KSL + (size_t)bg * SEQ * 64; const bf16_t* Vs = VSLT + (size_t)bg * 64 * SEQ;
            const bf16_t* Kw = KWN + (size_t)bg * SEQ * 64; const bf16_t* Vw = VWNT + (size_t)bg * 64 * SEQ;
            bf16x8 qf[2][2]; u32x4 mym[2]; unsigned Uw[2][4]; int tr[2];
#pragma unroll
            for (int rg = 0; rg < 2; ++rg) {
                tr[rg] = t0 + 4 * rg + tl;
                const size_t qrow = (size_t)(b * SEQ + tr[rg]);
                qf[rg][0] = *(const bf16x8*)(NQ + qrow * 512 + head * 64 + 8 * fq); qf[rg][1] = *(const bf16x8*)(NQ + qrow * 512 + head * 64 + 32 + 8 * fq);
                mym[rg] = *(const u32x4*)(SEL + ((size_t)bg * SEQ + tr[rg]) * 4);
#pragma unroll
                for (int w = 0; w < 4; ++w) { const unsigned mw = mym[rg][w];
                    Uw[rg][w] = (unsigned)__builtin_amdgcn_readlane((int)mw, 0) | (unsigned)__builtin_amdgcn_readlane((int)mw, 4) | (unsigned)__builtin_amdgcn_readlane((int)mw, 8) | (unsigned)__builtin_amdgcn_readlane((int)mw, 12); }
            }
            if (lane == 0) { Usc[wave * 4 + 0] = Uw[0][0] | Uw[1][0]; Usc[wave * 4 + 1] = Uw[0][1] | Uw[1][1]; Usc[wave * 4 + 2] = Uw[0][2] | Uw[1][2]; Usc[wave * 4 + 3] = Uw[0][3] | Uw[1][3]; }
            __syncthreads();
            if (wave == 0) {
                int n0 = 0;
#pragma unroll
                for (int q = 0; q < 2; ++q) { const int j = lane + 64 * q; unsigned ug = 0u;
#pragma unroll
                    for (int ww = 0; ww < 8; ++ww) ug |= Usc[ww * 4 + (j >> 5)];
                    const bool in = ((ug >> (j & 31)) & 1u) && (64 * j <= t0w + 63);
                    const unsigned long long bal = __ballot(in);
                    const int pos = n0 + __builtin_popcountll(bal & ((1ull << lane) - 1ull));
                    if (in) lst[pos] = j;
                    n0 += __builtin_popcountll(bal); }
                if (n0 & 1) { if (lane == 0) lst[n0] = 0x100; ++n0; }
                const int jw0 = (t0w - 511 > 0 ? t0w - 511 : 0) >> 6, nw = ((t0w + 63) >> 6) - jw0 + 1;
                if (lane < nw) lst[n0 + lane] = (jw0 + lane) | 0x80;
                if ((nw & 1) && lane == 0) lst[n0 + nw] = 0x180;
                if (lane == 0) nls[0] = n0 + ((nw + 1) & ~1);
                if (lane < 16) flg[lane] = 0;
            }
            __syncthreads();
            const int n = RFL(nls[0]);
            float mS[2], lS[2]; f32x4 oS[2][4];
#pragma unroll
            for (int rg = 0; rg < 2; ++rg) { mS[rg] = NEGBIG; lS[rg] = 0.f;
#pragma unroll
                for (int nt = 0; nt < 4; ++nt) oS[rg][nt] = (f32x4){0.f, 0.f, 0.f, 0.f}; }
            int nslc_ = 0;
            { int c_ = 0; for (int i_ = lane; i_ < n; i_ += 64) c_ += (lst[i_] & 0x80) ? 0 : 1; c_ = (int)wave_sum((float)c_); nslc_ = RFL(c_); }
#define RG_WAIT(ptr, target) do { while (__hip_atomic_load((ptr), __ATOMIC_RELAXED, __HIP_MEMORY_SCOPE_WORKGROUP) < (target)) __builtin_amdgcn_s_sleep(1); asm volatile("" ::: "memory"); } while (0)
#define RG_SIGNAL(ptr) do { LDS_WAIT(); if (lane == 0) __hip_atomic_fetch_add((ptr), 1, __ATOMIC_RELAXED, __HIP_MEMORY_SCOPE_WORKGROUP); } while (0)
#define DMA_ISSUE(k_) do { const int slot_ = (k_) % RB; RG_WAIT(flg + 8 + slot_, 8 * ((k_) / RB)); \
                for (int sub_ = 0; sub_ < 2; ++sub_) { const int e_ = RFL(lst[2 * (k_) + sub_]); \
                  if (!(e_ & 0x100)) { \
                    const int j_ = e_ & 127; const bf16_t* Kg_ = (e_ & 0x80) ? Kw : Ks; const bf16_t* Vg_ = (e_ & 0x80) ? Vw : Vs; const unsigned sb_ = ring_base + slot_ * SLOTB + sub_ * 16384; \
                    _Pragma("unroll") for (int q_ = 0; q_ < 8; ++q_) { constexpr int RC_[4] = {0, 16, 4, 20}; \
                        glds16s(Kg_ + (size_t)(64 * j_ + 32 * (q_ >> 2) + RC_[q_ & 3]) * 64, voffK, sb_ + q_ * 1024); } \
                    _Pragma("unroll") for (int q_ = 0; q_ < 8; ++q_) glds16s(Vg_ + (size_t)(8 * q_) * SEQ + 64 * j_, voffV, sb_ + 8192 + q_ * 1024); } } \
                } while (0)
#define DMA_PUBLISH(k_) do { asm volatile("s_waitcnt vmcnt(0)" ::: "memory"); if (lane == 0) __hip_atomic_store(flg + ((k_) % RB), (k_) / RB + 1, __ATOMIC_RELAXED, __HIP_MEMORY_SCOPE_WORKGROUP); } while (0)
#define ST_COMPUTE(s_, WIN) do { const int slot = (s_) % RB; \
                RG_WAIT(flg + slot, (s_) / RB + 1); \
                for (int sub = 0; sub < 2; ++sub) { const int e = RFL(lst[2 * (s_) + sub]); if (e & 0x100) continue; const int j = e & 127; \
                const unsigned char* Kt = ring + slot * SLOTB + sub * 16384; const unsigned char* Vt = Kt + 8192; \
                bool act[2], inter[2]; float rb[2]; \
                _Pragma("unroll") for (int rg = 0; rg < 2; ++rg) { const int t0g = t0 + 4 * rg; \
                    if (WIN) { act[rg] = (64 * j + 63 >= t0g - 511) && (64 * j <= t0g + 3); inter[rg] = (64 * j >= t0g + 3 - 511) && (64 * j + 63 <= t0g); rb[rg] = 0.f; } \
                    else { const unsigned uw = j < 32 ? Uw[rg][0] : j < 64 ? Uw[rg][1] : j < 96 ? Uw[rg][2] : Uw[rg][3]; act[rg] = (((uw >> (j & 31)) & 1u) != 0u) && (64 * j <= t0g + 3); \
                           const unsigned mw_ = j < 32 ? mym[rg].x : j < 64 ? mym[rg].y : j < 96 ? mym[rg].z : mym[rg].w; rb[rg] = ((mw_ >> (j & 31)) & 1u) ? 0.f : NEGBIG; inter[rg] = (64 * j + 63 <= t0g); } } \
                _Pragma("unroll") for (int rg = 0; rg < 2; ++rg) if (act[rg]) { \
                    const int t = tr[rg]; f32x4 sc[4]; bf16x8 pf0, pf1; bf16x8 kf[8], vf[8]; \
                    _Pragma("unroll") for (int q_ = 0; q_ < 4; ++q_) { kf[2 * q_] = *(const bf16x8*)(Kt + offA + q_ * 2048); kf[2 * q_ + 1] = *(const bf16x8*)(Kt + offB + q_ * 2048); } \
                    __builtin_amdgcn_sched_barrier(0);     \
                    { const f32x4 z_ = {0.f, 0.f, 0.f, 0.f}; \
                      _Pragma("unroll") for (int q_ = 0; q_ < 4; ++q_) { sc[q_] = MFMA16(kf[2 * q_], qf[rg][0], z_); sc[q_] = MFMA16(kf[2 * q_ + 1], qf[rg][1], sc[q_]); } } \
                    vf[0] = *(const bf16x8*)(Vt + offA); vf[1] = *(const bf16x8*)(Vt + offB); \
                    __builtin_amdgcn_sched_barrier(0);     \
                    if (inter[rg]) soft_step64<false>(sc, 64 * j + 8 * fq, (WIN) ? t - 511 : 0, t, rb[rg], mS[rg], lS[rg], oS[rg], pf0, pf1); \
                    else soft_step64<true>(sc, 64 * j + 8 * fq, (WIN) ? t - 511 : 0, t, rb[rg], mS[rg], lS[rg], oS[rg], pf0, pf1); \
                    __builtin_amdgcn_sched_barrier(0); \
                    _Pragma("unroll") for (int nt = 1; nt < 4; ++nt) { vf[2 * nt] = *(const bf16x8*)(Vt + offA + nt * 2048); vf[2 * nt + 1] = *(const bf16x8*)(Vt + offB + nt * 2048); } \
                    __builtin_amdgcn_sched_barrier(0); \
                    _Pragma("unroll") for (int nt = 0; nt < 4; ++nt) { oS[rg][nt] = MFMA16(vf[2 * nt], pf0, oS[rg][nt]); oS[rg][nt] = MFMA16(vf[2 * nt + 1], pf1, oS[rg][nt]); } \
                } } \
                RG_SIGNAL(flg + 8 + slot); } while (0)
#define ST_STAGE(s_, WIN) do { \
                if ((((s_) + 1) & 7) == wave && (s_) >= 1 && (s_) + 1 < np_) DMA_PUBLISH((s_) + 1);            \
                if ((((s_) + 2) & 7) == wave && (s_) + 2 < np_) DMA_ISSUE((s_) + 2); \
                ST_COMPUTE(s_, WIN); } while (0)
            const int np_ = n >> 1, nps_ = nslc_ >> 1;
            if (wave < 2 && wave < np_) { DMA_ISSUE(wave); DMA_PUBLISH(wave); }
            for (int s = 0; s < nps_; ++s) ST_STAGE(s, false);
#pragma unroll
            for (int rg = 0; rg < 2; ++rg) {
                const size_t qrow = (size_t)(b * SEQ + tr[rg]);
                const float a1 = NG[qrow * 24 + 8 + head] / lS[rg];
#pragma unroll
                for (int nt = 0; nt < 4; ++nt) { unsigned* op = (unsigned*)(OCMP + qrow * 512 + head * 64 + 16 * nt + 4 * fq);
                    const unsigned w0 = op[0], w1 = op[1];
                    const float r0 = __uint_as_float(w0 << 16) + a1 * oS[rg][nt][0], r1 = __uint_as_float(w0 & 0xffff0000u) + a1 * oS[rg][nt][1];
                    const float r2 = __uint_as_float(w1 << 16) + a1 * oS[rg][nt][2], r3 = __uint_as_float(w1 & 0xffff0000u) + a1 * oS[rg][nt][3];
                    if (rep == args.rep[2] - 1) { op[0] = cvt_pk_bf16(r0, r1); op[1] = cvt_pk_bf16(r2, r3); }
                    oS[rg][nt] = (f32x4){0.f, 0.f, 0.f, 0.f}; }
                mS[rg] = NEGBIG; lS[rg] = 0.f;
            }
            asm volatile("s_waitcnt vmcnt(0)" ::: "memory");
            for (int s = nps_; s < np_; ++s) ST_STAGE(s, true);
#pragma unroll
            for (int rg = 0; rg < 2; ++rg) {
                const size_t qrow = (size_t)(b * SEQ + tr[rg]);
                const float a2 = NG[qrow * 24 + 16 + head] / lS[rg];
#pragma unroll
                for (int nt = 0; nt < 4; ++nt) { unsigned* op = (unsigned*)(OCMP + qrow * 512 + head * 64 + 16 * nt + 4 * fq);
                    const unsigned w0 = op[0], w1 = op[1];
                    const float r0 = __uint_as_float(w0 << 16) + a2 * oS[rg][nt][0], r1 = __uint_as_float(w0 & 0xffff0000u) + a2 * oS[rg][nt][1];
                    const float r2 = __uint_as_float(w1 << 16) + a2 * oS[rg][nt][2], r3 = __uint_as_float(w1 & 0xffff0000u) + a2 * oS[rg][nt][3];
                    if (rep == args.rep[2] - 1) { op[0] = cvt_pk_bf16(r0, r1); op[1] = cvt_pk_bf16(r2, r3); } }
            }
            LDS_WAIT();
        }
    }
    __syncthreads();
#ifndef SWA_MUL
#define SWA_MUL 1
#endif
    {
        constexpr int RS = 72;
        bf16_t* Kb = (bf16_t*)lds; bf16_t* Vb = (bf16_t*)(lds + 2 * 64 * RS * 2);
        const int skr = tid >> 3, sc8 = (tid & 7) * 8;
        const int krow = (skr & 32) + (((skr & 7) < 4) ? (4 * ((skr & 31) >> 3) + (skr & 7)) : (16 + 4 * ((skr & 31) >> 3) + (skr & 7) - 4));
        for (int rep = 0, nrepS = args.rep[2] * SWA_MUL; rep < nrepS; ++rep)
        for (int wu = blockIdx.x; wu < 512; wu += G) {
            const int b = wu >> 8, t0w = (wu & 255) * 32, t0 = t0w + 4 * wave;
            const int tl = fr >> 3, h = fr & 7;
            const bf16_t* Kp = SK + (size_t)b * SEQ * 64; const bf16_t* Vp = SVT + (size_t)b * 64 * SEQ;
            bf16x8 qf[2][2]; int tr[2]; float mS[2], lS[2]; f32x4 oS[2][4];
#pragma unroll
            for (int rg = 0; rg < 2; ++rg) { tr[rg] = t0 + 2 * rg + tl; const size_t qrow = (size_t)(b * SEQ + tr[rg]);
                qf[rg][0] = *(const bf16x8*)(SQ + qrow * 512 + h * 64 + 8 * fq); qf[rg][1] = *(const bf16x8*)(SQ + qrow * 512 + h * 64 + 32 + 8 * fq);
                mS[rg] = NEGBIG; lS[rg] = 0.f;
#pragma unroll
                for (int nt = 0; nt < 4; ++nt) oS[rg][nt] = (f32x4){0.f, 0.f, 0.f, 0.f}; }
            const int jlo = (t0w - 127 > 0 ? t0w - 127 : 0) >> 6, n = ((t0w + 31) >> 6) - jlo + 1;
            u32x4 kreg, vreg;
#define SW_LOAD(j_) do { kreg = *(const u32x4*)(Kp + (size_t)(64 * (j_) + skr) * 64 + sc8); vreg = *(const u32x4*)(Vp + (size_t)skr * SEQ + 64 * (j_) + sc8); } while (0)
#define SW_WRITE(bufi) do { *(u32x4*)(Kb + (bufi) * 64 * RS + krow * RS + sc8) = kreg; *(u32x4*)(Vb + (bufi) * 64 * RS + skr * RS + sc8) = vreg; } while (0)
            SW_LOAD(jlo); SW_WRITE(0);
            __syncthreads();
            for (int s = 0; s < n; ++s) {
                const int j = jlo + s;
                if (s + 1 < n) SW_LOAD(j + 1);
                const bf16_t* Kt = Kb + (s & 1) * 64 * RS; const bf16_t* Vt = Vb + (s & 1) * 64 * RS;
#pragma unroll
                for (int rg = 0; rg < 2; ++rg) {
                    const int t0g = t0 + 2 * rg, t = tr[rg];
                    const bool act = (64 * j + 63 >= t0g - 127) && (64 * j <= t0g + 1), inter = (64 * j >= t0g + 1 - 127) && (64 * j + 63 <= t0g);
                    if (act) {
                        f32x4 sc[4]; bf16x8 pf0, pf1;
                        { const bf16_t* ka = Kt + fr * RS + 8 * fq; const f32x4 z_ = {0.f, 0.f, 0.f, 0.f};
#pragma unroll
                          for (int q_ = 0; q_ < 4; ++q_) { const bf16x8 ka0 = *(const bf16x8*)(ka + 16 * q_ * RS), ka1 = *(const bf16x8*)(ka + 16 * q_ * RS + 32);
                              sc[q_] = MFMA16(ka0, qf[rg][0], z_); sc[q_] = MFMA16(ka1, qf[rg][1], sc[q_]); } }
                        if (inter) soft_step64<false>(sc, 64 * j + 8 * fq, t - 127, t, 0.f, mS[rg], lS[rg], oS[rg], pf0, pf1);
                        else soft_step64<true>(sc, 64 * j + 8 * fq, t - 127, t, 0.f, mS[rg], lS[rg], oS[rg], pf0, pf1);
                        { const bf16_t* va = Vt + fr * RS + 8 * fq;
#pragma unroll
                          for (int nt = 0; nt < 4; ++nt) { const bf16x8 va0 = *(const bf16x8*)(va + 16 * nt * RS), va1 = *(const bf16x8*)(va + 16 * nt * RS + 32);
                              oS[rg][nt] = MFMA16(va0, pf0, oS[rg][nt]); oS[rg][nt] = MFMA16(va1, pf1, oS[rg][nt]); } }
                    }
                }
                if (s + 1 < n) SW_WRITE((s + 1) & 1);
                __syncthreads();
            }
#pragma unroll
            for (int rg = 0; rg < 2; ++rg) {
                const size_t qrow = (size_t)(b * SEQ + tr[rg]);
                const float sink2 = args.in[14][h] * LOG2E, mf = fmaxf(mS[rg], sink2), aa = fast_exp2(mS[rg] - mf), lt = lS[rg] * aa + fast_exp2(sink2 - mf), scl = aa / lt;
#pragma unroll
                for (int nt = 0; nt < 4; ++nt) { unsigned* op = (unsigned*)(OB + qrow * 512 + h * 64 + 16 * nt + 4 * fq);
                    if (rep == nrepS - 1) { op[0] = cvt_pk_bf16(oS[rg][nt][0] * scl, oS[rg][nt][1] * scl); op[1] = cvt_pk_bf16(oS[rg][nt][2] * scl, oS[rg][nt][3] * scl); } }
            }
        }
    }
    GRID_SYNC();
    if (DBG_STOP == 5) DUMP_LOOP(bf2f(OCMP[i_ & 8388607]) + bf2f(SQ[i_ & 8388607]));
    if (DBG_STOP == 10) DUMP_LOOP(bf2f(GA[i_]) + bf2f(GB[i_]));

#if !defined(DBG_SKIP_PASS1)
    { pg8::Gemm g{OCMP, WA, TOK, DM, 512}; pg8::StaticOrder S; S.init(TOK, DM, G, (int)blockIdx.x);
      pg8::EpiMerge<1> E{GA, nullptr};
      pg8::gemm_phase<pg8::EpiMerge<1>, pg8::StaticOrder, true, true>(ldsl, g, S, E); }
    if (DBG_STOP == 8) { GRID_SYNC(); DUMP_LOOP(bf2f(GA[i_])); }
    if (DBG_STOP == 9) GRID_SYNC();
#endif
#if !defined(DBG_SKIP_PASS2)
    { pg8::Gemm g{OB, WB, TOK, DM, 512}; pg8::StaticOrder S; S.init(TOK, DM, G, (int)blockIdx.x);
      pg8::EpiMerge<2> E{GA, GB};
      pg8::gemm_phase<pg8::EpiMerge<2>, pg8::StaticOrder, true, true>(ldsl, g, S, E); }
#endif
    GRID_SYNC();
    if (DBG_STOP == 6) DUMP_LOOP(bf2f(GA[i_]));
    { pg8::Gemm g{GA, WOUT, TOK, DM, DM}; pg8::StaticOrder S; S.init(TOK, DM, G, (int)blockIdx.x);
#if defined(DBG_NOFFN1)
      pg8::EpiResid E{x, H, XB, SSQ2, 1.0f};
#else
      pg8::EpiResid E{H, H, XB, SSQ2, 1.0f};
#endif
      pg8::gemm_phase<pg8::EpiResid, pg8::StaticOrder, true, true>(ldsl, g, S, E); }
    GRID_SYNC();
    if (DBG_STOP == 7) return;
    { pg8::Gemm g{XB, W2GU, TOK, 2 * DFF, DM}; pg8::StaticOrder S; S.init(TOK, 2 * DFF, G, (int)blockIdx.x);
      pg8::EpiSwiglu E{ACT, SSQ2};
      pg8::gemm_phase<pg8::EpiSwiglu, pg8::StaticOrder, true, true>(ldsl, g, S, E); }
    GRID_SYNC();
    if (G == 256) {
        pg8::Gemm g{ACT, W2D, TOK, DM, DFF}; pg8::StaticOrder S; S.init(TOK, DM, G, (int)blockIdx.x);
        pg8::EpiFinal E{H, H, SSQ3, args.in[22], (unsigned*)(ws + WS_BAR) + 3520, 0.5f};
        pg8::gemm_phase<pg8::EpiFinal, pg8::StaticOrder, true, true>(ldsl, g, S, E);
    } else {
        { pg8::Gemm g{ACT, W2D, TOK, DM, DFF}; pg8::StaticOrder S; S.init(TOK, DM, G, (int)blockIdx.x);
          pg8::EpiResid E{H, H, nullptr, SSQ3, 0.5f};
          pg8::gemm_phase<pg8::EpiResid, pg8::StaticOrder, true, true>(ldsl, g, S, E); }
        GRID_SYNC();
        const float* gf = args.in[22];
        for (int mrow = gw; mrow < TOK; mrow += NGW) {
            const float rs = pg8::rstd_of(SSQ3, mrow);
            f32x4* hr = (f32x4*)(H + (size_t)mrow * DM) + lane; const f32x4* gr = (const f32x4*)gf + lane;
#pragma unroll
            for (int j = 0; j < 4; ++j) { const f32x4 v = hr[64 * j], gg = gr[64 * j]; hr[64 * j] = v * rs * gg; }
        }
    }
}

extern "C" void kernel_launch(void* const* d_in, const int* in_sizes, int n_in, void* d_out, int out_size, void* d_ws, size_t ws_size, hipStream_t stream) {
    static int grid = 0;
    if (grid == 0) {
        int dev = 0, cus = 0, per_cu = 0;
        hipGetDevice(&dev);
        hipDeviceGetAttribute(&cus, hipDeviceAttributeMultiprocessorCount, dev);
        hipFuncSetAttribute((const void*)nsa_fwd, hipFuncAttributeMaxDynamicSharedMemorySize, LDS_BYTES);
        hipOccupancyMaxActiveBlocksPerMultiprocessor(&per_cu, (const void*)nsa_fwd, NWAVES * 64, LDS_BYTES);
        (void)hipGetLastError();
        if (per_cu < 1) per_cu = 1;
        grid = cus;
        if (n_in != 23 || ws_size < WS_END) { fprintf(stderr, "kernel_launch: unexpected n_in %d / ws %zu\n", n_in, ws_size); }
    }
    if (hipMemsetAsync((char*)d_ws + WS_BAR, 0, BAR_BYTES, stream) != hipSuccess) fprintf(stderr, "kernel_launch: memset of barrier words failed\n");
    Args a{};
    for (int i = 0; i < 23; ++i) a.in[i] = (const float*)d_in[i];
    a.out = (float*)d_out; a.ws = (unsigned char*)d_ws;
#ifndef REP4
#define REP4 1
#endif
#ifndef REP5
#define REP5 1
#endif
#ifndef REP6
#define REP6 1
#endif
#ifndef REPG
#define REPG 0
#endif
    a.rep[0] = REP4; a.rep[1] = REP5; a.rep[2] = REP6; a.rep[3] = REPG;
    void* kargs[] = {&a};
    hipError_t e = hipLaunchCooperativeKernel((const void*)nsa_fwd, dim3(grid), dim3(NWAVES * 64), kargs, LDS_BYTES, stream);
    if (e != hipSuccess) fprintf(stderr, "cooperative launch failed: %s (grid %d)\n", hipGetErrorString(e), grid);
}
```

```cpp
#include <hip/hip_runtime.h>
#include <hip/hip_cooperative_groups.h>
#include <cstdio>
#include <cstdint>
namespace cg = cooperative_groups;

constexpr int SEQ = 8192, NB = 2, TOK = NB * SEQ, DM = 1024, DFF = 2816;
constexpr float RMS_EPS = 1e-6f;
constexpr float LOG2E = 1.4426950408889634f;
constexpr float C2 = 0.125f * 1.4426950408889634f;
namespace pg8 {
#define PG8_LAS __attribute__((address_space(3)))
typedef unsigned short bf16_t;
typedef short bf16x8 __attribute__((ext_vector_type(8)));
typedef float f32x4 __attribute__((ext_vector_type(4)));
typedef unsigned u32x4 __attribute__((ext_vector_type(4)));
constexpr int BM = 256, BK = 64, HALF = 128, HTB = HALF * BK * 2  , STAGE_BYTES = 8 * HTB, NXCD = 8, WGM = 8;

__host__ __device__ __forceinline__ int lds_byte(int r, int c) { const int st = (r >> 4) * 2 + (c >> 5), rr = r & 15, cc = c & 31, ob = rr * 64 + cc * 2; return st * 1024 + (ob ^ (((ob >> 9) & 1) << 5)); }
__host__ __device__ __forceinline__ void stage_rc(int b, int& R, int& C) { const int st = b / 1024, sb = b % 1024, swz = sb ^ (((sb >> 9) & 1) << 5); R = (st >> 1) * 16 + swz / 64; C = (st & 1) * 32 + (swz % 64) / 2; }
__host__ __device__ __forceinline__ int perm32(int rho) { const int n = rho >> 4, i = rho & 15; return 8 * (i >> 2) + 4 * n + (i & 3); }

struct Unit { int pm, pn; };
struct Gemm { const bf16_t* A; const bf16_t* Bt; int M, N, K; };

struct StaticOrder {
    int nM, nN, nwg, G, c;
    __host__ __device__ void init(int M, int N, int G_, int c_) { nM = M / BM; nN = N / BM; nwg = nM * nN; G = G_; c = c_; }
    __host__ __device__ bool next(int i, Unit& u) const {
        const long L = (long)i * G + c; if (L >= nwg) return false;
        int wgid = (int)L; { const int q = nwg / NXCD, r = nwg % NXCD, xcd = wgid % NXCD, off = wgid / NXCD; wgid = (xcd < r ? xcd * (q + 1) : r * (q + 1) + (xcd - r) * q) + off; }
        const int nig = WGM * nN, gid = wgid / nig, fm = gid * WGM, gsz = (nM - fm) < WGM ? (nM - fm) : WGM;
        u.pm = fm + ((wgid % nig) % gsz); u.pn = (wgid % nig) / gsz; return true;
    }
    __device__ __forceinline__ void a_ready(const Unit&) const {}
    __device__ __forceinline__ void done(const Unit&) const {}
};

typedef __bf16 bf16x2n __attribute__((ext_vector_type(2)));
typedef float f32x2n __attribute__((ext_vector_type(2)));
__device__ __forceinline__ unsigned cvt_pk_bf16(float lo, float hi) { const f32x2n v = {lo, hi}; return __builtin_bit_cast(unsigned, __builtin_convertvector(v, bf16x2n)); }
typedef float f32x2 __attribute__((ext_vector_type(2)));
__device__ __forceinline__ float fast_rcp(float x) { return __builtin_amdgcn_rcpf(x); }
__device__ __forceinline__ float fast_exp2(float x) { return __builtin_amdgcn_exp2f(x); }
__device__ __forceinline__ float sigmoidf_(float x) { return fast_rcp(1.0f + fast_exp2(-x * 1.4426950408889634f)); }
__device__ __forceinline__ float bf2f(unsigned short b) { return __uint_as_float(((unsigned)b) << 16); }
__device__ __forceinline__ u32x4 pack8(f32x4 a, f32x4 b) { u32x4 w; w.x = cvt_pk_bf16(a[0], a[1]); w.y = cvt_pk_bf16(a[2], a[3]); w.z = cvt_pk_bf16(b[0], b[1]); w.w = cvt_pk_bf16(b[2], b[3]); return w; }
__device__ __forceinline__ float rstd_of(const float* ssq, int row) {
    const f32x4* p = (const f32x4*)(ssq + (size_t)row * 16); const f32x4 a = p[0], b = p[1], c = p[2], d = p[3];
    const float s = (((a[0] + a[1]) + (a[2] + a[3])) + ((b[0] + b[1]) + (b[2] + b[3]))) + (((c[0] + c[1]) + (c[2] + c[3])) + ((d[0] + d[1]) + (d[2] + d[3])));
    return 1.0f / sqrtf(s * (1.0f / 1024.0f) + 1e-6f); }

template <bool NT> __device__ __forceinline__ float rstd_row(const float* ssq, int row) {
    const f32x4* p = (const f32x4*)(ssq + (size_t)row * 16);
    const f32x4 a = NT ? __builtin_nontemporal_load(p) : p[0], b = NT ? __builtin_nontemporal_load(p + 1) : p[1], c = NT ? __builtin_nontemporal_load(p + 2) : p[2], d = NT ? __builtin_nontemporal_load(p + 3) : p[3];
    const float s = (((a[0] + a[1]) + (a[2] + a[3])) + ((b[0] + b[1]) + (b[2] + b[3]))) + (((c[0] + c[1]) + (c[2] + c[3])) + ((d[0] + d[1]) + (d[2] + d[3])));
    return 1.0f / sqrtf(s * (1.0f / 1024.0f) + 1e-6f); }
template <bool NT> __device__ __forceinline__ void wave_rstd8(const float* ssq, int rowbase, float (&rs)[2][4]) {
    const int lane = threadIdx.x & 63;
    const float v0 = rstd_row<NT>(ssq, rowbase + lane), v1 = rstd_row<NT>(ssq, rowbase + HALF + lane);
#pragma unroll
    for (int m = 0; m < 4; ++m) { rs[0][m] = __shfl(v0, m * 16 + (lane & 15)); rs[1][m] = __shfl(v1, m * 16 + (lane & 15)); }
}

struct EpiSwiglu {
    static constexpr bool PERM = true, AFTER_DRAIN = false;
    bf16_t* O; const float* ssq;
    __device__ __forceinline__ void operator()(const f32x4 (&acc)[2][2][4][2], const Unit& u, int wr, int wc, int fr, int fq) const {
        asm volatile("" : "+v"(fr), "+v"(fq));
        const int row0 = u.pm * BM + wr * 64 + fr, col0 = u.pn * 128 + wc * 32 + 8 * fq;
        float rsv[2][4]; wave_rstd8<false>(ssq, u.pm * BM + wr * 64, rsv);
#pragma unroll
        for (int ai = 0; ai < 2; ++ai)
#pragma unroll
            for (int m = 0; m < 4; ++m) {
                const int row = row0 + ai * HALF + m * 16; const float rs = rsv[ai][m];
                f32x4 o[2];
#pragma unroll
                for (int n = 0; n < 2; ++n) {
                    const f32x4 g = acc[ai][0][m][n] * rs, up = acc[ai][1][m][n] * rs;
#pragma unroll
                    for (int j = 0; j < 4; ++j) o[n][j] = g[j] * sigmoidf_(g[j]) * up[j];
                }
                *(u32x4*)(O + (size_t)row * 2816 + col0) = pack8(o[0], o[1]);
            }
    }
};

struct EpiResid {
    static constexpr bool PERM = true, AFTER_DRAIN = false;
    const float* base; float* out; bf16_t* xb; float* ssq; float scale;
    __device__ __forceinline__ void operator()(const f32x4 (&acc)[2][2][4][2], const Unit& u, int wr, int wc, int fr, int fq) const {
        asm volatile("" : "+v"(fr), "+v"(fq));
        const int row0 = u.pm * BM + wr * 64 + fr, col0 = u.pn * BM + wc * 32 + 8 * fq;
        f32x4 nb[2][2];
#pragma unroll
        for (int bj = 0; bj < 2; ++bj) { const size_t off = (size_t)row0 * 1024 + col0 + bj * HALF; nb[bj][0] = *(const f32x4*)(base + off); nb[bj][1] = *(const f32x4*)(base + off + 4); }
#pragma unroll
        for (int it = 0; it < 8; ++it) {
            const int ai = it >> 2, m = it & 3;
            const int row = row0 + ai * HALF + m * 16; float s = 0.f;
            f32x4 cb[2][2];
#pragma unroll
            for (int bj = 0; bj < 2; ++bj) { cb[bj][0] = nb[bj][0]; cb[bj][1] = nb[bj][1]; }
            if (it < 7) { const int rown = row0 + ((it + 1) >> 2) * HALF + ((it + 1) & 3) * 16;
#pragma unroll
                for (int bj = 0; bj < 2; ++bj) { const size_t off = (size_t)rown * 1024 + col0 + bj * HALF; nb[bj][0] = *(const f32x4*)(base + off); nb[bj][1] = *(const f32x4*)(base + off + 4); } }
#pragma unroll
            for (int bj = 0; bj < 2; ++bj) {
                const size_t off = (size_t)row * 1024 + col0 + bj * HALF;
                const f32x4 h0 = cb[bj][0] + acc[ai][bj][m][0] * scale, h1 = cb[bj][1] + acc[ai][bj][m][1] * scale;
                *(f32x4*)(out + off) = h0; *(f32x4*)(out + off + 4) = h1;
                if (xb) *(u32x4*)(xb + off) = pack8(h0, h1);
                s += (h0[0] * h0[0] + h0[1] * h0[1]) + (h0[2] * h0[2] + h0[3] * h0[3]) + (h1[0] * h1[0] + h1[1] * h1[1]) + (h1[2] * h1[2] + h1[3] * h1[3]);
            }
            s += __shfl_xor(s, 16); s += __shfl_xor(s, 32);
            if (fq == 0) ssq[(size_t)row * 16 + u.pn * 4 + wc] = s;
            asm volatile("" ::: "memory");
        }
    }
};

template <int PASS> struct EpiMerge {
    static constexpr bool PERM = true, AFTER_DRAIN = false;
    bf16_t* G; const bf16_t* G2;
    __device__ __forceinline__ void operator()(const f32x4 (&acc)[2][2][4][2], const Unit& u, int wr, int wc, int fr, int fq) const {
        asm volatile("" : "+v"(fr), "+v"(fq));
        const int row0 = u.pm * BM + wr * 64 + fr, col0 = u.pn * BM + wc * 32 + 8 * fq;
        unsigned ng[2][4]; u32x4 ng2[2];
#define EPM_LOAD(rw) do { _Pragma("unroll") for (int bj = 0; bj < 2; ++bj) { const size_t off_ = (size_t)(rw) * 1024 + col0 + bj * HALF; unsigned* gp_ = (unsigned*)(G + off_); \
            _Pragma("unroll") for (int q = 0; q < 4; ++q) ng[bj][q] = __hip_atomic_load(gp_ + q, __ATOMIC_RELAXED, __HIP_MEMORY_SCOPE_AGENT); \
            if (PASS == 2) ng2[bj] = *(const u32x4*)(G2 + off_); } } while (0)
        EPM_LOAD(row0);
#pragma unroll
        for (int it = 0; it < 8; ++it) {
            const int ai = it >> 2, m = it & 3;
            const int row = row0 + ai * HALF + m * 16;
            unsigned gw[2][4]; u32x4 g2[2];
#pragma unroll
            for (int bj = 0; bj < 2; ++bj) { g2[bj] = ng2[bj];
#pragma unroll
                for (int q = 0; q < 4; ++q) gw[bj][q] = ng[bj][q]; }
            if (it < 7) { const int rown = row0 + ((it + 1) >> 2) * HALF + ((it + 1) & 3) * 16; EPM_LOAD(rown); }
#pragma unroll
            for (int bj = 0; bj < 2; ++bj) {
                const size_t off = (size_t)row * 1024 + col0 + bj * HALF;
                f32x4 r0, r1;
#pragma unroll
                for (int q = 0; q < 2; ++q) {
                    const float glo = __uint_as_float(gw[bj][q] << 16), ghi = __uint_as_float(gw[bj][q] & 0xffff0000u), hlo = __uint_as_float(gw[bj][2 + q] << 16), hhi = __uint_as_float(gw[bj][2 + q] & 0xffff0000u);
                    if (PASS == 1) { r0[2 * q] = glo * acc[ai][bj][m][0][2 * q]; r0[2 * q + 1] = ghi * acc[ai][bj][m][0][2 * q + 1]; r1[2 * q] = hlo * acc[ai][bj][m][1][2 * q]; r1[2 * q + 1] = hhi * acc[ai][bj][m][1][2 * q + 1]; }
                    else { const unsigned a_ = g2[bj][q], b_ = g2[bj][2 + q];
                        r0[2 * q] = glo + __uint_as_float(a_ << 16) * acc[ai][bj][m][0][2 * q]; r0[2 * q + 1] = ghi + __uint_as_float(a_ & 0xffff0000u) * acc[ai][bj][m][0][2 * q + 1];
                        r1[2 * q] = hlo + __uint_as_float(b_ << 16) * acc[ai][bj][m][1][2 * q]; r1[2 * q + 1] = hhi + __uint_as_float(b_ & 0xffff0000u) * acc[ai][bj][m][1][2 * q + 1]; }
                }
                *(u32x4*)(G + off) = pack8(r0, r1);
            }
            asm volatile("" ::: "memory");
        }
#undef EPM_LOAD
    }
};

__device__ __forceinline__ void rope8(f32x4& v0, f32x4& v1, const f32x4 c, const f32x4 s) {
    f32x4 a, b;
    a[0] = v0[0] * c[0] - v0[1] * s[0]; a[1] = v0[1] * c[0] + v0[0] * s[0];
    a[2] = v0[2] * c[1] - v0[3] * s[1]; a[3] = v0[3] * c[1] + v0[2] * s[1];
    b[0] = v1[0] * c[2] - v1[1] * s[2]; b[1] = v1[1] * c[2] + v1[0] * s[2];
    b[2] = v1[2] * c[3] - v1[3] * s[3]; b[3] = v1[3] * c[3] + v1[2] * s[3];
    v0 = a; v1 = b;
}
__device__ __forceinline__ void store_t8(bf16_t* p, size_t stride, f32x4 v0, f32x4 v1) {
    const u32x4 w = pack8(v0, v1);
    p[0] = (bf16_t)(w.x & 0xffffu); p[stride] = (bf16_t)(w.x >> 16); p[2 * stride] = (bf16_t)(w.y & 0xffffu); p[3 * stride] = (bf16_t)(w.y >> 16);
    p[4 * stride] = (bf16_t)(w.z & 0xffffu); p[5 * stride] = (bf16_t)(w.z >> 16); p[6 * stride] = (bf16_t)(w.w & 0xffffu); p[7 * stride] = (bf16_t)(w.w >> 16);
}

struct EpiProj {
    static constexpr bool PERM = true, AFTER_DRAIN = false;
    const float* ssq; const float* ropeC; const float* ropeS;
    bf16_t *NQ, *KC, *VC, *KSL, *VSLT, *KWN, *VWNT, *SQ, *SK, *SVT, *GA, *GB; float* NG;
    __device__ __forceinline__ void operator()(const f32x4 (&acc)[2][2][4][2], const Unit& u, int wr, int wc, int fr, int fq) const {
        asm volatile("" : "+v"(fr), "+v"(fq));
        const int pn = u.pn;
        const int row0 = u.pm * BM + wr * 64 + fr;
        const int cw0 = wc * 32 + 8 * fq;
        float rsv[2][4]; wave_rstd8<false>(ssq, u.pm * BM + wr * 64, rsv);
        const bool need_rope = pn < 2 || (pn >= 3 && pn <= 6) || pn == 15;
        f32x4 ncs = {0.f, 0.f, 0.f, 0.f}, nsn = {0.f, 0.f, 0.f, 0.f};
        if (need_rope) { ncs = *(const f32x4*)(ropeC + (size_t)row0 * 32 + ((cw0 & 63) >> 1)); nsn = *(const f32x4*)(ropeS + (size_t)row0 * 32 + ((cw0 & 63) >> 1)); }
#pragma unroll
        for (int ai = 0; ai < 2; ++ai)
#pragma unroll
            for (int m = 0; m < 4; ++m) {
                const int row = row0 + ai * HALF + m * 16; const float rs = rsv[ai][m];
                const int b = row >> 13, s = row & 8191;
                const f32x4 cs = ncs, sn = nsn;
                if (need_rope && (ai * 4 + m) < 7) { const int rown = row0 + ((ai * 4 + m + 1) >> 2) * HALF + ((ai * 4 + m + 1) & 3) * 16;
                    ncs = *(const f32x4*)(ropeC + (size_t)rown * 32 + ((cw0 & 63) >> 1)); nsn = *(const f32x4*)(ropeS + (size_t)rown * 32 + ((cw0 & 63) >> 1)); }
#pragma unroll
                for (int bj = 0; bj < 2; ++bj) {
                    f32x4 v0 = acc[ai][bj][m][0] * rs, v1 = acc[ai][bj][m][1] * rs;
                    const int cw = bj * HALF + cw0;
                    if (pn < 2) { rope8(v0, v1, cs, sn); *(u32x4*)(NQ + (size_t)row * 512 + pn * 256 + cw) = pack8(v0, v1); }
                    else if (pn == 2) { bf16_t* dst = bj == 0 ? KC : VC; const int g = cw0 >> 6, d = cw0 & 63;
                        *(u32x4*)(dst + ((size_t)(b * 2 + g) * SEQ + s) * 64 + d) = pack8(v0, v1); }
                    else if (pn <= 4) { const int g = cw0 >> 6, d = cw0 & 63;
                        if (bj == 0) { rope8(v0, v1, cs, sn); bf16_t* dst = pn == 3 ? KSL : KWN; *(u32x4*)(dst + ((size_t)(b * 2 + g) * SEQ + s) * 64 + d) = pack8(v0, v1); }
                        else { bf16_t* dst = pn == 3 ? VSLT : VWNT; store_t8(dst + ((size_t)(b * 2 + g) * 64 + d) * SEQ + s, SEQ, v0, v1); } }
                    else if (pn <= 6) { rope8(v0, v1, cs, sn);
                        const u32x4 w = pack8(v0, v1); unsigned long long* qp = (unsigned long long*)(SQ + (size_t)row * 512 + (pn - 5) * 256 + cw);
                        __hip_atomic_store(qp, (unsigned long long)w.x | ((unsigned long long)w.y << 32), __ATOMIC_RELAXED, __HIP_MEMORY_SCOPE_AGENT);
                        __hip_atomic_store(qp + 1, (unsigned long long)w.z | ((unsigned long long)w.w << 32), __ATOMIC_RELAXED, __HIP_MEMORY_SCOPE_AGENT); }
                    else if (pn <= 14) { bf16_t* dst = pn <= 10 ? GA : GB; const int c = ((pn - 7) & 3) * 256 + cw;
#pragma unroll
                        for (int j = 0; j < 4; ++j) { v0[j] = sigmoidf_(v0[j]); v1[j] = sigmoidf_(v1[j]); }
                        *(u32x4*)(dst + (size_t)row * 1024 + c) = pack8(v0, v1); }
                    else {
                        if (bj == 0) {
                            if (cw0 < 64) { rope8(v0, v1, cs, sn); *(u32x4*)(SK + (size_t)row * 64 + cw0) = pack8(v0, v1); }
                            else store_t8(SVT + ((size_t)b * 64 + (cw0 - 64)) * SEQ + s, SEQ, v0, v1);
                        } else if (cw0 < 24) {
#pragma unroll
                            for (int j = 0; j < 4; ++j) { v0[j] = sigmoidf_(v0[j]); v1[j] = sigmoidf_(v1[j]); }
                            *(f32x4*)(NG + (size_t)row * 24 + cw0) = v0; *(f32x4*)(NG + (size_t)row * 24 + cw0 + 4) = v1;
                        }
                    }
                    asm volatile("" ::: "memory");
                }
            }
    }
};

struct EpiDry {
    static constexpr bool PERM = true, AFTER_DRAIN = false;
    float* sink; int flag;
    __device__ __forceinline__ void operator()(const f32x4 (&acc)[2][2][4][2], const Unit& u, int wr, int wc, int fr, int fq) const {
        if (flag) { f32x4 s = {0.f, 0.f, 0.f, 0.f};
#pragma unroll
            for (int ai = 0; ai < 2; ++ai)
#pragma unroll
                for (int bj = 0; bj < 2; ++bj)
#pragma unroll
                    for (int m = 0; m < 4; ++m) s += acc[ai][bj][m][0] + acc[ai][bj][m][1];
            *(f32x4*)(sink + (size_t)(u.pm * 4 + u.pn) * 4) = s; }
    }
};

struct EpiFinal {
    static constexpr bool PERM = true, AFTER_DRAIN = false;
    const float* base; float* out; float* ssq; const float* gain; unsigned* cnt; float scale;
    __device__ __forceinline__ void operator()(f32x4 (&acc)[2][2][4][2], const Unit& u, int wr, int wc, int fr, int fq) const {
        asm volatile("" : "+v"(fr), "+v"(fq));
        const int row0 = u.pm * BM + wr * 64 + fr, col0 = u.pn * BM + wc * 32 + 8 * fq;
        f32x4 nb[2][2];
#pragma unroll
        for (int bj = 0; bj < 2; ++bj) { const size_t off = (size_t)row0 * 1024 + col0 + bj * HALF; nb[bj][0] = *(const f32x4*)(base + off); nb[bj][1] = *(const f32x4*)(base + off + 4); }
#pragma unroll
        for (int it = 0; it < 8; ++it) {
            const int ai = it >> 2, m = it & 3;
            const int row = row0 + ai * HALF + m * 16; float s = 0.f;
            f32x4 cb[2][2];
#pragma unroll
            for (int bj = 0; bj < 2; ++bj) { cb[bj][0] = nb[bj][0]; cb[bj][1] = nb[bj][1]; }
            if (it < 7) { const int rown = row0 + ((it + 1) >> 2) * HALF + ((it + 1) & 3) * 16;
#pragma unroll
                for (int bj = 0; bj < 2; ++bj) { const size_t off = (size_t)rown * 1024 + col0 + bj * HALF; nb[bj][0] = *(const f32x4*)(base + off); nb[bj][1] = *(const f32x4*)(base + off + 4); } }
#pragma unroll
            for (int bj = 0; bj < 2; ++bj) {
                const f32x4 h0 = cb[bj][0] + acc[ai][bj][m][0] * scale, h1 = cb[bj][1] + acc[ai][bj][m][1] * scale;
                acc[ai][bj][m][0] = h0; acc[ai][bj][m][1] = h1;
                s += (h0[0] * h0[0] + h0[1] * h0[1]) + (h0[2] * h0[2] + h0[3] * h0[3]) + (h1[0] * h1[0] + h1[1] * h1[1]) + (h1[2] * h1[2] + h1[3] * h1[3]);
            }
            s += __shfl_xor(s, 16); s += __shfl_xor(s, 32);
            if (fq == 0) __hip_atomic_store(ssq + (size_t)row * 16 + u.pn * 4 + wc, s, __ATOMIC_RELAXED, __HIP_MEMORY_SCOPE_AGENT);
            asm volatile("" ::: "memory");
        }
        f32x4 gv[2][2];
#pragma unroll
        for (int bj = 0; bj < 2; ++bj) { gv[bj][0] = *(const f32x4*)(gain + col0 + bj * HALF); gv[bj][1] = *(const f32x4*)(gain + col0 + bj * HALF + 4); }
        asm volatile("s_waitcnt vmcnt(0)" ::: "memory");
        __syncthreads();
        if (threadIdx.x == 0) {
            __hip_atomic_fetch_add(cnt + u.pm, 1u, __ATOMIC_RELAXED, __HIP_MEMORY_SCOPE_AGENT);
            while (__hip_atomic_load(cnt + u.pm, __ATOMIC_RELAXED, __HIP_MEMORY_SCOPE_AGENT) < 4u) __builtin_amdgcn_s_sleep(1);
        }
        __syncthreads();
        float rsv[2][4]; wave_rstd8<true>(ssq, u.pm * BM + wr * 64, rsv);
#pragma unroll
        for (int ai = 0; ai < 2; ++ai)
#pragma unroll
            for (int m = 0; m < 4; ++m) {
                const int row = row0 + ai * HALF + m * 16; const float rs = rsv[ai][m];
#pragma unroll
                for (int bj = 0; bj < 2; ++bj) {
                    const size_t off = (size_t)row * 1024 + col0 + bj * HALF;
                    *(f32x4*)(out + off) = acc[ai][bj][m][0] * rs * gv[bj][0]; *(f32x4*)(out + off + 4) = acc[ai][bj][m][1] * rs * gv[bj][1];
                }
            }
    }
};
template <class Epi, class Sched, bool ALIGN_EPI = false, bool SP2 = false>
__device__ __forceinline__ void gemm_phase(PG8_LAS unsigned char* lds, const Gemm g, const Sched& S, const Epi& E) {
    const int tid = threadIdx.x, wid = __builtin_amdgcn_readfirstlane(tid >> 6), lane = tid & 63, wr = wid >> 2, wc = wid & 3, fr = lane & 15, fq = lane >> 4;
    const int K = g.K, nt = K / BK;
    unsigned voffA[2], voffB[2];
#pragma unroll
    for (int i = 0; i < 2; ++i) { int R, C; stage_rc(tid * 16 + i * 8192, R, C); const int Rb = Epi::PERM ? ((R & ~31) + perm32(R & 31)) : R;
        voffA[i] = (unsigned)(R * K + C) * 2u; voffB[i] = (unsigned)(Rb * K + C) * 2u; }
    const size_t kstep = (size_t)(BK * 2);
    const size_t hstep = (size_t)HALF * K * 2;
    const size_t tstep = 2 * hstep;
    const unsigned ldsw = (unsigned)wid * 1024u;
    const int aoff = lds_byte(wr * 64 + fr, fq * 8), boff = lds_byte(wc * 32 + fr, fq * 8);
#define PG8_SA(b, h) (((b) * 2 + (h)) * HTB)
#define PG8_SB(b, h) ((4 + (b) * 2 + (h)) * HTB)
#define PG8_STAGE(bufoff, gbase, voff) do { _Pragma("unroll") for (int _i = 0; _i < 2; ++_i) \
        __builtin_amdgcn_global_load_lds((const unsigned*)((const char*)(gbase) + (voff)[_i]), (PG8_LAS unsigned*)(lds + (bufoff) + ldsw + _i * 8192), 16, 0, 0); } while (0)
#define PG8_LDA(dst, b, h) do { _Pragma("unroll") for (int m = 0; m < 4; ++m) _Pragma("unroll") for (int k = 0; k < 2; ++k) dst[m][k] = *(const PG8_LAS bf16x8*)(lds + PG8_SA(b, h) + aoff + m * 2048 + k * 1024); } while (0)
#define PG8_LDB(dst, b, h) do { _Pragma("unroll") for (int n = 0; n < 2; ++n) _Pragma("unroll") for (int k = 0; k < 2; ++k) dst[n][k] = *(const PG8_LAS bf16x8*)(lds + PG8_SB(b, h) + boff + n * 2048 + k * 1024); } while (0)
#define PG8_MMA(ai, bj, At, Bt) do { __builtin_amdgcn_s_setprio(1); _Pragma("unroll") for (int m = 0; m < 4; ++m) _Pragma("unroll") for (int n = 0; n < 2; ++n) _Pragma("unroll") for (int k = 0; k < 2; ++k) \
        acc[ai][bj][m][n] = __builtin_amdgcn_mfma_f32_16x16x32_bf16(Bt[n][k], At[m][k], acc[ai][bj][m][n], 0, 0, 0); __builtin_amdgcn_s_setprio(0); } while (0)
#define PG8_WAIT_V(n) asm volatile("s_waitcnt vmcnt(" #n ")" ::: "memory")
#define PG8_WAIT_L(n) asm volatile("s_waitcnt lgkmcnt(" #n ")" ::: "memory")
#define PG8_BAR __builtin_amdgcn_s_barrier()
#define PG8_SCHED __builtin_amdgcn_sched_barrier(0)
    Unit cur, nxt; int ui = 0;
    if (!S.next(0, cur)) return;
    f32x4 acc[2][2][4][2];
#pragma unroll
    for (int a = 0; a < 2; ++a)
#pragma unroll
        for (int b = 0; b < 2; ++b)
#pragma unroll
            for (int m = 0; m < 4; ++m)
#pragma unroll
                for (int n = 0; n < 2; ++n) acc[a][b][m][n] = (f32x4){0.f, 0.f, 0.f, 0.f};
    bf16x8 At[4][2], B0[2][2], B1[2][2];
    const char* cA = (const char*)g.A + (size_t)cur.pm * tstep; const char* cB = (const char*)g.Bt + (size_t)cur.pn * tstep;
    S.a_ready(cur);
    if constexpr (SP2) {
        PG8_STAGE(PG8_SB(0, 0), cB, voffB); PG8_STAGE(PG8_SB(0, 1), cB + hstep, voffB); PG8_STAGE(PG8_SA(0, 0), cA, voffA); PG8_STAGE(PG8_SA(0, 1), cA + hstep, voffA);
        if (wr == 1) PG8_BAR;
        PG8_WAIT_V(2); PG8_BAR;
        PG8_STAGE(PG8_SB(1, 0), cB + kstep, voffB); PG8_STAGE(PG8_SA(1, 0), cA + kstep, voffA); PG8_STAGE(PG8_SB(1, 1), cB + hstep + kstep, voffB);
        PG8_WAIT_V(6); PG8_BAR;
    } else {
        PG8_STAGE(PG8_SB(0, 0), cB, voffB); PG8_STAGE(PG8_SA(0, 0), cA, voffA); PG8_STAGE(PG8_SB(0, 1), cB + hstep, voffB); PG8_STAGE(PG8_SA(0, 1), cA + hstep, voffA);
        if (wr == 1) PG8_BAR;
        PG8_WAIT_V(4); PG8_BAR;
        PG8_STAGE(PG8_SB(1, 0), cB + kstep, voffB); PG8_STAGE(PG8_SA(1, 0), cA + kstep, voffA); PG8_STAGE(PG8_SB(1, 1), cB + hstep + kstep, voffB);
        PG8_WAIT_V(6); PG8_BAR;
    }
    for (;;) {
        const bool has_next = S.next(ui + 1, nxt);
        const char* nA = has_next ? (const char*)g.A + (size_t)nxt.pm * tstep : cA; const char* nB = has_next ? (const char*)g.Bt + (size_t)nxt.pn * tstep : cB;
        for (int t = 0; t < nt; t += 2) {
            const bool last = (t == nt - 2);
            const char* a1 = cA + (size_t)(t + 1) * kstep;
            const char* a2 = last ? nA : cA + (size_t)(t + 2) * kstep; const char* b2 = last ? nB : cB + (size_t)(t + 2) * kstep;
            const char* a3 = a2 + kstep; const char* b3 = b2 + kstep;
            if (last && has_next) S.a_ready(nxt);
            if constexpr (SP2) {
            PG8_LDB(B0, 0, 0); PG8_LDB(B1, 0, 1); PG8_SCHED; PG8_LDA(At, 0, 0); PG8_STAGE(PG8_SA(1, 1), a1 + hstep, voffA);
            PG8_WAIT_V(8); PG8_WAIT_L(0); PG8_BAR; PG8_MMA(0, 0, At, B0); PG8_MMA(0, 1, At, B1); PG8_BAR; PG8_SCHED;
            PG8_LDA(At, 0, 1); PG8_STAGE(PG8_SB(0, 0), b2, voffB); PG8_STAGE(PG8_SB(0, 1), b2 + hstep, voffB); PG8_STAGE(PG8_SA(0, 0), a2, voffA);
            PG8_WAIT_V(8); PG8_WAIT_L(0); PG8_BAR; PG8_MMA(1, 0, At, B0); PG8_MMA(1, 1, At, B1); PG8_BAR; PG8_SCHED;
            PG8_LDB(B0, 1, 0); PG8_LDB(B1, 1, 1); PG8_SCHED; PG8_LDA(At, 1, 0); PG8_STAGE(PG8_SA(0, 1), a2 + hstep, voffA);
            PG8_WAIT_V(8); PG8_WAIT_L(0); PG8_BAR; PG8_MMA(0, 0, At, B0); PG8_MMA(0, 1, At, B1); PG8_BAR; PG8_SCHED;
            PG8_LDA(At, 1, 1); PG8_STAGE(PG8_SB(1, 0), b3, voffB); PG8_STAGE(PG8_SB(1, 1), b3 + hstep, voffB); PG8_STAGE(PG8_SA(1, 0), a3, voffA);
            PG8_WAIT_V(8); PG8_WAIT_L(0); PG8_BAR; PG8_MMA(1, 0, At, B0); PG8_MMA(1, 1, At, B1); PG8_BAR; PG8_SCHED;
            } else {
            PG8_LDB(B0, 0, 0); PG8_SCHED; PG8_LDA(At, 0, 0); PG8_STAGE(PG8_SA(1, 1), a1 + hstep, voffA);
            PG8_WAIT_L(8); PG8_BAR; PG8_WAIT_L(0); PG8_MMA(0, 0, At, B0); PG8_BAR; PG8_SCHED;
            PG8_LDB(B1, 0, 1); PG8_STAGE(PG8_SB(0, 0), b2, voffB);
            PG8_BAR; PG8_WAIT_L(0); PG8_MMA(0, 1, At, B1); PG8_BAR;
            PG8_LDA(At, 0, 1); PG8_STAGE(PG8_SA(0, 0), a2, voffA);
            PG8_BAR; PG8_WAIT_L(0); PG8_MMA(1, 0, At, B0); PG8_BAR; PG8_SCHED;
            PG8_STAGE(PG8_SB(0, 1), b2 + hstep, voffB);
            PG8_WAIT_V(6); PG8_BAR; PG8_MMA(1, 1, At, B1); PG8_BAR;
            PG8_LDB(B0, 1, 0); PG8_SCHED; PG8_LDA(At, 1, 0); PG8_STAGE(PG8_SA(0, 1), a2 + hstep, voffA);
            PG8_WAIT_L(8); PG8_BAR; PG8_WAIT_L(0); PG8_MMA(0, 0, At, B0); PG8_BAR; PG8_SCHED;
            PG8_LDB(B1, 1, 1); PG8_STAGE(PG8_SB(1, 0), b3, voffB);
            PG8_BAR; PG8_WAIT_L(0); PG8_MMA(0, 1, At, B1); PG8_BAR;
            PG8_LDA(At, 1, 1); PG8_STAGE(PG8_SA(1, 0), a3, voffA);
            PG8_BAR; PG8_WAIT_L(0); PG8_MMA(1, 0, At, B0); PG8_BAR; PG8_SCHED;
            PG8_STAGE(PG8_SB(1, 1), b3 + hstep, voffB);
            PG8_WAIT_V(6); PG8_BAR; PG8_MMA(1, 1, At, B1); PG8_BAR;
            }
        }
        if constexpr (ALIGN_EPI) { if (wr == 0) PG8_BAR; }
        if constexpr (!Epi::AFTER_DRAIN) { E(acc, cur, wr, wc, fr, fq); S.done(cur); }
        if (!has_next) break;
#pragma unroll
        for (int a = 0; a < 2; ++a)
#pragma unroll
            for (int b = 0; b < 2; ++b)
#pragma unroll
                for (int m = 0; m < 4; ++m)
#pragma unroll
                    for (int n = 0; n < 2; ++n) acc[a][b][m][n] = (f32x4){0.f, 0.f, 0.f, 0.f};
        cur = nxt; cA = nA; cB = nB; ++ui;
        if constexpr (ALIGN_EPI) { if (wr == 1) PG8_BAR; }
    }
    PG8_WAIT_V(0);
    if constexpr (!ALIGN_EPI) { if (wr == 0) PG8_BAR; }
    PG8_BAR;
    if constexpr (Epi::AFTER_DRAIN) { E.fused(acc, cur, wr, wc, fr, fq, lds, wid, lane); S.done(cur); }
#undef PG8_SA
#undef PG8_SB
#undef PG8_STAGE
#undef PG8_LDA
#undef PG8_LDB
#undef PG8_MMA
#undef PG8_WAIT_V
#undef PG8_WAIT_L
#undef PG8_BAR
#undef PG8_SCHED
}
}

using pg8::bf16_t; using pg8::bf16x8; using pg8::f32x4; using pg8::u32x4; using pg8::cvt_pk_bf16; using pg8::fast_exp2; using pg8::fast_rcp; using pg8::bf2f;
#define LAS __attribute__((address_space(3)))
constexpr int NWAVES = 8;
constexpr int LDS_BYTES = 131072 + 4096 + 1024;
constexpr size_t MiB = 1u << 20;
constexpr size_t WS_SEL = 0, WS_KCMP = 512 * 1024, WS_VCMPT = 768 * 1024;
constexpr size_t WS_W1GU = 1 * MiB, WS_W1D = 12 * MiB, WS_WIN = 18 * MiB, WS_CW1K = 26 * MiB, WS_CW1V = 27 * MiB, WS_CW2K = 28 * MiB, WS_CW2V = 28 * MiB + 65536;
constexpr size_t WS_WA = 29 * MiB, WS_WB = 30 * MiB, WS_WOUT = 31 * MiB, WS_W2GU = 33 * MiB, WS_W2D = 44 * MiB, WS_PEB = 49 * MiB + 512 * 1024;
constexpr size_t WS_BAR = 49 * MiB + 576 * 1024, BAR_BYTES = 16384;
constexpr size_t WS_ROPEC = 50 * MiB, WS_ROPES = 52 * MiB;
constexpr size_t WS_XB = 54 * MiB;
constexpr size_t WS_ACT = 86 * MiB;
constexpr size_t WS_GA = 86 * MiB, WS_GB = 118 * MiB;
constexpr size_t WS_SQ = 174 * MiB, WS_OCMP = 190 * MiB, WS_KC = 206 * MiB, WS_VC = 210 * MiB, WS_KSL = 214 * MiB, WS_VSLT = 218 * MiB, WS_KWN = 222 * MiB, WS_VWNT = 226 * MiB;
constexpr size_t WS_SK = 230 * MiB, WS_SVT = 232 * MiB;
constexpr size_t WS_SSQ0 = 234 * MiB, WS_SSQ1 = 235 * MiB, WS_SSQ2 = 236 * MiB, WS_SSQ3 = 237 * MiB;
constexpr size_t WS_NQ = 238 * MiB, WS_NG = 254 * MiB, WS_END = 255 * MiB + 512 * 1024;

__device__ const float INV_FREQ[32] = {1.f, 0.749894202f, 0.562341332f, 0.421696514f, 0.316227764f, 0.237137377f, 0.177827939f, 0.133352146f, 0.100000001f, 0.0749894232f, 0.0562341325f, 0.0421696492f, 0.0316227749f, 0.0237137377f, 0.0177827943f, 0.013335214f, 0.00999999978f, 0.00749894232f, 0.00562341325f, 0.00421696482f, 0.00316227763f, 0.00237137382f, 0.00177827943f, 0.00133352145f, 0.00100000005f, 0.000749894185f, 0.000562341302f, 0.000421696517f, 0.000316227757f, 0.00023713737f, 0.00017782794f, 0.00013335215f};

struct Args { const float* in[23]; float* out; unsigned char* ws; int rep[4]; };

#define LDS_WAIT() asm volatile("s_waitcnt lgkmcnt(0)" ::: "memory")
#define MFMA16(a, b, c) __builtin_amdgcn_mfma_f32_16x16x32_bf16(a, b, c, 0, 0, 0)

__device__ __forceinline__ float wave_sum(float v) {
#pragma unroll
    for (int o = 1; o < 64; o <<= 1) v += __shfl_xor(v, o);
    return v;
}
__device__ __forceinline__ unsigned f2bf(float f) { unsigned u = __builtin_bit_cast(unsigned, f); return (u + 0x7fffu + ((u >> 16) & 1u)) >> 16; }
__device__ __forceinline__ unsigned pk2(float lo, float hi) { return f2bf(lo) | (f2bf(hi) << 16); }

__device__ __forceinline__ int il_pos(int d) { return d < 32 ? 2 * d : 2 * (d - 32) + 1; }
__device__ __forceinline__ int win_dest(int c) {
    if (c < 512) return (c & ~63) + il_pos(c & 63);
    if (c < 768) return c;
    if (c < 896) return (c & ~63) + il_pos(c & 63);
    if (c < 1024) return c;
    if (c < 1152) return (c & ~63) + il_pos(c & 63);
    if (c < 1280) return c;
    if (c < 1304) return 3968 + (c - 1280);
    if (c < 1816) { const int q = c - 1304; return 1280 + (q & ~63) + il_pos(q & 63); }
    if (c < 1880) return 3840 + il_pos(c - 1816);
    if (c < 1944) return 3904 + (c - 1880);
    if (c < 2968) return 1792 + (c - 1944);
    return 2816 + (c - 2968);
}
__device__ __forceinline__ int dest_row(int mode, int row_off, int n) {
    if (mode == 0) return row_off + n;
    if (mode == 1) return (n >> 7) * 256 + (n & 127) + row_off;
    if (mode == 2) return win_dest(n);
    return il_pos(n);
}
__device__ __forceinline__ void transpose_item(const float* __restrict__ W, int K, int N, bf16_t* WT, int mode, int row_off, const float* __restrict__ gain, LAS float* scr, int item, int lane) {
    const int nblk = (N + 31) / 32, kb = item / nblk, nb = item % nblk, k0 = 64 * kb, n0 = 32 * nb;
    const int c4 = (lane & 7) * 4, nn = n0 + c4;
#pragma unroll
    for (int i = 0; i < 8; ++i) { const int kk = 8 * i + (lane >> 3);
        f32x4 v = nn < N ? *(const f32x4*)(W + (size_t)(k0 + kk) * N + nn) : (f32x4){0.f, 0.f, 0.f, 0.f};
        if (gain) v = v * gain[k0 + kk];
        scr[kk * 33 + c4] = v[0]; scr[kk * 33 + c4 + 1] = v[1]; scr[kk * 33 + c4 + 2] = v[2]; scr[kk * 33 + c4 + 3] = v[3]; }
    LDS_WAIT();
    const int c = lane & 7;
#pragma unroll
    for (int j = 0; j < 4; ++j) { const int nl = (lane >> 3) + 8 * j; const int n = n0 + nl;
        if (n < N) { const LAS float* s = scr + (8 * c) * 33 + nl;
            u32x4 o; o.x = pk2(s[0 * 33], s[1 * 33]); o.y = pk2(s[2 * 33], s[3 * 33]); o.z = pk2(s[4 * 33], s[5 * 33]); o.w = pk2(s[6 * 33], s[7 * 33]);
            *(u32x4*)(WT + (size_t)dest_row(mode, row_off, n) * K + k0 + 8 * c) = o; } }
    LDS_WAIT();
}

__device__ __forceinline__ void qk_pair(const bf16_t* __restrict__ K, int kbase, int lane, const bf16x8 (&qf)[2], f32x4& sA, f32x4& sB) {
    const int i = lane & 15, fq = lane >> 4;
    const bf16_t* pa = K + (size_t)(kbase + 8 * (i >> 2) + (i & 3)) * 64 + 8 * fq;
    const bf16x8 a0 = *(const bf16x8*)pa, a1 = *(const bf16x8*)(pa + 32), b0 = *(const bf16x8*)(pa + 256), b1 = *(const bf16x8*)(pa + 288);
    const f32x4 z = {0.f, 0.f, 0.f, 0.f};
    sA = MFMA16(a0, qf[0], z); sA = MFMA16(a1, qf[1], sA);
    sB = MFMA16(b0, qf[0], z); sB = MFMA16(b1, qf[1], sB);
}
__device__ __forceinline__ void pv_pair(const bf16_t* __restrict__ VT, int ldv, int kbase, int lane, bf16x8 pf, f32x4 (&o)[4]) {
    const int i = lane & 15, fq = lane >> 4;
#pragma unroll
    for (int nt = 0; nt < 4; ++nt) { const bf16x8 a = *(const bf16x8*)(VT + (size_t)(16 * nt + i) * ldv + kbase + 8 * fq); o[nt] = MFMA16(a, pf, o[nt]); }
}
__device__ __forceinline__ float rowmax4(float v) {
    const unsigned u = __float_as_uint(v); const auto r = __builtin_amdgcn_permlane16_swap(u, u, false, false);
    const float a = fmaxf(__uint_as_float(r[0]), __uint_as_float(r[1]));
    const unsigned ua = __float_as_uint(a); const auto r2 = __builtin_amdgcn_permlane32_swap(ua, ua, false, false);
    return fmaxf(__uint_as_float(r2[0]), __uint_as_float(r2[1])); }
__device__ __forceinline__ float rowsum4(float v) {
    const unsigned u = __float_as_uint(v); const auto r = __builtin_amdgcn_permlane16_swap(u, u, false, false);
    const float a = __uint_as_float(r[0]) + __uint_as_float(r[1]);
    const unsigned ua = __float_as_uint(a); const auto r2 = __builtin_amdgcn_permlane32_swap(ua, ua, false, false);
    return __uint_as_float(r2[0]) + __uint_as_float(r2[1]); }
constexpr float NEGBIG = -1e30f;
#define SCORES8(sA, sB, key0, lo, hi, s, v) \
    float s[8]; bool v[8]; \
    _Pragma("unroll") for (int e = 0; e < 8; ++e) { const int key_ = (key0) + e; v[e] = (key_ >= (lo)) && (key_ <= (hi)); const float x_ = (e < 4 ? sA[e & 3] : sB[e & 3]) * C2; s[e] = v[e] ? x_ : NEGBIG; }

__device__ __forceinline__ bf16x8 soft_step(f32x4 sA, f32x4 sB, int key0, int lo, int hi, float& m, float& l, f32x4 (&o)[4]) {
    SCORES8(sA, sB, key0, lo, hi, s, v)
    float mx = fmaxf(fmaxf(fmaxf(s[0], s[1]), fmaxf(s[2], s[3])), fmaxf(fmaxf(s[4], s[5]), fmaxf(s[6], s[7])));
    mx = rowmax4(mx);
    const float mn = fmaxf(m, mx), alpha = fast_exp2(m - mn);
    float p[8], sum = 0.f;
#pragma unroll
    for (int e = 0; e < 8; ++e) { p[e] = v[e] ? fast_exp2(s[e] - mn) : 0.f; sum += p[e]; }
    sum = rowsum4(sum);
    l = l * alpha + sum; m = mn;
#pragma unroll
    for (int nt = 0; nt < 4; ++nt) o[nt] = o[nt] * alpha;
    u32x4 w; w.x = cvt_pk_bf16(p[0], p[1]); w.y = cvt_pk_bf16(p[2], p[3]); w.z = cvt_pk_bf16(p[4], p[5]); w.w = cvt_pk_bf16(p[6], p[7]);
    return __builtin_bit_cast(bf16x8, w);
}

#define RLX_AGENT __ATOMIC_RELAXED, __HIP_MEMORY_SCOPE_AGENT
#define XB_TMO      128
#define XB_XCNT(j)  (256  + 64 * (j))
#define XB_XSUB(j)  (1280 + 64 * (j))
#define XB_XGEN(j)  (2304 + 64 * (j))
#define XB_TOP      3328
#define XB_TOPGEN   3392
#define XCD_BAR_WORDS 3456
#define XB_SPIN_CAP (1u << 18)

__device__ __forceinline__ unsigned xb_ld(unsigned* p)              { return __hip_atomic_load(p, __ATOMIC_RELAXED, __HIP_MEMORY_SCOPE_AGENT); }
__device__ __forceinline__ unsigned xb_add(unsigned* p, unsigned v) { return __hip_atomic_fetch_add(p, v, __ATOMIC_RELAXED, __HIP_MEMORY_SCOPE_AGENT); }
__device__ __forceinline__ unsigned xb_xcc_id() { return (unsigned)__builtin_amdgcn_s_getreg((3 << 11) | 20) & 0xFu; }
#define XB_SPIN(cond, bar) do { unsigned _sp = 0; while (cond) { __builtin_amdgcn_s_sleep(1); \
    if ((++_sp & 255u) == 0u) { if (xb_ld(&(bar)[XB_TMO])) break; if (_sp > XB_SPIN_CAP) { atomicAdd(&(bar)[XB_TMO], 1u); break; } } } } while (0)

struct XcdBarrier {
    unsigned* bar; unsigned x;
    volatile LAS unsigned* st;
};

__device__ __forceinline__ XcdBarrier xcd_barrier_post(unsigned* bar, volatile LAS unsigned* st) {
    XcdBarrier b; b.bar = bar; b.x = xb_xcc_id(); b.st = st;
    if (threadIdx.x == 0) (void)xb_add(&bar[XB_XCNT(b.x)], 1u);
    return b;
}
__device__ __forceinline__ void xcd_barrier_complete(unsigned* bar, unsigned x, unsigned& nloc, unsigned& nx) {
    const unsigned G = gridDim.x * gridDim.y * gridDim.z;
    unsigned sum, cnt, mine, sp = 0u;
    for (;;) {
        sum = 0u; cnt = 0u; mine = 0u;
#pragma unroll
        for (unsigned j = 0; j < 16; ++j) { const unsigned c = xb_ld(&bar[XB_XCNT(j)]); sum += c; cnt += (c > 0u) ? 1u : 0u; mine = (j == x) ? c : mine; }
        if (sum == G) break;
        __builtin_amdgcn_s_sleep(1);
        if ((++sp & 255u) == 0u) { if (xb_ld(&bar[XB_TMO])) break; if (sp > XB_SPIN_CAP) { atomicAdd(&bar[XB_TMO], 1u); break; } }
    }
    nloc = mine > 0u ? mine : 1u; nx = cnt > 0u ? cnt : 1u;
}

__device__ __forceinline__ void xcd_barrier(const XcdBarrier& b) {
    asm volatile("s_waitcnt vmcnt(0)" ::: "memory");
    __syncthreads();
    if (threadIdx.x == 0) {
        unsigned* bar = b.bar;
        __builtin_amdgcn_s_waitcnt(0);
        unsigned nloc = b.st[0], nx = b.st[1];
        if (nloc == 0u) { xcd_barrier_complete(bar, b.x, nloc, nx); b.st[0] = nloc; b.st[1] = nx; }
        const unsigned old = xb_add(&bar[XB_XSUB(b.x)], 1u);
        const unsigned gen = old / nloc;
        if (old + 1u == (gen + 1u) * nloc) {
            __builtin_amdgcn_fence(__ATOMIC_RELEASE, "agent");
            asm volatile("s_waitcnt vmcnt(0)" ::: "memory");
            const unsigned og = xb_add(&bar[XB_TOP], 1u);
            const unsigned tg = og / nx;
            if (og + 1u == (tg + 1u) * nx) xb_add(&bar[XB_TOPGEN], 1u);
            else XB_SPIN(xb_ld(&bar[XB_TOPGEN]) == tg, bar);
            __builtin_amdgcn_fence(__ATOMIC_ACQUIRE, "agent");
            xb_add(&bar[XB_XGEN(b.x)], 1u);
            asm volatile("s_waitcnt vmcnt(0)" ::: "memory");
        } else {
            XB_SPIN(xb_ld(&bar[XB_XGEN(b.x)]) == gen, bar);
            __builtin_amdgcn_fence(__ATOMIC_ACQUIRE, "agent");
            asm volatile("s_waitcnt vmcnt(0)" ::: "memory");
        }
    }
    __syncthreads();
}

struct Frag { bf16x8 k0, k1, k2, k3, v0, v1, v2, v3; };
template <bool WITH_V> __device__ __forceinline__ void load_frag(Frag& f, const bf16_t* __restrict__ K, const bf16_t* __restrict__ VT, int ldv, int kbase, int lane) {
    const int i = lane & 15, fq = lane >> 4;
    const bf16_t* pa = K + (size_t)(kbase + 8 * (i >> 2) + (i & 3)) * 64 + 8 * fq;
    f.k0 = *(const bf16x8*)pa; f.k1 = *(const bf16x8*)(pa + 32); f.k2 = *(const bf16x8*)(pa + 256); f.k3 = *(const bf16x8*)(pa + 288);
    if (WITH_V) { const bf16_t* pv = VT + (size_t)i * ldv + kbase + 8 * fq;
        f.v0 = *(const bf16x8*)pv; f.v1 = *(const bf16x8*)(pv + (size_t)16 * ldv); f.v2 = *(const bf16x8*)(pv + (size_t)32 * ldv); f.v3 = *(const bf16x8*)(pv + (size_t)48 * ldv); }
}
__device__ __forceinline__ void qk_frag(const Frag& f, const bf16x8 (&qf)[2], f32x4& sA, f32x4& sB) {
    const f32x4 z = {0.f, 0.f, 0.f, 0.f};
    sA = MFMA16(f.k0, qf[0], z); sA = MFMA16(f.k1, qf[1], sA);
    sB = MFMA16(f.k2, qf[0], z); sB = MFMA16(f.k3, qf[1], sB);
}
__device__ __forceinline__ void pv_frag(const Frag& f, bf16x8 pf, f32x4 (&o)[4]) {
    o[0] = MFMA16(f.v0, pf, o[0]); o[1] = MFMA16(f.v1, pf, o[1]); o[2] = MFMA16(f.v2, pf, o[2]); o[3] = MFMA16(f.v3, pf, o[3]);
}
__device__ __forceinline__ void glds16(const void* g, unsigned lds_base) {
    unsigned sv; asm volatile("s_mov_b32 %0, m0\n\ts_mov_b32 m0, %2\n\ts_nop 0\n\tglobal_load_lds_dwordx4 %1, off\n\ts_mov_b32 m0, %0" : "=&s"(sv) : "v"(g), "s"(lds_base) : "memory"); }
__device__ __forceinline__ void glds16s(const void* sbase, unsigned voff, unsigned lds_base) {
    unsigned sv; asm volatile("s_mov_b32 %0, m0\n\ts_mov_b32 m0, %3\n\ts_nop 0\n\tglobal_load_lds_dwordx4 %1, %2\n\ts_mov_b32 m0, %0" : "=&s"(sv) : "v"(voff), "s"(sbase), "s"(lds_base) : "memory"); }
#define RFL(x) __builtin_amdgcn_readfirstlane(x)
template <bool MASK> __device__ __forceinline__ void soft_step64(const f32x4 (&sc)[4], int key0, int lo, int hi, float rowbias, float& m, float& l, f32x4 (&o)[4], bf16x8& pf0, bf16x8& pf1) {
    float s[16];
#pragma unroll
    for (int e = 0; e < 16; ++e) { const float x = __builtin_fmaf(sc[e >> 2][e & 3], C2, rowbias);
        if (MASK) { const int key_ = key0 + 32 * (e >> 3) + (e & 7); s[e] = (key_ >= lo && key_ <= hi) ? x : NEGBIG; } else s[e] = x; }
    float mx = fmaxf(fmaxf(fmaxf(fmaxf(s[0], s[1]), fmaxf(s[2], s[3])), fmaxf(fmaxf(s[4], s[5]), fmaxf(s[6], s[7]))), fmaxf(fmaxf(fmaxf(s[8], s[9]), fmaxf(s[10], s[11])), fmaxf(fmaxf(s[12], s[13]), fmaxf(s[14], s[15]))));
    mx = rowmax4(mx);
    const float mn = fmaxf(m, mx), alpha = fast_exp2(m - mn);
    float p[16], sum = 0.f;
#pragma unroll
    for (int e = 0; e < 16; ++e) { p[e] = fast_exp2(s[e] - mn); sum += p[e]; }
    sum = rowsum4(sum);
    l = l * alpha + sum; m = mn;
#pragma unroll
    for (int nt = 0; nt < 4; ++nt) o[nt] = o[nt] * alpha;
    u32x4 w0, w1;
    w0.x = cvt_pk_bf16(p[0], p[1]); w0.y = cvt_pk_bf16(p[2], p[3]); w0.z = cvt_pk_bf16(p[4], p[5]); w0.w = cvt_pk_bf16(p[6], p[7]);
    w1.x = cvt_pk_bf16(p[8], p[9]); w1.y = cvt_pk_bf16(p[10], p[11]); w1.z = cvt_pk_bf16(p[12], p[13]); w1.w = cvt_pk_bf16(p[14], p[15]);
    pf0 = __builtin_bit_cast(bf16x8, w0); pf1 = __builtin_bit_cast(bf16x8, w1);
}


__global__ void __launch_bounds__(NWAVES * 64, 2) nsa_fwd(Args args) {
    extern __shared__ __attribute__((aligned(16))) unsigned char lds[];
    cg::grid_group grid = cg::this_grid();
    const int tid = threadIdx.x, lane = tid & 63, wave = __builtin_amdgcn_readfirstlane(tid >> 6);
    const int G = gridDim.x, gw = blockIdx.x * NWAVES + wave, NGW = G * NWAVES;
    unsigned char* ws = args.ws;
    LAS unsigned char* ldsl = (LAS unsigned char*)lds;

    const float* x = args.in[0]; const int* positions = (const int*)args.in[1];
    float* H = args.out;
    float* SSQ0 = (float*)(ws + WS_SSQ0); float* SSQ1 = (float*)(ws + WS_SSQ1); float* SSQ2 = (float*)(ws + WS_SSQ2); float* SSQ3 = (float*)(ws + WS_SSQ3);
    float* PEB = (float*)(ws + WS_PEB);
    bf16_t* W1GU = (bf16_t*)(ws + WS_W1GU); bf16_t* W1D = (bf16_t*)(ws + WS_W1D); bf16_t* WIN = (bf16_t*)(ws + WS_WIN);
    bf16_t* CW1K = (bf16_t*)(ws + WS_CW1K); bf16_t* CW1V = (bf16_t*)(ws + WS_CW1V); bf16_t* CW2K = (bf16_t*)(ws + WS_CW2K); bf16_t* CW2V = (bf16_t*)(ws + WS_CW2V);
    bf16_t* WA = (bf16_t*)(ws + WS_WA); bf16_t* WB = (bf16_t*)(ws + WS_WB); bf16_t* WOUT = (bf16_t*)(ws + WS_WOUT); bf16_t* W2GU = (bf16_t*)(ws + WS_W2GU); bf16_t* W2D = (bf16_t*)(ws + WS_W2D);
    float* ROPEC = (float*)(ws + WS_ROPEC); float* ROPES = (float*)(ws + WS_ROPES);
    bf16_t* XB = (bf16_t*)(ws + WS_XB); bf16_t* ACT = (bf16_t*)(ws + WS_ACT);
    bf16_t* GA = (bf16_t*)(ws + WS_GA); bf16_t* GB = (bf16_t*)(ws + WS_GB); bf16_t* NQ = (bf16_t*)(ws + WS_NQ);
    bf16_t* KCMP = (bf16_t*)(ws + WS_KCMP); bf16_t* VCMPT = (bf16_t*)(ws + WS_VCMPT); unsigned* SEL = (unsigned*)(ws + WS_SEL); float* NG = (float*)(ws + WS_NG);
    bf16_t* SQ = (bf16_t*)(ws + WS_SQ); bf16_t* OCMP = (bf16_t*)(ws + WS_OCMP); bf16_t* KC = (bf16_t*)(ws + WS_KC); bf16_t* VC = (bf16_t*)(ws + WS_VC);
    bf16_t* KSL = (bf16_t*)(ws + WS_KSL); bf16_t* VSLT = (bf16_t*)(ws + WS_VSLT); bf16_t* KWN = (bf16_t*)(ws + WS_KWN); bf16_t* VWNT = (bf16_t*)(ws + WS_VWNT);
    bf16_t* SK = (bf16_t*)(ws + WS_SK); bf16_t* SVT = (bf16_t*)(ws + WS_SVT);
#if defined(DBG_NOFFN1)
    bf16_t* OB = (bf16_t*)(ws + 150 * MiB);
#else
    bf16_t* OB = SQ;
#endif

    const int fr = lane & 15, fq = lane >> 4;
#define GRID_SYNC_CG() do { asm volatile("s_waitcnt vmcnt(0) lgkmcnt(0)" ::: "memory"); __syncthreads(); grid.sync(); \
        __builtin_amdgcn_fence(__ATOMIC_ACQUIRE, "agent"); asm volatile("s_waitcnt vmcnt(0)" ::: "memory"); __syncthreads(); } while (0)
#define GRID_SYNC() xcd_barrier(xbar)
    volatile LAS unsigned* MISC = (volatile LAS unsigned*)(ldsl + LDS_BYTES - 1024);
    if (tid < 16) MISC[tid] = 0u;
    __syncthreads();
    XcdBarrier xbar = xcd_barrier_post((unsigned*)(ws + WS_BAR), MISC + 8);

#ifndef DBG_STOP
#define DBG_STOP 0
#endif
#define DUMP_LOOP(expr) do { for (size_t i_ = (size_t)blockIdx.x * 512 + tid; i_ < (size_t)TOK * DM; i_ += (size_t)G * 512) { args.out[i_] = (expr); } return; } while (0)
    {
        LAS float* scr = (LAS float*)(ldsl + wave * 16384);
        constexpr int I_GU = 16 * 88, I_D = 44 * 32, I_IN = 16 * 125, I_C1 = 32 * 8, I_C2 = 4 * 2, I_AB = 8 * 32, I_O = 16 * 32;
        constexpr int NITEMS = 6 * I_GU + I_IN + 2 * I_C1 + 2 * I_C2 + 2 * I_AB + I_O;
        static_assert(I_GU == I_D, "items");
        for (int it = gw; it < 2 * I_GU + I_IN; it += NGW) {
            int r = it;
            if (r < I_GU) { transpose_item(args.in[3], 1024, 2816, W1GU, 1, 0, args.in[2], scr, r, lane); continue; } r -= I_GU;
            if (r < I_GU) { transpose_item(args.in[4], 1024, 2816, W1GU, 1, 128, args.in[2], scr, r, lane); continue; } r -= I_GU;
            transpose_item(args.in[7], 1024, 3992, WIN, 2, 0, args.in[6], scr, r, lane);
        }
        for (int mrow = gw; mrow < TOK; mrow += 2 * NGW) {
            const int mrow2 = mrow + NGW;
            const bool two = mrow2 < TOK;
            const f32x4* xr = (const f32x4*)(x + (size_t)mrow * DM) + lane; const f32x4* xr2 = (const f32x4*)(x + (size_t)(two ? mrow2 : mrow) * DM) + lane;
            f32x4 v[4], w[4];
#pragma unroll
            for (int j = 0; j < 4; ++j) { v[j] = xr[64 * j]; w[j] = xr2[64 * j]; }
            unsigned long long* o8 = (unsigned long long*)(XB + (size_t)mrow * DM) + lane; unsigned long long* p8 = (unsigned long long*)(XB + (size_t)mrow2 * DM) + lane;
            float s = 0.f, s2 = 0.f;
#pragma unroll
            for (int j = 0; j < 4; ++j) { s += (v[j][0] * v[j][0] + v[j][1] * v[j][1]) + (v[j][2] * v[j][2] + v[j][3] * v[j][3]);
                s2 += (w[j][0] * w[j][0] + w[j][1] * w[j][1]) + (w[j][2] * w[j][2] + w[j][3] * w[j][3]);
                o8[64 * j] = (unsigned long long)pk2(v[j][0], v[j][1]) | ((unsigned long long)pk2(v[j][2], v[j][3]) << 32);
                if (two) p8[64 * j] = (unsigned long long)pk2(w[j][0], w[j][1]) | ((unsigned long long)pk2(w[j][2], w[j][3]) << 32); }
            s = wave_sum(s); s2 = wave_sum(s2);
            if (lane < 16) { SSQ0[(size_t)mrow * 16 + lane] = lane == 0 ? s : 0.f; if (two) SSQ0[(size_t)mrow2 * 16 + lane] = lane == 0 ? s2 : 0.f; }
        }
        for (int idx = blockIdx.x * (NWAVES * 64) + tid; idx < TOK * 32; idx += G * NWAVES * 64) {
            const int trow = idx >> 5, i = idx & 31;
            const float ang = (float)positions[trow] * INV_FREQ[i];
            const double rev = (double)ang * 0.15915494309189535; const float frac = (float)(rev - __builtin_rint(rev));
            ROPEC[idx] = __builtin_amdgcn_cosf(frac); ROPES[idx] = __builtin_amdgcn_sinf(frac);
        }
        for (int o = gw; o < 2048; o += NGW) {
            const int part = o >> 9, oo = o & 511, z = oo >> 8, j = oo & 255; const float* pe = args.in[z ? 11 : 8]; const float* w1 = args.in[z ? 12 : 9];
            float s = 0.f;
#pragma unroll
            for (int i = 0; i < 8; ++i) { const int kk = 512 * part + 64 * i + lane; s += pe[kk] * w1[(size_t)kk * 256 + j]; }
            s = wave_sum(s);
            if (lane == 0) PEB[part * 512 + oo] = s;
        }
    }
    if (args.rep[3] == 77) GRID_SYNC_CG();
    GRID_SYNC();

#if !defined(DBG_NOFFN1)
    { pg8::Gemm g{XB, W1GU, TOK, 2 * DFF, DM}; pg8::StaticOrder S; S.init(TOK, 2 * DFF, G, (int)blockIdx.x);
      pg8::EpiSwiglu E{ACT, SSQ0};
      pg8::gemm_phase<pg8::EpiSwiglu, pg8::StaticOrder, true, true>(ldsl, g, S, E); }
    {
        constexpr int I_GU = 16 * 88, I_D = 44 * 32, I_C1 = 32 * 8, I_C2 = 4 * 2, I_AB = 8 * 32, I_O = 16 * 32;
        constexpr int NLATE = 2 * I_GU + 2 * I_D + 2 * I_C1 + 2 * I_C2 + 2 * I_AB + I_O, NUNITS = (TOK / 256) * (2 * DFF / 256);
        const int rem = NUNITS % G, first = rem ? rem : 0, np = rem ? G - rem : G;
        if ((int)blockIdx.x >= first) {
            LAS float* scr = (LAS float*)(ldsl + wave * 16384);
            for (int it = ((int)blockIdx.x - first) * NWAVES + wave; it < NLATE; it += np * NWAVES) {
                int r = it;
                if (r < I_D) { transpose_item(args.in[5], 2816, 1024, W1D, 0, 0, nullptr, scr, r, lane); continue; } r -= I_D;
                if (r < I_GU) { transpose_item(args.in[19], 1024, 2816, W2GU, 1, 0, args.in[18], scr, r, lane); continue; } r -= I_GU;
                if (r < I_GU) { transpose_item(args.in[20], 1024, 2816, W2GU, 1, 128, args.in[18], scr, r, lane); continue; } r -= I_GU;
                if (r < I_D) { transpose_item(args.in[21], 2816, 1024, W2D, 0, 0, nullptr, scr, r, lane); continue; } r -= I_D;
                if (r < I_C1) { transpose_item(args.in[9], 2048, 256, CW1K, 0, 0, nullptr, scr, r, lane); continue; } r -= I_C1;
                if (r < I_C1) { transpose_item(args.in[12], 2048, 256, CW1V, 0, 0, nullptr, scr, r, lane); continue; } r -= I_C1;
                if (r < I_C2) { transpose_item(args.in[10], 256, 64, CW2K, 3, 0, nullptr, scr, r, lane); continue; } r -= I_C2;
                if (r < I_C2) { transpose_item(args.in[13], 256, 64, CW2V, 0, 0, nullptr, scr, r, lane); continue; } r -= I_C2;
                if (r < I_AB) { transpose_item(args.in[15], 512, 1024, WA, 0, 0, nullptr, scr, r, lane); continue; } r -= I_AB;
                if (r < I_AB) { transpose_item(args.in[16], 512, 1024, WB, 0, 0, nullptr, scr, r, lane); continue; } r -= I_AB;
                transpose_item(args.in[17], 1024, 1024, WOUT, 0, 0, nullptr, scr, r, lane);
            }
        }
    }
    GRID_SYNC();
    if (DBG_STOP == 12) DUMP_LOOP(bf2f(ACT[i_]) + bf2f(ACT[i_ + 16777216]) + (i_ < 12582912 ? bf2f(ACT[i_ + 33554432]) : 0.f));
    if (args.rep[3] == 1) { pg8::Gemm g{XB, W1GU, TOK, 2 * DFF, DM}; pg8::StaticOrder S; S.init(TOK, 2 * DFF, G, (int)blockIdx.x); pg8::EpiDry E{PEB, args.rep[0] - 1};
      pg8::gemm_phase<pg8::EpiDry, pg8::StaticOrder, true, true>(ldsl, g, S, E); GRID_SYNC(); }
    if (args.rep[3] == 2) { pg8::Gemm g{ACT, W1D, TOK, DM, DFF}; pg8::StaticOrder S; S.init(TOK, DM, G, (int)blockIdx.x); pg8::EpiDry E{PEB, args.rep[0] - 1};
      pg8::gemm_phase<pg8::EpiDry, pg8::StaticOrder, true, true>(ldsl, g, S, E); GRID_SYNC(); }
    if (args.rep[3] == 3) { pg8::Gemm g{XB, WIN, TOK, 4096, DM}; pg8::StaticOrder S; S.init(TOK, 4096, G, (int)blockIdx.x); pg8::EpiDry E{PEB, args.rep[0] - 1};
      pg8::gemm_phase<pg8::EpiDry, pg8::StaticOrder, true, true>(ldsl, g, S, E); GRID_SYNC(); }
    if (args.rep[3] == 4) { pg8::Gemm g{XB, WA, TOK, DM, 512}; pg8::StaticOrder S; S.init(TOK, DM, G, (int)blockIdx.x); pg8::EpiDry E{PEB, args.rep[0] - 1};
      pg8::gemm_phase<pg8::EpiDry, pg8::StaticOrder, true, true>(ldsl, g, S, E); GRID_SYNC(); }
    if (args.rep[3] == 6) { GRID_SYNC(); GRID_SYNC(); GRID_SYNC(); GRID_SYNC(); GRID_SYNC(); GRID_SYNC(); GRID_SYNC(); GRID_SYNC(); GRID_SYNC(); GRID_SYNC(); }
    { pg8::Gemm g{ACT, W1D, TOK, DM, DFF}; pg8::StaticOrder S; S.init(TOK, DM, G, (int)blockIdx.x);
      pg8::EpiResid E{x, H, XB, SSQ1, 0.5f};
      pg8::gemm_phase<pg8::EpiResid, pg8::StaticOrder, true, true>(ldsl, g, S, E); }
    GRID_SYNC();
    if (DBG_STOP == 1) return;
#endif
    { pg8::Gemm g{XB, WIN, TOK, 4096, DM}; pg8::StaticOrder S; S.init(TOK, 4096, G, (int)blockIdx.x);
      pg8::EpiProj E{
#if defined(DBG_NOFFN1)
 SSQ0,
#else
 SSQ1,
#endif
 ROPEC, ROPES, NQ, KC, VC, KSL, VSLT, KWN, VWNT, SQ, SK, SVT, GA, GB, NG};
      pg8::gemm_phase<pg8::EpiProj, pg8::StaticOrder, true, true>(ldsl, g, S, E); }
    GRID_SYNC();
    if (DBG_STOP == 13) DUMP_LOOP(bf2f(NQ[i_ & 8388607]) + bf2f(SQ[i_ & 8388607]) + bf2f(KC[i_ & 2097151]) + bf2f(VC[i_ & 2097151]) + bf2f(KSL[i_ & 2097151]) + bf2f(VSLT[i_ & 2097151]) + bf2f(KWN[i_ & 2097151]) + bf2f(VWNT[i_ & 2097151]) + bf2f(SK[i_ & 1048575]) + bf2f(SVT[i_ & 1048575]) + NG[i_ % (TOK * 24)]);
    if (DBG_STOP == 11) DUMP_LOOP(bf2f(GA[i_]) + bf2f(GB[i_]));
    if (DBG_STOP == 2) DUMP_LOOP(bf2f(GA[i_]) + bf2f(GB[i_]) + bf2f(NQ[i_ & 8388607]) + bf2f(SQ[i_ & 8388607]) + bf2f(KC[i_ & 2097151]) + bf2f(VC[i_ & 2097151]) + bf2f(KSL[i_ & 2097151]) + bf2f(VSLT[i_ & 2097151]) + bf2f(KWN[i_ & 2097151]) + bf2f(VWNT[i_ & 2097151]) + bf2f(SK[i_ & 1048575]) + bf2f(SVT[i_ & 1048575]) + NG[i_ % (TOK * 24)]);

    for (int rep = 0; rep < args.rep[0]; ++rep)
    for (int u = blockIdx.x; u < 256; u += G) {
        const int z = u >> 7, r0 = (u & 127) * 16;
        const bf16_t* A = z ? VC : KC; const bf16_t* W1 = z ? CW1V : CW1K; const bf16_t* W2 = z ? CW2V : CW2K; const float* peb = PEB + z * 256;
        constexpr int AS = 2048 + 8;
        bf16_t* As_ = (bf16_t*)lds;
        bf16_t* hid = (bf16_t*)(lds + 16 * AS * 2);
        {
            u32x4 av[8];
#pragma unroll
            for (int i = 0; i < 8; ++i) { const int c = tid + 512 * i, row = c >> 8, ch = c & 255; av[i] = *(const u32x4*)(A + (size_t)(r0 + row) * 1024 + ch * 8); }
#pragma unroll
            for (int i = 0; i < 8; ++i) { const int c = tid + 512 * i, row = c >> 8, ch = c & 255; *(u32x4*)(As_ + row * AS + ch * 8) = av[i]; }
        }
        __syncthreads();
        f32x4 acc0 = {0.f, 0.f, 0.f, 0.f}, acc1 = {0.f, 0.f, 0.f, 0.f};
        const bf16_t* ap = As_ + fr * AS + 8 * fq;
        const bf16_t* bp0 = W1 + (size_t)(32 * wave + fr) * 2048 + 8 * fq; const bf16_t* bp1 = bp0 + 16 * 2048;
#pragma unroll 16
        for (int k0 = 0; k0 < 2048; k0 += 32) {
            const bf16x8 a = *(const bf16x8*)(ap + k0), b0 = *(const bf16x8*)(bp0 + k0), b1 = *(const bf16x8*)(bp1 + k0);
            acc0 = MFMA16(b0, a, acc0); acc1 = MFMA16(b1, a, acc1);
        }
#pragma unroll
        for (int nt = 0; nt < 2; ++nt) {
            const f32x4 a = nt ? acc1 : acc0; const int col = 32 * wave + 16 * nt + 4 * fq;
            float hv[4];
#pragma unroll
            for (int r = 0; r < 4; ++r) { const float h = a[r] + ((peb[col + r] + peb[512 + col + r]) + (peb[1024 + col + r] + peb[1536 + col + r])); const float uu = 0.7978845608028654f * (h + 0.044715f * h * h * h);
                const float th = 1.0f - 2.0f * fast_rcp(1.0f + fast_exp2(2.0f * LOG2E * uu)); hv[r] = 0.5f * h * (1.0f + th); }
            unsigned* hp = (unsigned*)(hid + fr * 264 + col); hp[0] = cvt_pk_bf16(hv[0], hv[1]); hp[1] = cvt_pk_bf16(hv[2], hv[3]);
        }
        __syncthreads();
        if (wave < 4) {
            f32x4 acc2 = {0.f, 0.f, 0.f, 0.f};
            const bf16_t* wp = W2 + (size_t)(16 * wave + fr) * 256 + 8 * fq;
#pragma unroll
            for (int k0 = 0; k0 < 256; k0 += 32) { const bf16x8 a = *(const bf16x8*)(wp + k0), bb = *(const bf16x8*)(hid + fr * 264 + k0 + 8 * fq); acc2 = MFMA16(a, bb, acc2); }
            const int r = r0 + fr, bg = r >> 9, i = r & 511, bb_ = bg >> 1;
            const bool ok = i < 511;
            if (z == 0) {
                const int trow = bb_ * SEQ + 16 * (ok ? i : 0) + 31, i0 = 8 * wave + 2 * fq;
                const float c0 = ROPEC[(size_t)trow * 32 + i0], s0 = ROPES[(size_t)trow * 32 + i0], c1 = ROPEC[(size_t)trow * 32 + i0 + 1], s1 = ROPES[(size_t)trow * 32 + i0 + 1];
                float o0 = acc2[0] * c0 - acc2[1] * s0, o1 = acc2[1] * c0 + acc2[0] * s0, o2 = acc2[2] * c1 - acc2[3] * s1, o3 = acc2[3] * c1 + acc2[2] * s1;
                if (!ok) { o0 = 0.f; o1 = 0.f; o2 = 0.f; o3 = 0.f; }
                unsigned* kp = (unsigned*)(KCMP + ((size_t)bg * 512 + i) * 64 + 16 * wave + 4 * fq); kp[0] = cvt_pk_bf16(o0, o1); kp[1] = cvt_pk_bf16(o2, o3);
            } else {
#pragma unroll
                for (int rr = 0; rr < 4; ++rr) VCMPT[((size_t)bg * 64 + 16 * wave + 4 * fq + rr) * 512 + i] = (bf16_t)f2bf(ok ? acc2[rr] : 0.f);
            }
        }
        __syncthreads();
    }
    GRID_SYNC();
    if (DBG_STOP == 3) DUMP_LOOP(bf2f(KCMP[i_ & 131071]) + bf2f(VCMPT[i_ & 131071]));

    if (DBG_STOP == 4) DUMP_LOOP(bf2f(OCMP[i_ & 8388607]) + (float)(SEL[i_ & 131071] & 0xffffu));

    {
        constexpr int RB = 4, SLOTB = 32768;
        const unsigned ring_base = (unsigned)(size_t)ldsl;
        const unsigned char* ring = (const unsigned char*)lds;
        unsigned* Usc = (unsigned*)(lds + RB * SLOTB);
        int* lst = (int*)(lds + RB * SLOTB + 128);
        int* nls = (int*)(lds + RB * SLOTB + 128 + 1024);
        int* flg = (int*)(lds + RB * SLOTB + 128 + 1024 + 128);
        const int dl_r = lane >> 3, dl_c = lane & 7;
        const unsigned voffK = (unsigned)((8 * (dl_r >> 2) + (dl_r & 3)) * 128 + ((dl_c ^ dl_r) << 4)), voffV = (unsigned)(dl_r * SEQ * 2 + ((dl_c ^ dl_r) << 4));
        const int offA = fr * 128 + ((fq ^ (fr & 7)) << 4), offB = fr * 128 + (((fq ^ (fr & 7)) ^ 4) << 4);
        for (int rep = 0; rep < args.rep[2]; ++rep)
        for (int wu = blockIdx.x; wu < 512; wu += G) {
            const int bg6 = 2 * (wu >> 8) + ((wu & 255) >> 7), tau6 = ((wu & 255) & 128) ? 127 - (wu & 127) : (wu & 127), tile6 = (wu >> 8) ? 127 - tau6 : tau6;
    {
        constexpr int RS = 72;
        bf16_t* Kb = (bf16_t*)lds;
        bf16_t* Vb = (bf16_t*)(lds + 2 * 64 * RS * 2);
        float* Pl = (float*)(lds + 40960 + wave * 10240);
        unsigned long long* KEY = (unsigned long long*)(Pl + 2048);
        const int skr = tid >> 3, sc8 = (tid & 7) * 8;
        const int krow = (skr & 32) + (((skr & 7) < 4) ? (4 * ((skr & 31) >> 3) + (skr & 7)) : (16 + 4 * ((skr & 31) >> 3) + (skr & 7) - 4));
        for (int h5 = 0; h5 < 2; ++h5) {
            const int bg = bg6, tile = 2 * tile6 + h5, t0w = tile * 32, t0 = t0w + 4 * wave, b = bg >> 1, g = bg & 1;
            const int tl = fr >> 2, hh = fr & 3, t = t0 + tl, head = g * 4 + hh;
            const size_t qrow = (size_t)(b * SEQ + t);
            bf16x8 qf[2]; qf[0] = *(const bf16x8*)(NQ + qrow * 512 + head * 64 + 8 * fq); qf[1] = *(const bf16x8*)(NQ + qrow * 512 + head * 64 + 32 + 8 * fq);
            const bf16_t* Kc = KCMP + (size_t)bg * 512 * 64; const bf16_t* Vc = VCMPT + (size_t)bg * 64 * 512;
            const int hi = (t >= 31) ? ((t - 31) >> 4) : -1;
            const int hiw = (t0 + 3 >= 31) ? ((t0 + 3 - 31) >> 4) : -1;
            const int nst = (2 * tile + 64) >> 6;
            u32x4 kreg, vreg;
#define C_LOADK(s_) do { kreg = *(const u32x4*)(Kc + (size_t)(64 * (s_) + skr) * 64 + sc8); } while (0)
#define C_LOADV(s_) do { vreg = *(const u32x4*)(Vc + (size_t)skr * 512 + 64 * (s_) + sc8); } while (0)
#define C_WRITEK(bufi) do { *(u32x4*)(Kb + (bufi) * 64 * RS + krow * RS + sc8) = kreg; } while (0)
#define C_WRITEV(bufi) do { *(u32x4*)(Vb + (bufi) * 64 * RS + skr * RS + sc8) = vreg; } while (0)
#define C_FRAGK(F, Kt, half) do { const bf16_t* ka = (Kt) + (32 * (half) + fr) * RS + 8 * fq; \
                F.k0 = *(const bf16x8*)ka; F.k1 = *(const bf16x8*)(ka + 32); F.k2 = *(const bf16x8*)(ka + 16 * RS); F.k3 = *(const bf16x8*)(ka + 16 * RS + 32); } while (0)
#define C_FRAGV(F, Vt, half) do { const bf16_t* va = (Vt) + fr * RS + 32 * (half) + 8 * fq; \
                F.v0 = *(const bf16x8*)va; F.v1 = *(const bf16x8*)(va + 16 * RS); F.v2 = *(const bf16x8*)(va + 32 * RS); F.v3 = *(const bf16x8*)(va + 48 * RS); } while (0)
            float m = NEGBIG, l = 0.f;
            C_LOADK(0); C_WRITEK(0);
            __syncthreads();
            for (int s = 0; s < nst; ++s) {
                if (s + 1 < nst) C_LOADK(s + 1);
                const bf16_t* Kt = Kb + (s & 1) * 64 * RS;
#pragma unroll
                for (int half = 0; half < 2; ++half) {
                    const int kbase = 64 * s + 32 * half;
                    if (kbase <= hiw) {
                        Frag F; C_FRAGK(F, Kt, half);
                        f32x4 sA, sB; qk_frag(F, qf, sA, sB);
                        SCORES8(sA, sB, kbase + 8 * fq, 0, hi, sc_, v)
                        float mx = fmaxf(fmaxf(fmaxf(sc_[0], sc_[1]), fmaxf(sc_[2], sc_[3])), fmaxf(fmaxf(sc_[4], sc_[5]), fmaxf(sc_[6], sc_[7])));
                        mx = rowmax4(mx);
                        const float mn = fmaxf(m, mx), alpha = fast_exp2(m - mn);
                        float sum = 0.f;
#pragma unroll
                        for (int e = 0; e < 8; ++e) sum += v[e] ? fast_exp2(sc_[e] - mn) : 0.f;
                        sum = rowsum4(sum);
                        l = l * alpha + sum; m = mn;
                    }
                }
                if (s + 1 < nst) C_WRITEK((s + 1) & 1);
                __syncthreads();
            }
            const float inv_l = l > 0.f ? 1.0f / l : 0.f;
#pragma unroll
            for (int q = 0; q < 8; ++q) ((f32x4*)Pl)[lane + 64 * q] = (f32x4){0.f, 0.f, 0.f, 0.f};
            f32x4 o[4];
#pragma unroll
            for (int nt = 0; nt < 4; ++nt) o[nt] = (f32x4){0.f, 0.f, 0.f, 0.f};
            C_LOADK(0); C_LOADV(0); C_WRITEK(0); C_WRITEV(0);
            __syncthreads();
            for (int s = 0; s < nst; ++s) {
                if (s + 1 < nst) { C_LOADK(s + 1); C_LOADV(s + 1); }
                const bf16_t* Kt = Kb + (s & 1) * 64 * RS; const bf16_t* Vt = Vb + (s & 1) * 64 * RS;
#pragma unroll
                for (int half = 0; half < 2; ++half) {
                    const int kbase = 64 * s + 32 * half;
                    if (kbase <= hiw) {
                        Frag F; C_FRAGK(F, Kt, half); C_FRAGV(F, Vt, half);
                        f32x4 sA, sB; qk_frag(F, qf, sA, sB);
                        SCORES8(sA, sB, kbase + 8 * fq, 0, hi, sc_, v)
                        float p[8], ps[8];
#pragma unroll
                        for (int e = 0; e < 8; ++e) { p[e] = v[e] ? fast_exp2(sc_[e] - m) * inv_l : 0.f; float q_ = p[e] + __shfl_xor(p[e], 1); ps[e] = q_ + __shfl_xor(q_, 2); }
                        if (hh == 0) { f32x4* pp = (f32x4*)(Pl + tl * 512 + kbase + 8 * fq); pp[0] = (f32x4){ps[0], ps[1], ps[2], ps[3]}; pp[1] = (f32x4){ps[4], ps[5], ps[6], ps[7]}; }
                        u32x4 w; w.x = cvt_pk_bf16(p[0], p[1]); w.y = cvt_pk_bf16(p[2], p[3]); w.z = cvt_pk_bf16(p[4], p[5]); w.w = cvt_pk_bf16(p[6], p[7]);
                        pv_frag(F, __builtin_bit_cast(bf16x8, w), o);
                    }
                }
                if (s + 1 < nst) { C_WRITEK((s + 1) & 1); C_WRITEV((s + 1) & 1); }
                __syncthreads();
            }
            {
                const float gc = NG[qrow * 24 + head];
#pragma unroll
                for (int nt = 0; nt < 4; ++nt) { unsigned* op = (unsigned*)(OCMP + qrow * 512 + head * 64 + 16 * nt + 4 * fq);
                    op[0] = cvt_pk_bf16(o[nt][0] * gc, o[nt][1] * gc); op[1] = cvt_pk_bf16(o[nt][2] * gc, o[nt][3] * gc); }
            }
            LDS_WAIT();
            for (int tk = 0; tk < 4; ++tk) {
                const int tt = t0 + tk, tb = tt >> 6;
                const float* P = Pl + tk * 512;
                unsigned hv[2];
#pragma unroll
                for (int q = 0; q < 2; ++q) { const int j = lane + 64 * q;
                    const float a = (j > 0 ? 0.5f * P[4 * j - 1] : 0.f) + P[4 * j] + P[4 * j + 1] + P[4 * j + 2] + 0.5f * P[4 * j + 3];
                    const bool forced = (j == 0) || (j <= tb && tb - j < 2);
                    hv[q] = j > tb ? 0u : (forced ? 0x7f000000u : __float_as_uint(a) + 1u); }
                unsigned T = 0u;
                for (int bit = 30; bit >= 0; --bit) {
                    const unsigned cand = T | (1u << bit);
                    const int cnt = __builtin_popcountll(__ballot(hv[0] >= cand)) + __builtin_popcountll(__ballot(hv[1] >= cand));
                    T = cnt >= 16 ? cand : T;
                }
                const unsigned long long g0 = __ballot(hv[0] > T), g1 = __ballot(hv[1] > T), e0 = __ballot(hv[0] == T), e1 = __ballot(hv[1] == T);
                const int need = 16 - (__builtin_popcountll(g0) + __builtin_popcountll(g1));
                const unsigned long long below = (1ull << lane) - 1ull;
                const bool s0 = (hv[0] > T) || ((hv[0] == T) && __builtin_popcountll(e0 & below) < need);
                const bool s1 = (hv[1] > T) || ((hv[1] == T) && (__builtin_popcountll(e0) + __builtin_popcountll(e1 & below)) < need);
                const unsigned long long b0 = __ballot(s0 && lane <= tb), b1 = __ballot(s1 && lane + 64 <= tb);
                if (lane == 0) { u32x4 w; w.x = (unsigned)b0; w.y = (unsigned)(b0 >> 32); w.z = (unsigned)b1; w.w = (unsigned)(b1 >> 32); *(u32x4*)(SEL + ((size_t)bg * SEQ + tt) * 4) = w; }
            }
            LDS_WAIT();
        }
    }
            asm volatile("s_waitcnt vmcnt(0)" ::: "memory");
            __syncthreads();
            const int k_ = wu >> 8, bb_ = wu & 255, bg = 2 * k_ + (bb_ >> 7), tau = (bb_ & 128) ? 127 - (bb_ & 127) : (bb_ & 127), tile = k_ ? 127 - tau : tau;
            const int t0w = tile * 64, t0 = t0w + 8 * wave, b = bg >> 1, g = bg & 1;
            const int tl = fr >> 2, hh = fr & 3, head = g * 4 + hh;
            const bf16_t* Ks = KSL + (size_t)bg * SEQ * 64; const bf16_t* Vs = VSLT + (size_t)bg * 64 * SEQ;
            const bf16_t* Kw = KWN + (size_t)bg * SEQ * 64; const bf16_t* Vw = VWNT + (size_t)bg * 64 * SEQ;
            bf16x8 qf[2][2]; u32x4 mym[2]; unsigned Uw[2][4]; int tr[2];
#pragma unroll
            for (int rg = 0; rg < 2; ++rg) {
                tr[rg] = t0 + 4 * rg + tl;
                const size_t qrow = (size_t)(b * SEQ + tr[rg]);
                qf[rg][0] = *(const bf16x8*)(NQ + qrow * 512 + head * 64 + 8 * fq); qf[rg][1] = *(const bf16x8*)(NQ + qrow * 512 + head * 64 + 32 + 8 * fq);
                mym[rg] = __builtin_nontemporal_load((const u32x4*)(SEL + ((size_t)bg * SEQ + tr[rg]) * 4));
#pragma unroll
                for (int w = 0; w < 4; ++w) { const unsigned mw = mym[rg][w];
                    Uw[rg][w] = (unsigned)__builtin_amdgcn_readlane((int)mw, 0) | (unsigned)__builtin_amdgcn_readlane((int)mw, 4) | (unsigned)__builtin_amdgcn_readlane((int)mw, 8) | (unsigned)__builtin_amdgcn_readlane((int)mw, 12); }
            }
            if (lane == 0) { Usc[wave * 4 + 0] = Uw[0][0] | Uw[1][0]; Usc[wave * 4 + 1] = Uw[0][1] | Uw[1][1]; Usc[wave * 4 + 2] = Uw[0][2] | Uw[1][2]; Usc[wave * 4 + 3] = Uw[0][3] | Uw[1][3]; }
            __syncthreads();
            if (wave == 0) {
                int n0 = 0;
#pragma unroll
                for (int q = 0; q < 2; ++q) { const int j = lane + 64 * q; unsigned ug = 0u;
#pragma unroll
                    for (int ww = 0; ww < 8; ++ww) ug |= Usc[ww * 4 + (j >> 5)];
                    const bool in = ((ug >> (j & 31)) & 1u) && (64 * j <= t0w + 63);
                    const unsigned long long bal = __ballot(in);
                    const int pos = n0 + __builtin_popcountll(bal & ((1ull << lane) - 1ull));
                    if (in) lst[pos] = j;
                    n0 += __builtin_popcountll(bal); }
                if (n0 & 1) { if (lane == 0) lst[n0] = 0x100; ++n0; }
                const int jw0 = (t0w - 511 > 0 ? t0w - 511 : 0) >> 6, nw = ((t0w + 63) >> 6) - jw0 + 1;
                if (lane < nw) lst[n0 + lane] = (jw0 + lane) | 0x80;
                if ((nw & 1) && lane == 0) lst[n0 + nw] = 0x180;
                if (lane == 0) nls[0] = n0 + ((nw + 1) & ~1);
                if (lane < 16) flg[lane] = 0;
            }
            __syncthreads();
            const int n = RFL(nls[0]);
            float mS[2], lS[2]; f32x4 oS[2][4];
#pragma unroll
            for (int rg = 0; rg < 2; ++rg) { mS[rg] = NEGBIG; lS[rg] = 0.f;
#pragma unroll
                for (int nt = 0; nt < 4; ++nt) oS[rg][nt] = (f32x4){0.f, 0.f, 0.f, 0.f}; }
            int nslc_ = 0;
            { int c_ = 0; for (int i_ = lane; i_ < n; i_ += 64) c_ += (lst[i_] & 0x80) ? 0 : 1; c_ = (int)wave_sum((float)c_); nslc_ = RFL(c_); }
#define RG_WAIT(ptr, target) do { while (__hip_atomic_load((ptr), __ATOMIC_RELAXED, __HIP_MEMORY_SCOPE_WORKGROUP) < (target)) __builtin_amdgcn_s_sleep(1); asm volatile("" ::: "memory"); } while (0)
#define RG_SIGNAL(ptr) do { LDS_WAIT(); if (lane == 0) __hip_atomic_fetch_add((ptr), 1, __ATOMIC_RELAXED, __HIP_MEMORY_SCOPE_WORKGROUP); } while (0)
#define DMA_ISSUE(k_) do { const int slot_ = (k_) % RB; RG_WAIT(flg + 8 + slot_, 8 * ((k_) / RB)); \
                for (int sub_ = 0; sub_ < 2; ++sub_) { const int e_ = RFL(lst[2 * (k_) + sub_]); \
                  if (!(e_ & 0x100)) { \
                    const int j_ = e_ & 127; const bf16_t* Kg_ = (e_ & 0x80) ? Kw : Ks; const bf16_t* Vg_ = (e_ & 0x80) ? Vw : Vs; const unsigned sb_ = ring_base + slot_ * SLOTB + sub_ * 16384; \
                    _Pragma("unroll") for (int q_ = 0; q_ < 8; ++q_) { constexpr int RC_[4] = {0, 16, 4, 20}; \
                        glds16s(Kg_ + (size_t)(64 * j_ + 32 * (q_ >> 2) + RC_[q_ & 3]) * 64, voffK, sb_ + q_ * 1024); } \
                    _Pragma("unroll") for (int q_ = 0; q_ < 8; ++q_) glds16s(Vg_ + (size_t)(8 * q_) * SEQ + 64 * j_, voffV, sb_ + 8192 + q_ * 1024); } } \
                } while (0)
#define DMA_PUBLISH(k_) do { asm volatile("s_waitcnt vmcnt(0)" ::: "memory"); if (lane == 0) __hip_atomic_store(flg + ((k_) % RB), (k_) / RB + 1, __ATOMIC_RELAXED, __HIP_MEMORY_SCOPE_WORKGROUP); } while (0)
#define ST_COMPUTE(s_, WIN) do { const int slot = (s_) % RB; \
                RG_WAIT(flg + slot, (s_) / RB + 1); \
                for (int sub = 0; sub < 2; ++sub) { const int e = RFL(lst[2 * (s_) + sub]); if (e & 0x100) continue; const int j = e & 127; \
                const unsigned char* Kt = ring + slot * SLOTB + sub * 16384; const unsigned char* Vt = Kt + 8192; \
                bool act[2], inter[2]; float rb[2]; \
                _Pragma("unroll") for (int rg = 0; rg < 2; ++rg) { const int t0g = t0 + 4 * rg; \
                    if (WIN) { act[rg] = (64 * j + 63 >= t0g - 511) && (64 * j <= t0g + 3); inter[rg] = (64 * j >= t0g + 3 - 511) && (64 * j + 63 <= t0g); rb[rg] = 0.f; } \
                    else { const unsigned uw = j < 32 ? Uw[rg][0] : j < 64 ? Uw[rg][1] : j < 96 ? Uw[rg][2] : Uw[rg][3]; act[rg] = (((uw >> (j & 31)) & 1u) != 0u) && (64 * j <= t0g + 3); \
                           const unsigned mw_ = j < 32 ? mym[rg].x : j < 64 ? mym[rg].y : j < 96 ? mym[rg].z : mym[rg].w; rb[rg] = ((mw_ >> (j & 31)) & 1u) ? 0.f : NEGBIG; inter[rg] = (64 * j + 63 <= t0g); } } \
                _Pragma("unroll") for (int rg = 0; rg < 2; ++rg) if (act[rg]) { \
                    const int t = tr[rg]; f32x4 sc[4]; bf16x8 pf0, pf1; bf16x8 kf[8], vf[8]; \
                    _Pragma("unroll") for (int q_ = 0; q_ < 4; ++q_) { kf[2 * q_] = *(const bf16x8*)(Kt + offA + q_ * 2048); kf[2 * q_ + 1] = *(const bf16x8*)(Kt + offB + q_ * 2048); } \
                    __builtin_amdgcn_sched_barrier(0);     \
                    { const f32x4 z_ = {0.f, 0.f, 0.f, 0.f}; \
                      _Pragma("unroll") for (int q_ = 0; q_ < 4; ++q_) { sc[q_] = MFMA16(kf[2 * q_], qf[rg][0], z_); sc[q_] = MFMA16(kf[2 * q_ + 1], qf[rg][1], sc[q_]); } } \
                    vf[0] = *(const bf16x8*)(Vt + offA); vf[1] = *(const bf16x8*)(Vt + offB); \
                    __builtin_amdgcn_sched_barrier(0);     \
                    if (inter[rg]) soft_step64<false>(sc, 64 * j + 8 * fq, (WIN) ? t - 511 : 0, t, rb[rg], mS[rg], lS[rg], oS[rg], pf0, pf1); \
                    else soft_step64<true>(sc, 64 * j + 8 * fq, (WIN) ? t - 511 : 0, t, rb[rg], mS[rg], lS[rg], oS[rg], pf0, pf1); \
                    __builtin_amdgcn_sched_barrier(0); \
                    _Pragma("unroll") for (int nt = 1; nt < 4; ++nt) { vf[2 * nt] = *(const bf16x8*)(Vt + offA + nt * 2048); vf[2 * nt + 1] = *(const bf16x8*)(Vt + offB + nt * 2048); } \
                    __builtin_amdgcn_sched_barrier(0); \
                    _Pragma("unroll") for (int nt = 0; nt < 4; ++nt) { oS[rg][nt] = MFMA16(vf[2 * nt], pf0, oS[rg][nt]); oS[rg][nt] = MFMA16(vf[2 * nt + 1], pf1, oS[rg][nt]); } \
                } } \
                RG_SIGNAL(flg + 8 + slot); } while (0)
#define ST_STAGE(s_, WIN) do { \
                if ((((s_) + 1) & 7) == wave && (s_) >= 1 && (s_) + 1 < np_) DMA_PUBLISH((s_) + 1);            \
                if ((((s_) + 2) & 7) == wave && (s_) + 2 < np_) DMA_ISSUE((s_) + 2); \
                ST_COMPUTE(s_, WIN); } while (0)
            const int np_ = n >> 1, nps_ = nslc_ >> 1;
            if (wave < 2 && wave < np_) { DMA_ISSUE(wave); DMA_PUBLISH(wave); }
            for (int s = 0; s < nps_; ++s) ST_STAGE(s, false);
#pragma unroll
            for (int rg = 0; rg < 2; ++rg) {
                const size_t qrow = (size_t)(b * SEQ + tr[rg]);
                const float a1 = NG[qrow * 24 + 8 + head] / lS[rg];
#pragma unroll
                for (int nt = 0; nt < 4; ++nt) { unsigned* op = (unsigned*)(OCMP + qrow * 512 + head * 64 + 16 * nt + 4 * fq);
                    const unsigned w0 = op[0], w1 = op[1];
                    const float r0 = __uint_as_float(w0 << 16) + a1 * oS[rg][nt][0], r1 = __uint_as_float(w0 & 0xffff0000u) + a1 * oS[rg][nt][1];
                    const float r2 = __uint_as_float(w1 << 16) + a1 * oS[rg][nt][2], r3 = __uint_as_float(w1 & 0xffff0000u) + a1 * oS[rg][nt][3];
                    if (rep == args.rep[2] - 1) { op[0] = cvt_pk_bf16(r0, r1); op[1] = cvt_pk_bf16(r2, r3); }
                    oS[rg][nt] = (f32x4){0.f, 0.f, 0.f, 0.f}; }
                mS[rg] = NEGBIG; lS[rg] = 0.f;
            }
            asm volatile("s_waitcnt vmcnt(0)" ::: "memory");
            for (int s = nps_; s < np_; ++s) ST_STAGE(s, true);
#pragma unroll
            for (int rg = 0; rg < 2; ++rg) {
                const size_t qrow = (size_t)(b * SEQ + tr[rg]);
                const float a2 = NG[qrow * 24 + 16 + head] / lS[rg];
#pragma unroll
                for (int nt = 0; nt < 4; ++nt) { unsigned* op = (unsigned*)(OCMP + qrow * 512 + head * 64 + 16 * nt + 4 * fq);
                    const unsigned w0 = op[0], w1 = op[1];
                    const float r0 = __uint_as_float(w0 << 16) + a2 * oS[rg][nt][0], r1 = __uint_as_float(w0 & 0xffff0000u) + a2 * oS[rg][nt][1];
                    const float r2 = __uint_as_float(w1 << 16) + a2 * oS[rg][nt][2], r3 = __uint_as_float(w1 & 0xffff0000u) + a2 * oS[rg][nt][3];
                    if (rep == args.rep[2] - 1) { op[0] = cvt_pk_bf16(r0, r1); op[1] = cvt_pk_bf16(r2, r3); } }
            }
            LDS_WAIT();
            __syncthreads();
        }
    }
    __syncthreads();
#ifndef SWA_MUL
#define SWA_MUL 1
#endif
    {
        constexpr int RS = 72;
        bf16_t* Kb = (bf16_t*)lds; bf16_t* Vb = (bf16_t*)(lds + 2 * 64 * RS * 2);
        const int skr = tid >> 3, sc8 = (tid & 7) * 8;
        const int krow = (skr & 32) + (((skr & 7) < 4) ? (4 * ((skr & 31) >> 3) + (skr & 7)) : (16 + 4 * ((skr & 31) >> 3) + (skr & 7) - 4));
        for (int rep = 0, nrepS = args.rep[2] * SWA_MUL; rep < nrepS; ++rep)
        for (int wu = blockIdx.x; wu < 512; wu += G) {
            const int b = wu >> 8, t0w = (wu & 255) * 32, t0 = t0w + 4 * wave;
            const int tl = fr >> 3, h = fr & 7;
            const bf16_t* Kp = SK + (size_t)b * SEQ * 64; const bf16_t* Vp = SVT + (size_t)b * 64 * SEQ;
            bf16x8 qf[2][2]; int tr[2]; float mS[2], lS[2]; f32x4 oS[2][4];
#pragma unroll
            for (int rg = 0; rg < 2; ++rg) { tr[rg] = t0 + 2 * rg + tl; const size_t qrow = (size_t)(b * SEQ + tr[rg]);
                qf[rg][0] = *(const bf16x8*)(SQ + qrow * 512 + h * 64 + 8 * fq); qf[rg][1] = *(const bf16x8*)(SQ + qrow * 512 + h * 64 + 32 + 8 * fq);
                mS[rg] = NEGBIG; lS[rg] = 0.f;
#pragma unroll
                for (int nt = 0; nt < 4; ++nt) oS[rg][nt] = (f32x4){0.f, 0.f, 0.f, 0.f}; }
            const int jlo = (t0w - 127 > 0 ? t0w - 127 : 0) >> 6, n = ((t0w + 31) >> 6) - jlo + 1;
            u32x4 kreg, vreg;
#define SW_LOAD(j_) do { kreg = *(const u32x4*)(Kp + (size_t)(64 * (j_) + skr) * 64 + sc8); vreg = *(const u32x4*)(Vp + (size_t)skr * SEQ + 64 * (j_) + sc8); } while (0)
#define SW_WRITE(bufi) do { *(u32x4*)(Kb + (bufi) * 64 * RS + krow * RS + sc8) = kreg; *(u32x4*)(Vb + (bufi) * 64 * RS + skr * RS + sc8) = vreg; } while (0)
            SW_LOAD(jlo); SW_WRITE(0);
            __syncthreads();
            for (int s = 0; s < n; ++s) {
                const int j = jlo + s;
                if (s + 1 < n) SW_LOAD(j + 1);
                const bf16_t* Kt = Kb + (s & 1) * 64 * RS; const bf16_t* Vt = Vb + (s & 1) * 64 * RS;
#pragma unroll
                for (int rg = 0; rg < 2; ++rg) {
                    const int t0g = t0 + 2 * rg, t = tr[rg];
                    const bool act = (64 * j + 63 >= t0g - 127) && (64 * j <= t0g + 1), inter = (64 * j >= t0g + 1 - 127) && (64 * j + 63 <= t0g);
                    if (act) {
                        f32x4 sc[4]; bf16x8 pf0, pf1;
                        { const bf16_t* ka = Kt + fr * RS + 8 * fq; const f32x4 z_ = {0.f, 0.f, 0.f, 0.f};
#pragma unroll
                          for (int q_ = 0; q_ < 4; ++q_) { const bf16x8 ka0 = *(const bf16x8*)(ka + 16 * q_ * RS), ka1 = *(const bf16x8*)(ka + 16 * q_ * RS + 32);
                              sc[q_] = MFMA16(ka0, qf[rg][0], z_); sc[q_] = MFMA16(ka1, qf[rg][1], sc[q_]); } }
                        if (inter) soft_step64<false>(sc, 64 * j + 8 * fq, t - 127, t, 0.f, mS[rg], lS[rg], oS[rg], pf0, pf1);
                        else soft_step64<true>(sc, 64 * j + 8 * fq, t - 127, t, 0.f, mS[rg], lS[rg], oS[rg], pf0, pf1);
                        { const bf16_t* va = Vt + fr * RS + 8 * fq;
#pragma unroll
                          for (int nt = 0; nt < 4; ++nt) { const bf16x8 va0 = *(const bf16x8*)(va + 16 * nt * RS), va1 = *(const bf16x8*)(va + 16 * nt * RS + 32);
                              oS[rg][nt] = MFMA16(va0, pf0, oS[rg][nt]); oS[rg][nt] = MFMA16(va1, pf1, oS[rg][nt]); } }
                    }
                }
                if (s + 1 < n) SW_WRITE((s + 1) & 1);
                __syncthreads();
            }
#pragma unroll
            for (int rg = 0; rg < 2; ++rg) {
                const size_t qrow = (size_t)(b * SEQ + tr[rg]);
                const float sink2 = args.in[14][h] * LOG2E, mf = fmaxf(mS[rg], sink2), aa = fast_exp2(mS[rg] - mf), lt = lS[rg] * aa + fast_exp2(sink2 - mf), scl = aa / lt;
#pragma unroll
                for (int nt = 0; nt < 4; ++nt) { unsigned* op = (unsigned*)(OB + qrow * 512 + h * 64 + 16 * nt + 4 * fq);
                    if (rep == nrepS - 1) { op[0] = cvt_pk_bf16(oS[rg][nt][0] * scl, oS[rg][nt][1] * scl); op[1] = cvt_pk_bf16(oS[rg][nt][2] * scl, oS[rg][nt][3] * scl); } }
            }
        }
    }
    GRID_SYNC();
    if (DBG_STOP == 5) DUMP_LOOP(bf2f(OCMP[i_ & 8388607]) + bf2f(SQ[i_ & 8388607]));
    if (DBG_STOP == 10) DUMP_LOOP(bf2f(GA[i_]) + bf2f(GB[i_]));

#if !defined(DBG_SKIP_PASS1)
    { pg8::Gemm g{OCMP, WA, TOK, DM, 512}; pg8::StaticOrder S; S.init(TOK, DM, G, (int)blockIdx.x);
      pg8::EpiMerge<1> E{GA, nullptr};
      pg8::gemm_phase<pg8::EpiMerge<1>, pg8::StaticOrder, true, true>(ldsl, g, S, E); }
    if (DBG_STOP == 8) { GRID_SYNC(); DUMP_LOOP(bf2f(GA[i_])); }
    if (DBG_STOP == 9) GRID_SYNC();
#endif
#if !defined(DBG_SKIP_PASS2)
    { pg8::Gemm g{OB, WB, TOK, DM, 512}; pg8::StaticOrder S; S.init(TOK, DM, G, (int)blockIdx.x);
      pg8::EpiMerge<2> E{GA, GB};
      pg8::gemm_phase<pg8::EpiMerge<2>, pg8::StaticOrder, true, true>(ldsl, g, S, E); }
#endif
    GRID_SYNC();
    if (DBG_STOP == 6) DUMP_LOOP(bf2f(GA[i_]));
    { pg8::Gemm g{GA, WOUT, TOK, DM, DM}; pg8::StaticOrder S; S.init(TOK, DM, G, (int)blockIdx.x);
#if defined(DBG_NOFFN1)
      pg8::EpiResid E{x, H, XB, SSQ2, 1.0f};
#else
      pg8::EpiResid E{H, H, XB, SSQ2, 1.0f};
#endif
      pg8::gemm_phase<pg8::EpiResid, pg8::StaticOrder, true, true>(ldsl, g, S, E); }
    GRID_SYNC();
    if (DBG_STOP == 7) return;
    { pg8::Gemm g{XB, W2GU, TOK, 2 * DFF, DM}; pg8::StaticOrder S; S.init(TOK, 2 * DFF, G, (int)blockIdx.x);
      pg8::EpiSwiglu E{ACT, SSQ2};
      pg8::gemm_phase<pg8::EpiSwiglu, pg8::StaticOrder, true, true>(ldsl, g, S, E); }
    GRID_SYNC();
    if (G == 256) {
        pg8::Gemm g{ACT, W2D, TOK, DM, DFF}; pg8::StaticOrder S; S.init(TOK, DM, G, (int)blockIdx.x);
        pg8::EpiFinal E{H, H, SSQ3, args.in[22], (unsigned*)(ws + WS_BAR) + 3520, 0.5f};
        pg8::gemm_phase<pg8::EpiFinal, pg8::StaticOrder, true, true>(ldsl, g, S, E);
    } else {
        { pg8::Gemm g{ACT, W2D, TOK, DM, DFF}; pg8::StaticOrder S; S.init(TOK, DM, G, (int)blockIdx.x);
          pg8::EpiResid E{H, H, nullptr, SSQ3, 0.5f};
          pg8::gemm_phase<pg8::EpiResid, pg8::StaticOrder, true, true>(ldsl, g, S, E); }
        GRID_SYNC();
        const float* gf = args.in[22];
        for (int mrow = gw; mrow < TOK; mrow += NGW) {
            const float rs = pg8::rstd_of(SSQ3, mrow);
            f32x4* hr = (f32x4*)(H + (size_t)mrow * DM) + lane; const f32x4* gr = (const f32x4*)gf + lane;
#pragma unroll
            for (int j = 0; j < 4; ++j) { const f32x4 v = hr[64 * j], gg = gr[64 * j]; hr[64 * j] = v * rs * gg; }
        }
    }
}

extern "C" void kernel_launch(void* const* d_in, const int* in_sizes, int n_in, void* d_out, int out_size, void* d_ws, size_t ws_size, hipStream_t stream) {
    static int grid = 0;
    if (grid == 0) {
        int dev = 0, cus = 0, per_cu = 0;
        hipGetDevice(&dev);
        hipDeviceGetAttribute(&cus, hipDeviceAttributeMultiprocessorCount, dev);
        hipFuncSetAttribute((const void*)nsa_fwd, hipFuncAttributeMaxDynamicSharedMemorySize, LDS_BYTES);
        hipOccupancyMaxActiveBlocksPerMultiprocessor(&per_cu, (const void*)nsa_fwd, NWAVES * 64, LDS_BYTES);
        (void)hipGetLastError();
        if (per_cu < 1) per_cu = 1;
        grid = cus;
        if (n_in != 23 || ws_size < WS_END) { fprintf(stderr, "kernel_launch: unexpected n_in %d / ws %zu\n", n_in, ws_size); }
    }
    if (hipMemsetAsync((char*)d_ws + WS_BAR, 0, BAR_BYTES, stream) != hipSuccess) fprintf(stderr, "kernel_launch: memset of barrier words failed\n");
    Args a{};
    for (int i = 0; i < 23; ++i) a.in[i] = (const float*)d_in[i];
    a.out = (float*)d_out; a.ws = (unsigned char*)d_ws;
#ifndef REP4
#define REP4 1
#endif
#ifndef REP5
#define REP5 1
#endif
#ifndef REP6
#define REP6 1
#endif
#ifndef REPG
#define REPG 0
#endif
    a.rep[0] = REP4; a.rep[1] = REP5; a.rep[2] = REP6; a.rep[3] = REPG;
    void* kargs[] = {&a};
    hipError_t e = hipLaunchCooperativeKernel((const void*)nsa_fwd, dim3(grid), dim3(NWAVES * 64), kargs, LDS_BYTES, stream);
    if (e != hipSuccess) fprintf(stderr, "cooperative launch failed: %s (grid %d)\n", hipGetErrorString(e), grid);
}
```
